# Optimizing an MI355X kernel written in HIP

```python
import math
import jax, jax.numpy as jnp
from jax import lax
import numpy as np

D_MODEL = 2048
BATCH = 1
SEQ = 8192
DEPTH = 4

GRID_W = 64
QBLK = 128
HEAD_DIM = 64
BRANCH_W = 512
N_BRANCH = 4
ROPE_THETA = 10000.0
EPS = 1e-6
NEG = -1e30

A_HEADS = 8
A_NOPE = 64
A_ROPE = 32
A_V = 64
A_QK = A_NOPE + A_ROPE
Q_LORA = 384
KV_LORA = 128

B_HEADS = 8
B_KV_HEADS = 2
B_GROUP = B_HEADS // B_KV_HEADS

C_HEADS = 8
C_CONFIGS = ((128, 1), (512, 4), (2048, 16))
C_GROUPS = len(C_CONFIGS)

D_HEADS = 4
D_V = 2 * HEAD_DIM

NUM_BUCKETS = 32
T5_MAX_DISTANCE = 1024
BIAS_HEADS = C_GROUPS * C_HEADS + D_HEADS

IN_SPLITS = (
    Q_LORA, KV_LORA, A_ROPE,
    B_HEADS * HEAD_DIM, B_KV_HEADS * HEAD_DIM, B_KV_HEADS * HEAD_DIM,
    C_GROUPS * C_HEADS * HEAD_DIM, C_GROUPS * C_HEADS * HEAD_DIM, C_GROUPS * C_HEADS * HEAD_DIM,
    D_HEADS * 2 * HEAD_DIM, D_HEADS * 2 * HEAD_DIM, D_HEADS * D_V,
    N_BRANCH * BRANCH_W,
    N_BRANCH * D_MODEL,
)
N_IN = sum(IN_SPLITS)

kernel_name = "hybrid_gated_mla_gqa_dilated_diff_encoder"


def rmsnorm(x, w):
    xf = x.astype(jnp.float32)
    y = xf * lax.rsqrt(jnp.mean(xf * xf, axis=-1, keepdims=True) + EPS)
    return (y * w.astype(jnp.float32)).astype(x.dtype)


def rope_cos_sin(pos, dim):
    inv = ROPE_THETA ** (-jnp.arange(0, dim, 2, dtype=jnp.float32) / dim)
    ang = pos.astype(jnp.float32)[:, None] * inv[None, :]
    return jnp.cos(ang), jnp.sin(ang)


def apply_rope(x, cos, sin):
    half = x.shape[-1] // 2
    xf = x.astype(jnp.float32)
    x1, x2 = xf[..., :half], xf[..., half:]
    c, s = cos[:, None, :], sin[:, None, :]
    return jnp.concatenate([x1 * c - x2 * s, x1 * s + x2 * c], axis=-1).astype(x.dtype)


def rel_bucket(rel):
    nb = NUM_BUCKETS // 2
    max_exact = nb // 2
    side = jnp.where(rel > 0, nb, 0)
    n = jnp.abs(rel)
    nf = jnp.maximum(n, 1).astype(jnp.float32)
    large = max_exact + (jnp.log(nf / max_exact) / math.log(T5_MAX_DISTANCE / max_exact)
                         * (nb - max_exact)).astype(jnp.int32)
    large = jnp.minimum(large, nb - 1)
    return side + jnp.where(n < max_exact, n, large)


def sweep(fn, n_tokens):
    starts = jnp.arange(n_tokens // QBLK, dtype=jnp.int32) * QBLK
    return lax.map(fn, starts)


def unblock(y):
    nb, b, q = y.shape[:3]
    return jnp.moveaxis(y, 0, 1).reshape((b, nb * q) + y.shape[3:])


def block_q(a, t0):
    return lax.dynamic_slice_in_dim(a, t0, QBLK, axis=1)


def mla_mixer(c_q, c_kv, k_r, q_norm_w, kv_norm_w, w_uq, w_ukv, qk_norm, cos, sin):
    b, s, _ = c_q.shape
    q = (rmsnorm(c_q, q_norm_w) @ w_uq).reshape(b, s, A_HEADS, A_QK)
    kv = (rmsnorm(c_kv, kv_norm_w) @ w_ukv).reshape(b, s, A_HEADS, A_NOPE + A_V)
    k_nope, v = kv[..., :A_NOPE], kv[..., A_NOPE:]
    k = jnp.concatenate([k_nope, jnp.broadcast_to(k_r[:, :, None, :], (b, s, A_HEADS, A_ROPE))], axis=-1)
    q = rmsnorm(q, qk_norm[0])
    k = rmsnorm(k, qk_norm[1])
    q = jnp.concatenate([q[..., :A_NOPE], apply_rope(q[..., A_NOPE:], cos, sin)], axis=-1)
    k = jnp.concatenate([k[..., :A_NOPE], apply_rope(k[..., A_NOPE:], cos, sin)], axis=-1)
    scale = A_QK ** -0.5

    def blk(t0):
        qb = block_q(q, t0)
        logits = jnp.einsum('bqhd,bshd->bhqs', qb, k).astype(jnp.float32) * scale
        p = jax.nn.softmax(logits, axis=-1).astype(v.dtype)
        return jnp.einsum('bhqs,bshd->bqhd', p, v)

    return unblock(sweep(blk, s)).reshape(b, s, A_HEADS * A_V)


def gqa_axial_mixer(q, k, v, qk_norm, row_cs, col_cs):
    b, s, _ = q.shape
    half = HEAD_DIM // 2
    q = rmsnorm(q.reshape(b, s, B_HEADS, HEAD_DIM), qk_norm[0])
    k = rmsnorm(k.reshape(b, s, B_KV_HEADS, HEAD_DIM), qk_norm[1])
    v = v.reshape(b, s, B_KV_HEADS, HEAD_DIM)

    def axial(a):
        return jnp.concatenate([apply_rope(a[..., :half], *row_cs), apply_rope(a[..., half:], *col_cs)], axis=-1)

    q = axial(q).reshape(b, s, B_KV_HEADS, B_GROUP, HEAD_DIM)
    k = axial(k)
    scale = HEAD_DIM ** -0.5

    def blk(t0):
        qb = block_q(q, t0)
        logits = jnp.einsum('bqkgd,bskd->bkgqs', qb, k).astype(jnp.float32) * scale
        p = jax.nn.softmax(logits, axis=-1).astype(v.dtype)
        return jnp.einsum('bkgqs,bskd->bqkgd', p, v)

    return unblock(sweep(blk, s)).reshape(b, s, B_HEADS * HEAD_DIM)


def dilated_mixer(q, k, v, qk_norm, bias_table):
    b, s, _ = q.shape
    shp = (b, s, C_GROUPS, C_HEADS, HEAD_DIM)
    q = rmsnorm(q.reshape(shp), qk_norm[0][:, None, :])
    k = rmsnorm(k.reshape(shp), qk_norm[1][:, None, :])
    v = v.reshape(shp)
    scale = HEAD_DIM ** -0.5
    outs, lses = [], []
    for g, (window, dil) in enumerate(C_CONFIGS):
        n_side = window // (2 * dil)
        offs = dil * jnp.arange(-n_side, n_side + 1, dtype=jnp.int32)
        bias = bias_table[rel_bucket(offs)][:, g * C_HEADS:(g + 1) * C_HEADS].T
        qg, kg, vg = q[:, :, g], k[:, :, g], v[:, :, g]

        def blk(t0):
            qb = block_q(qg, t0)
            idx = t0 + jnp.arange(QBLK, dtype=jnp.int32)[:, None] + offs[None, :]
            valid = (idx >= 0) & (idx < s)
            idxc = jnp.clip(idx, 0, s - 1)
            kb = kg[:, idxc]
            vb = vg[:, idxc]
            logits = jnp.einsum('bqhd,bqjhd->bhqj', qb, kb).astype(jnp.float32) * scale
            logits = logits + bias[None, :, None, :].astype(jnp.float32)
            logits = jnp.where(valid[None, None], logits, NEG)
            lse = jax.nn.logsumexp(logits, axis=-1)
            p = jnp.exp(logits - lse[..., None]).astype(vb.dtype)
            o = jnp.einsum('bhqj,bqjhd->bqhd', p, vb)
            return o, jnp.swapaxes(lse, 1, 2)

        o, lse = sweep(blk, s)
        outs.append(unblock(o))
        lses.append(unblock(lse))
    wts = jax.nn.softmax(jnp.stack(lses, axis=0), axis=0)
    out = jnp.einsum('gbsh,gbshd->bshd', wts.astype(v.dtype), jnp.stack(outs, axis=0))
    return out.reshape(b, s, C_HEADS * HEAD_DIM)


def diff_mixer(q, k, v, qk_norm, lam_vecs, subnorm_w, bias_table, lambda_init):
    b, s, _ = q.shape
    q = rmsnorm(q.reshape(b, s, D_HEADS, 2, HEAD_DIM), qk_norm[0])
    k = rmsnorm(k.reshape(b, s, D_HEADS, 2, HEAD_DIM), qk_norm[1])
    v = v.reshape(b, s, D_HEADS, D_V)
    lv = lam_vecs.astype(jnp.float32)
    lam = jnp.exp(jnp.sum(lv[0] * lv[1])) - jnp.exp(jnp.sum(lv[2] * lv[3])) + lambda_init
    scale = HEAD_DIM ** -0.5
    kpos = jnp.arange(s, dtype=jnp.int32)

    def blk(t0):
        qb = block_q(q, t0)
        qpos = t0 + jnp.arange(QBLK, dtype=jnp.int32)
        bias = jnp.transpose(bias_table[rel_bucket(kpos[None, :] - qpos[:, None])], (2, 0, 1))
        logits = jnp.einsum('bqhmd,bshmd->bhmqs', qb, k).astype(jnp.float32) * scale
        logits = logits + bias[None, :, None].astype(jnp.float32)
        p = jax.nn.softmax(logits, axis=-1)
        attn = (p[:, :, 0] - lam * p[:, :, 1]).astype(v.dtype)
        return jnp.einsum('bhqs,bshe->bqhe', attn, v)

    o = unblock(sweep(blk, s))
    o = rmsnorm(o, subnorm_w) * (1.0 - lambda_init)
    return o.reshape(b, s, D_HEADS * D_V)


def setup_inputs(seed: int = 0) -> dict:
    key = jax.random.key(seed)
    ks = jax.random.split(key, 16)
    f32 = jnp.float32

    def nrm(k, shape, scale):
        return jax.random.normal(k, shape, f32) * scale

    def gain(k, shape):
        return 1.0 + nrm(k, shape, 0.02)

    return {
        "x": nrm(ks[0], (BATCH, SEQ, D_MODEL), 1.0),
        "norm_w": gain(ks[1], (DEPTH, D_MODEL)),
        "w_in": nrm(ks[2], (DEPTH, D_MODEL, N_IN), D_MODEL ** -0.5),
        "mla_q_norm": gain(ks[3], (DEPTH, Q_LORA)),
        "mla_kv_norm": gain(ks[4], (DEPTH, KV_LORA)),
        "mla_w_uq": nrm(ks[5], (DEPTH, Q_LORA, A_HEADS * A_QK), Q_LORA ** -0.5),
        "mla_w_ukv": nrm(ks[6], (DEPTH, KV_LORA, A_HEADS * (A_NOPE + A_V)), KV_LORA ** -0.5),
        "mla_qk_norm": gain(ks[7], (DEPTH, 2, A_QK)),
        "gqa_qk_norm": gain(ks[8], (DEPTH, 2, HEAD_DIM)),
        "dil_qk_norm": gain(ks[9], (DEPTH, 2, C_GROUPS, HEAD_DIM)),
        "diff_qk_norm": gain(ks[10], (DEPTH, 2, HEAD_DIM)),
        "diff_lambda": nrm(ks[11], (DEPTH, 4, HEAD_DIM), 0.1),
        "diff_subnorm": gain(ks[12], (DEPTH, D_V)),
        "rel_bias": nrm(ks[13], (NUM_BUCKETS, BIAS_HEADS), 0.2),
        "w_branch": nrm(ks[14], (DEPTH, N_BRANCH, BRANCH_W, D_MODEL), BRANCH_W ** -0.5),
        "w_out": nrm(ks[15], (DEPTH, D_MODEL, D_MODEL), 0.5 * D_MODEL ** -0.5),
    }


def reference(x, norm_w, w_in, mla_q_norm, mla_kv_norm, mla_w_uq, mla_w_ukv, mla_qk_norm,
              gqa_qk_norm, dil_qk_norm, diff_qk_norm, diff_lambda, diff_subnorm, rel_bias,
              w_branch, w_out):
    b, s, _ = x.shape
    rows = s // GRID_W
    pos = jnp.arange(s, dtype=jnp.int32)
    row_pos = jnp.repeat(jnp.arange(rows, dtype=jnp.int32), GRID_W)
    col_pos = jnp.tile(jnp.arange(GRID_W, dtype=jnp.int32), rows)
    a_cs = rope_cos_sin(pos, A_ROPE)
    row_cs = rope_cos_sin(row_pos, HEAD_DIM // 2)
    col_cs = rope_cos_sin(col_pos, HEAD_DIM // 2)
    split_pts = [int(p) for p in np.cumsum(IN_SPLITS)[:-1]]
    bias_c = rel_bias[:, :C_GROUPS * C_HEADS]
    bias_d = rel_bias[:, C_GROUPS * C_HEADS:]

    for l in range(DEPTH):
        h = rmsnorm(x, norm_w[l])
        proj = h @ w_in[l]
        (a_cq, a_ckv, a_kr, b_q, b_k, b_v, c_q, c_k, c_v,
         d_q, d_k, d_v, silu_g, merge_g) = jnp.split(proj, split_pts, axis=-1)

        y_a = mla_mixer(a_cq, a_ckv, a_kr, mla_q_norm[l], mla_kv_norm[l], mla_w_uq[l],
                        mla_w_ukv[l], mla_qk_norm[l], *a_cs)
        y_b = gqa_axial_mixer(b_q, b_k, b_v, gqa_qk_norm[l], row_cs, col_cs)
        y_c = dilated_mixer(c_q, c_k, c_v, dil_qk_norm[l], bias_c)
        lambda_init = 0.8 - 0.6 * math.exp(-0.3 * l)
        y_d = diff_mixer(d_q, d_k, d_v, diff_qk_norm[l], diff_lambda[l], diff_subnorm[l],
                         bias_d, lambda_init)

        y = jnp.stack([y_a, y_b, y_c, y_d], axis=2)
        y = y * jax.nn.silu(silu_g.reshape(b, s, N_BRANCH, BRANCH_W))
        z = jnp.einsum('bsnc,ncd->bsnd', y, w_branch[l])
        gates = jax.nn.sigmoid(merge_g.reshape(b, s, N_BRANCH, D_MODEL))
        mixed = jnp.sum(gates * z, axis=2)
        x = x + mixed @ w_out[l]
    return x
```

```cpp
#include <hip/hip_runtime.h>
#include <hip/hip_cooperative_groups.h>
#include <cstdio>
#include <cstdint>
namespace cg = cooperative_groups;

#define LAS __attribute__((address_space(3)))
#define DI __device__ __forceinline__
typedef unsigned short bf16_t;
typedef short bf16x8 __attribute__((ext_vector_type(8)));
typedef short s16x4 __attribute__((ext_vector_type(4)));
typedef float f32x4 __attribute__((ext_vector_type(4)));
typedef float f32x16 __attribute__((ext_vector_type(16)));
typedef unsigned u32x4 __attribute__((ext_vector_type(4)));
typedef unsigned u32x2 __attribute__((ext_vector_type(2)));

constexpr int S = 8192, DM = 2048, DEPTH = 4, NIN = 17696, LDP = 17920;
constexpr int NHT = 19, C_ACQ = 4864, C_ACKV = 5248, C_AKR = 5376, C_BV = 5408, C_CV = 5536, C_DV = 7072, C_SILU = 7584, C_GATE = 9632, C_END = 17824;
constexpr int SRC_BQ = 544, SRC_BK = 1056, SRC_BV = 1184, SRC_CQ = 1312, SRC_CK = 2848, SRC_CV = 4384, SRC_DQ = 5920, SRC_DK = 6432, SRC_DV = 6944, SRC_SILU = 7456, SRC_GATE = 9504;
__host__ __device__ inline int head_src(int idx) { return idx < 8 ? SRC_BQ + 64 * idx : idx < 10 ? SRC_BK + 64 * (idx - 8) : idx < 34 ? SRC_CQ + 64 * (idx - 10) : idx < 58 ? SRC_CK + 64 * (idx - 34)
                                                        : idx < 66 ? SRC_DQ + 64 * (idx - 58) : SRC_DK + 64 * (idx - 66); }
__host__ __device__ inline int in_src_col(int c) {
    if (c < NHT * 256) { const int T = c >> 8, ct = c & 255, bj = ct >> 7, wc = (ct >> 5) & 3, o = ct & 31, fq = o >> 3, n = (o >> 2) & 1, hs = 4 * T + wc;
        return hs < 74 ? head_src(hs) + 32 * bj + 16 * n + 4 * fq : -1; }
    const int r = c - NHT * 256;
    return r < 544 ? r : r < 672 ? SRC_BV + (r - 544) : r < 2208 ? SRC_CV + (r - 672) : r < 2720 ? SRC_DV + (r - 2208) : r < 4768 ? SRC_SILU + (r - 2720) : r < 12960 ? SRC_GATE + (r - 4768) : -1;
}
constexpr float EPS = 1e-6f;
constexpr float LOG2E = 1.4426950408889634f;

constexpr size_t MiB = 1u << 20;
constexpr size_t WS_WIN = 0;
constexpr size_t SZ_WIN1 = (size_t)LDP * DM * 2;
constexpr size_t WS_WB = WS_WIN + 4 * SZ_WIN1;
constexpr size_t SZ_WB1 = (size_t)4 * 2048 * 512 * 2;
constexpr size_t WS_WO = WS_WB + 4 * SZ_WB1;
constexpr size_t SZ_WO1 = (size_t)2048 * 2048 * 2;
constexpr size_t WS_WUQ = WS_WO + 4 * SZ_WO1;
constexpr size_t SZ_WUQ1 = (size_t)768 * 384 * 2;
constexpr size_t WS_WUKV = WS_WUQ + 4 * MiB;
constexpr size_t SZ_WUKV1 = (size_t)1024 * 256 * 2;
constexpr size_t WS_COS = WS_WUKV + 4 * MiB;
constexpr size_t WS_SIN = WS_COS + MiB;
constexpr size_t WS_DTAB = WS_SIN + MiB;
constexpr size_t WS_CTAB = WS_DTAB + MiB;
constexpr size_t WS_H = WS_CTAB + MiB;
constexpr size_t WS_PROJ = WS_H + 32 * MiB;
constexpr size_t WS_QUP = WS_PROJ + (size_t)S * LDP * 2;
constexpr size_t WS_KVUP = WS_QUP + 12 * MiB;
constexpr size_t WS_QA = WS_KVUP + 16 * MiB;
constexpr size_t WS_KA = WS_QA + 12 * MiB;
constexpr size_t WS_VA = WS_KA + 12 * MiB;
constexpr size_t WS_QB = WS_VA + 8 * MiB;
constexpr size_t WS_KB = WS_QB + 8 * MiB;
constexpr size_t WS_QC = WS_KB + 2 * MiB;
constexpr size_t WS_KC = WS_QC + 24 * MiB;
constexpr size_t WS_QD = WS_KC + 24 * MiB;
constexpr size_t WS_KD = WS_QD + 8 * MiB;
constexpr size_t WS_Y = WS_KD + 8 * MiB;
constexpr size_t WS_MIXF = WS_Y + 32 * MiB;
constexpr size_t WS_MIXB = WS_MIXF + 64 * MiB;
constexpr size_t WS_BAR = WS_MIXB + 32 * MiB;
constexpr size_t WS_SSQ = WS_BAR + MiB;
constexpr size_t WS_END = WS_SSQ + MiB;

constexpr int LDS_BYTES = 155648;
#ifndef REP_MASK
#define REP_MASK 0
#endif

DI unsigned cvt_pk(float lo, float hi) {
    typedef float f2 __attribute__((ext_vector_type(2))); typedef __bf16 b2 __attribute__((ext_vector_type(2)));
    f2 v = {lo, hi}; b2 b = __builtin_convertvector(v, b2); return __builtin_bit_cast(unsigned, b);
}
DI float bflo(unsigned u) { return __uint_as_float(u << 16); }
DI float bfhi(unsigned u) { return __uint_as_float(u & 0xffff0000u); }
DI void unpack8(const u32x4 v, float* x) { x[0] = bflo(v.x); x[1] = bfhi(v.x); x[2] = bflo(v.y); x[3] = bfhi(v.y); x[4] = bflo(v.z); x[5] = bfhi(v.z); x[6] = bflo(v.w); x[7] = bfhi(v.w); }
DI u32x4 pack8(const float* x) { u32x4 v; v.x = cvt_pk(x[0], x[1]); v.y = cvt_pk(x[2], x[3]); v.z = cvt_pk(x[4], x[5]); v.w = cvt_pk(x[6], x[7]); return v; }
DI float sigmoidf_(float v) { return __builtin_amdgcn_rcpf(1.0f + __expf(-v)); }
DI int crow(int r, int hi) { return (r & 3) + 8 * (r >> 2) + 4 * hi; }
DI float shx(float v, int m, int lane) { return __int_as_float(__builtin_amdgcn_ds_bpermute((lane ^ m) << 2, __float_as_int(v))); }

namespace pg8 {
constexpr int BM = 256, BK = 64, HALF = 128, HTB = HALF * BK * 2, STAGE_BYTES = 8 * HTB, NXCD = 8, WGM = 8;
DI int lds_byte(int r, int c) { const int st = (r >> 4) * 2 + (c >> 5), rr = r & 15, cc = c & 31, ob = rr * 64 + cc * 2; return st * 1024 + (ob ^ (((ob >> 9) & 1) << 5)); }
DI void stage_rc(int b, int& R, int& C) { const int st = b / 1024, sb = b % 1024, swz = sb ^ (((sb >> 9) & 1) << 5); R = (st >> 1) * 16 + swz / 64; C = (st & 1) * 32 + (swz % 64) / 2; }
DI int perm32(int rho) { const int n = rho >> 4, i = rho & 15; return 8 * (i >> 2) + 4 * n + (i & 3); }

struct Unit { int pm, pn, tag; const char* a; const char* b; };

DI void static_order(int L, int nM, int nN, int& pm, int& pn) {
    const int nwg = nM * nN; int wgid = L;
    { const int q = nwg / NXCD, r = nwg % NXCD, xcd = wgid % NXCD, off = wgid / NXCD; wgid = (xcd < r ? xcd * (q + 1) : r * (q + 1) + (xcd - r) * q) + off; }
    const int nig = WGM * nN, gid = wgid / nig, fm = gid * WGM, gsz = (nM - fm) < WGM ? (nM - fm) : WGM;
    pm = fm + ((wgid % nig) % gsz); pn = (wgid % nig) / gsz;
}
struct SchedGrid {
    const char* A; const char* B; int nM, nN, G, c; size_t tstepA, tstepB;
    DI bool next(int i, Unit& u) const {
        const long L = (long)i * G + c; if (L >= (long)nM * nN) return false;
        static_order((int)L, nM, nN, u.pm, u.pn); u.tag = 0; u.a = A + (size_t)u.pm * tstepA; u.b = B + (size_t)u.pn * tstepB; return true;
    }
};
struct SchedBranch {
    const char* A; const char* B; int nM, nN, G, c; size_t tstepA, tstepB, bstepA, bstepB;
    DI bool next(int i, Unit& u) const {
        const long L = (long)(i >> 2) * G + c; if (L >= (long)nM * nN) return false;
        static_order((int)L, nM, nN, u.pm, u.pn); u.tag = i & 3;
        u.a = A + (size_t)u.pm * tstepA + (size_t)u.tag * bstepA; u.b = B + (size_t)u.pn * tstepB + (size_t)u.tag * bstepB; return true;
    }
};

struct EpiBf16 {
    static constexpr bool HOOK = false;
    bf16_t* O; int ldc;
    DI void operator()(const f32x4 (&acc)[2][2][4][2], const Unit& u, int wr, int wc, int fr, int fq) const {
        const int row0 = u.pm * BM + wr * 64 + fr, col0 = u.pn * BM + wc * 32 + 8 * fq;
#pragma unroll
        for (int ai = 0; ai < 2; ++ai)
#pragma unroll
            for (int m = 0; m < 4; ++m) { bf16_t* rowp = O + (size_t)(row0 + ai * HALF + m * 16) * ldc + col0;
#pragma unroll
                for (int bj = 0; bj < 2; ++bj) { const f32x4 v0 = acc[ai][bj][m][0], v1 = acc[ai][bj][m][1];
                    u32x4 w; w.x = cvt_pk(v0[0], v0[1]); w.y = cvt_pk(v0[2], v0[3]); w.z = cvt_pk(v1[0], v1[1]); w.w = cvt_pk(v1[2], v1[3]);
                    *(u32x4*)(rowp + bj * HALF) = w; } }
    }
};
struct HeadInfo { const float* wv; bf16_t* dst; int dstride; float scale; bool rope; };
struct EpiProj {
    static constexpr bool HOOK = false;
    bf16_t* O; const float* ssq;
    const float* gqa_n; const float* dil_n; const float* diff_n;
    const float* cosT; const float* sinT;
    bf16_t* Qb; bf16_t* Kb; bf16_t* Qc; bf16_t* Kc; bf16_t* Qd; bf16_t* Kd;
    DI HeadInfo head(int idx) const {
        HeadInfo h; h.dstride = 64; h.scale = 1.f; h.rope = false;
        if (idx < 8) { h.wv = gqa_n; h.dst = Qb + (size_t)idx * S * 64; h.scale = 0.125f * LOG2E; h.rope = true; }
        else if (idx < 10) { h.wv = gqa_n + 64; h.dst = Kb + (size_t)(idx - 8) * S * 64; h.rope = true; }
        else if (idx < 34) { const int j = idx - 10; h.wv = dil_n + (j >> 3) * 64; h.dst = Qc + (size_t)j * S * 64; h.scale = 0.125f * LOG2E; }
        else if (idx < 58) { const int j = idx - 34; h.wv = dil_n + (3 + (j >> 3)) * 64; h.dst = Kc + (size_t)j * S * 64; }
        else if (idx < 66) { const int j = idx - 58; h.wv = diff_n; h.dst = Qd + (size_t)(j >> 1) * S * 128 + (j & 1) * 64; h.dstride = 128; h.scale = 0.125f * LOG2E; }
        else { const int j = idx - 66; h.wv = diff_n + 64; h.dst = Kd + (size_t)(j >> 1) * S * 128 + (j & 1) * 64; h.dstride = 128; }
        return h;
    }
    DI void operator()(const f32x4 (&acc)[2][2][4][2], const Unit& u, int wr, int wc, int fr, int fq) const {
        int row0 = u.pm * BM + wr * 64 + fr, col0 = u.pn * BM + wc * 32 + 8 * fq;
        asm volatile("" : "+v"(row0), "+v"(col0));
        float rstd[2][4];
#pragma unroll
        for (int ai = 0; ai < 2; ++ai)
#pragma unroll
            for (int m = 0; m < 4; ++m) rstd[ai][m] = rsqrtf(ssq[row0 + ai * HALF + m * 16] * (1.0f / DM) + EPS);
        if (u.pn < NHT) {
            const int hs = 4 * u.pn + wc;
            if (hs >= 74) return;
            const HeadInfo hd = head(hs);
            const int lane = fq * 16 + fr;
            f32x4 w[2][2];
#pragma unroll
            for (int bj = 0; bj < 2; ++bj)
#pragma unroll
                for (int n = 0; n < 2; ++n) w[bj][n] = *(const f32x4*)(hd.wv + 32 * bj + 16 * n + 4 * fq) * hd.scale;
#pragma unroll
            for (int ai = 0; ai < 2; ++ai)
#pragma unroll
                for (int m = 0; m < 4; ++m) {
                    const int t = row0 + ai * HALF + m * 16;
                    f32x4 x[2][2]; float ss = 0.f;
#pragma unroll
                    for (int bj = 0; bj < 2; ++bj)
#pragma unroll
                        for (int n = 0; n < 2; ++n) { x[bj][n] = acc[ai][bj][m][n] * rstd[ai][m]; const f32x4 q = x[bj][n] * x[bj][n]; ss += (q[0] + q[1]) + (q[2] + q[3]); }
                    ss += shx(ss, 16, lane); ss += shx(ss, 32, lane);
                    const float rn = rsqrtf(ss * (1.0f / 64.0f) + EPS);
#pragma unroll
                    for (int bj = 0; bj < 2; ++bj) {
                        f32x4 x1 = x[bj][0] * rn * w[bj][0], x2 = x[bj][1] * rn * w[bj][1];
                        if (hd.rope) {
                            const int pos = bj == 0 ? (t >> 6) : (t & 63);
                            const f32x4 c = *(const f32x4*)(cosT + pos * 16 + 4 * fq), sn = *(const f32x4*)(sinT + pos * 16 + 4 * fq);
                            const f32x4 y1 = x1 * c - x2 * sn, y2 = x1 * sn + x2 * c; x1 = y1; x2 = y2;
                        }
                        bf16_t* d = hd.dst + (size_t)t * hd.dstride + 32 * bj + 4 * fq;
                        u32x2 o1, o2; o1.x = cvt_pk(x1[0], x1[1]); o1.y = cvt_pk(x1[2], x1[3]); o2.x = cvt_pk(x2[0], x2[1]); o2.y = cvt_pk(x2[2], x2[3]);
                        *(u32x2*)d = o1; *(u32x2*)(d + 16) = o2;
                    }
                }
            return;
        }
#pragma unroll
        for (int bj = 0; bj < 2; ++bj) {
            const int colw = u.pn * BM + bj * HALF + wc * 32;
            const int act = colw < C_SILU ? 0 : (colw < C_GATE ? 1 : 2);
#pragma unroll
            for (int ai = 0; ai < 2; ++ai)
#pragma unroll
                for (int m = 0; m < 4; ++m) {
                    float v[8];
#pragma unroll
                    for (int j = 0; j < 4; ++j) { v[j] = acc[ai][bj][m][0][j] * rstd[ai][m]; v[4 + j] = acc[ai][bj][m][1][j] * rstd[ai][m]; }
                    if (act) {
#pragma unroll
                        for (int j = 0; j < 8; ++j) { const float sg = sigmoidf_(v[j]); v[j] = act == 1 ? v[j] * sg : sg; }
                    }
                    *(u32x4*)(O + (size_t)(row0 + ai * HALF + m * 16) * LDP + col0 + bj * HALF) = pack8(v);
                }
        }
    }
};
struct EpiBranch {
    static constexpr bool HOOK = true;
    bf16_t* MB; const bf16_t* G;
    DI void hook(f32x4 (&acc)[2][2][4][2], const Unit& u, int n, int wr, int wc, int fr, int fq) const {
        int row0 = u.pm * BM + wr * 64 + fr, col0 = u.pn * BM + wc * 32 + 8 * fq;
        asm volatile("" : "+v"(row0), "+v"(col0));
#pragma unroll
        for (int ai = 0; ai < 2; ++ai) {
#pragma unroll
            for (int m = 0; m < 4; ++m) { const size_t row = (size_t)(row0 + ai * HALF + m * 16);
#pragma unroll
                for (int bj = 0; bj < 2; ++bj) { const int col = col0 + bj * HALF;
                    float gp[8], gc[8]; unpack8(*(const u32x4*)(G + row * LDP + (size_t)(n - 1) * DM + col), gp); unpack8(*(const u32x4*)(G + row * LDP + (size_t)n * DM + col), gc);
#pragma unroll
                    for (int j = 0; j < 4; ++j) { acc[ai][bj][m][0][j] *= fmaxf(gp[j], 1e-30f) * __builtin_amdgcn_rcpf(fmaxf(gc[j], 1e-30f));
                                                  acc[ai][bj][m][1][j] *= fmaxf(gp[4 + j], 1e-30f) * __builtin_amdgcn_rcpf(fmaxf(gc[4 + j], 1e-30f)); } }
                if (m & 1) asm volatile("" ::: "memory"); }
        }
    }
    DI void operator()(const f32x4 (&acc)[2][2][4][2], const Unit& u, int wr, int wc, int fr, int fq) const {
        int row0 = u.pm * BM + wr * 64 + fr, col0 = u.pn * BM + wc * 32 + 8 * fq;
        asm volatile("" : "+v"(row0), "+v"(col0));
#pragma unroll
        for (int ai = 0; ai < 2; ++ai)
#pragma unroll
            for (int m = 0; m < 4; ++m) { const size_t row = (size_t)(row0 + ai * HALF + m * 16);
#pragma unroll
                for (int bj = 0; bj < 2; ++bj) { const int col = col0 + bj * HALF;
                    float g[8]; unpack8(*(const u32x4*)(G + row * LDP + (size_t)3 * DM + col), g);
                    const f32x4 v0 = acc[ai][bj][m][0], v1 = acc[ai][bj][m][1];
                    u32x4 w; w.x = cvt_pk(v0[0] * fmaxf(g[0], 1e-30f), v0[1] * fmaxf(g[1], 1e-30f)); w.y = cvt_pk(v0[2] * fmaxf(g[2], 1e-30f), v0[3] * fmaxf(g[3], 1e-30f));
                    w.z = cvt_pk(v1[0] * fmaxf(g[4], 1e-30f), v1[1] * fmaxf(g[5], 1e-30f)); w.w = cvt_pk(v1[2] * fmaxf(g[6], 1e-30f), v1[3] * fmaxf(g[7], 1e-30f));
                    *(u32x4*)(MB + row * DM + col) = w; } }
    }
};
template <bool NEXT>
struct EpiOut {
    static constexpr bool HOOK = false;
    const float* Xin; float* Xout; bf16_t* XB; float* ssq;
    DI void operator()(const f32x4 (&acc)[2][2][4][2], const Unit& u, int wr, int wc, int fr, int fq) const {
        int row0 = u.pm * BM + wr * 64 + fr, col0 = u.pn * BM + wc * 32 + 8 * fq; const int lane = fq * 16 + fr;
        asm volatile("" : "+v"(row0), "+v"(col0));
#pragma unroll
        for (int ai = 0; ai < 2; ++ai) {
            f32x4 xa[4][2][2];
#pragma unroll
            for (int m = 0; m < 4; ++m)
#pragma unroll
                for (int bj = 0; bj < 2; ++bj) { const size_t off = (size_t)(row0 + ai * HALF + m * 16) * DM + col0 + bj * HALF;
                    xa[m][bj][0] = *(const f32x4*)(Xin + off); xa[m][bj][1] = *(const f32x4*)(Xin + off + 4); }
#pragma unroll
            for (int m = 0; m < 4; ++m) { const int row = row0 + ai * HALF + m * 16; float ss = 0.f;
#pragma unroll
                for (int bj = 0; bj < 2; ++bj) { const size_t off = (size_t)row * DM + col0 + bj * HALF;
                    const f32x4 a = xa[m][bj][0] + acc[ai][bj][m][0], b = xa[m][bj][1] + acc[ai][bj][m][1];
                    *(f32x4*)(Xout + off) = a; *(f32x4*)(Xout + off + 4) = b;
                    if (NEXT) { u32x4 w; w.x = cvt_pk(a[0], a[1]); w.y = cvt_pk(a[2], a[3]); w.z = cvt_pk(b[0], b[1]); w.w = cvt_pk(b[2], b[3]); *(u32x4*)(XB + off) = w;
                        ss += (a[0] * a[0] + a[1] * a[1]) + (a[2] * a[2] + a[3] * a[3]) + (b[0] * b[0] + b[1] * b[1]) + (b[2] * b[2] + b[3] * b[3]); } }
                if (NEXT) { ss += shx(ss, 16, lane); ss += shx(ss, 32, lane); if (fq == 0) atomicAdd(ssq + row, ss); } }
            asm volatile("" ::: "memory");
        }
    }
};

template <class Epi, class Sched>
DI void gemm_phase(LAS unsigned char* lds, const int tid, const int K, const int lda, const int ldb, const Sched& S_, const Epi& E) {
    const int wid = __builtin_amdgcn_readfirstlane(tid >> 6), lane = tid & 63, wr = wid >> 2, wc = wid & 3, fr = lane & 15, fq = lane >> 4;
    const int nt = K / BK;
    unsigned voffA[2], voffB[2];
#pragma unroll
    for (int i = 0; i < 2; ++i) { int R, C; stage_rc(tid * 16 + i * 8192, R, C); const int Rb = (R & ~31) + perm32(R & 31);
        voffA[i] = (unsigned)(R * lda + C) * 2u; voffB[i] = (unsigned)(Rb * ldb + C) * 2u; }
    const size_t kstep = (size_t)(BK * 2);
    const size_t hstepA = (size_t)HALF * lda * 2, hstepB = (size_t)HALF * ldb * 2;
    const unsigned ldsw = (unsigned)wid * 1024u;
    const int aoff = lds_byte(wr * 64 + fr, fq * 8), boff = lds_byte(wc * 32 + fr, fq * 8);
#define PG8_SA(b, h) (((b) * 2 + (h)) * HTB)
#define PG8_SB(b, h) ((4 + (b) * 2 + (h)) * HTB)
#define PG8_STAGE(bufoff, gbase, voff) do { _Pragma("unroll") for (int _i = 0; _i < 2; ++_i) \
        __builtin_amdgcn_global_load_lds((const unsigned*)((const char*)(gbase) + (voff)[_i]), (LAS unsigned*)(lds + (bufoff) + ldsw + _i * 8192), 16, 0, 0); } while (0)
#define PG8_LDA(dst, b, h) do { _Pragma("unroll") for (int m = 0; m < 4; ++m) _Pragma("unroll") for (int k = 0; k < 2; ++k) dst[m][k] = *(const LAS bf16x8*)(lds + PG8_SA(b, h) + aoff + m * 2048 + k * 1024); } while (0)
#define PG8_LDB(dst, b, h) do { _Pragma("unroll") for (int n = 0; n < 2; ++n) _Pragma("unroll") for (int k = 0; k < 2; ++k) dst[n][k] = *(const LAS bf16x8*)(lds + PG8_SB(b, h) + boff + n * 2048 + k * 1024); } while (0)
#define PG8_MMA(ai, bj, At, Bt) do { __builtin_amdgcn_s_setprio(1); _Pragma("unroll") for (int m = 0; m < 4; ++m) _Pragma("unroll") for (int n = 0; n < 2; ++n) _Pragma("unroll") for (int k = 0; k < 2; ++k) \
        acc[ai][bj][m][n] = __builtin_amdgcn_mfma_f32_16x16x32_bf16(Bt[n][k], At[m][k], acc[ai][bj][m][n], 0, 0, 0); __builtin_amdgcn_s_setprio(0); } while (0)
#define PG8_WAIT_V(n) asm volatile("s_waitcnt vmcnt(" #n ")" ::: "memory")
#define PG8_WAIT_L(n) asm volatile("s_waitcnt lgkmcnt(" #n ")" ::: "memory")
#define PG8_BAR __builtin_amdgcn_s_barrier()
#define PG8_SCHED __builtin_amdgcn_sched_barrier(0)
    Unit cur, nxt; int ui = 0;
    if (!S_.next(0, cur)) return;
    f32x4 acc[2][2][4][2];
#pragma unroll
    for (int a = 0; a < 2; ++a)
#pragma unroll
        for (int b = 0; b < 2; ++b)
#pragma unroll
            for (int m = 0; m < 4; ++m)
#pragma unroll
                for (int n = 0; n < 2; ++n) acc[a][b][m][n] = (f32x4){0.f, 0.f, 0.f, 0.f};
    bf16x8 At[4][2], B0[2][2], B1[2][2];
    const char* cA = cur.a; const char* cB = cur.b;
    PG8_STAGE(PG8_SB(0, 0), cB, voffB); PG8_STAGE(PG8_SB(0, 1), cB + hstepB, voffB); PG8_STAGE(PG8_SA(0, 0), cA, voffA); PG8_STAGE(PG8_SA(0, 1), cA + hstepA, voffA);
    if (wr == 1) PG8_BAR;
    PG8_WAIT_V(2); PG8_BAR;
    PG8_STAGE(PG8_SB(1, 0), cB + kstep, voffB); PG8_STAGE(PG8_SA(1, 0), cA + kstep, voffA); PG8_STAGE(PG8_SB(1, 1), cB + hstepB + kstep, voffB);
    PG8_WAIT_V(6); PG8_BAR;
    for (;;) {
        const bool has_next = S_.next(ui + 1, nxt);
        const char* nA = has_next ? nxt.a : cA; const char* nB = has_next ? nxt.b : cB;
        for (int t = 0; t < nt; t += 2) {
            const bool last = (t == nt - 2);
            const char* a1 = cA + (size_t)(t + 1) * kstep;
            const char* a2 = last ? nA : cA + (size_t)(t + 2) * kstep; const char* b2 = last ? nB : cB + (size_t)(t + 2) * kstep;
            const char* a3 = a2 + kstep; const char* b3 = b2 + kstep;
            PG8_LDB(B0, 0, 0); PG8_LDB(B1, 0, 1); PG8_SCHED; PG8_LDA(At, 0, 0); PG8_STAGE(PG8_SA(1, 1), a1 + hstepA, voffA);
            PG8_WAIT_V(8); PG8_WAIT_L(0); PG8_BAR; PG8_MMA(0, 0, At, B0); PG8_MMA(0, 1, At, B1); PG8_BAR; PG8_SCHED;
            PG8_LDA(At, 0, 1); PG8_STAGE(PG8_SB(0, 0), b2, voffB); PG8_STAGE(PG8_SB(0, 1), b2 + hstepB, voffB); PG8_STAGE(PG8_SA(0, 0), a2, voffA);
            PG8_WAIT_V(8); PG8_WAIT_L(0); PG8_BAR; PG8_MMA(1, 0, At, B0); PG8_MMA(1, 1, At, B1); PG8_BAR; PG8_SCHED;
            PG8_LDB(B0, 1, 0); PG8_LDB(B1, 1, 1); PG8_SCHED; PG8_LDA(At, 1, 0); PG8_STAGE(PG8_SA(0, 1), a2 + hstepA, voffA);
            PG8_WAIT_V(8); PG8_WAIT_L(0); PG8_BAR; PG8_MMA(0, 0, At, B0); PG8_MMA(0, 1, At, B1); PG8_BAR; PG8_SCHED;
            PG8_LDA(At, 1, 1); PG8_STAGE(PG8_SB(1, 0), b3, voffB); PG8_STAGE(PG8_SB(1, 1), b3 + hstepB, voffB); PG8_STAGE(PG8_SA(1, 0), a3, voffA);
            PG8_WAIT_V(8); PG8_WAIT_L(0); PG8_BAR; PG8_MMA(1, 0, At, B0); PG8_MMA(1, 1, At, B1); PG8_BAR; PG8_SCHED;
            if constexpr (Epi::HOOK) { if (((t + 2) & 7) == 0 && !last) { E.hook(acc, cur, (t + 2) >> 3, wr, wc, fr, fq); PG8_SCHED; } }
        }
        if (wr == 0) PG8_BAR;
        E(acc, cur, wr, wc, fr, fq);
        if (!has_next) break;
#pragma unroll
        for (int a = 0; a < 2; ++a)
#pragma unroll
            for (int b = 0; b < 2; ++b)
#pragma unroll
                for (int m = 0; m < 4; ++m)
#pragma unroll
                    for (int n = 0; n < 2; ++n) acc[a][b][m][n] = (f32x4){0.f, 0.f, 0.f, 0.f};
        cur = nxt; cA = nA; cB = nB; ++ui;
        if (wr == 1) PG8_BAR;
    }
    PG8_WAIT_V(0);
    PG8_BAR;
#undef PG8_SA
#undef PG8_SB
#undef PG8_STAGE
#undef PG8_LDA
#undef PG8_LDB
#undef PG8_MMA
#undef PG8_WAIT_V
#undef PG8_WAIT_L
#undef PG8_BAR
#undef PG8_SCHED
}
}

#define MFMA32(a, b, c) __builtin_amdgcn_mfma_f32_32x32x16_bf16((a), (b), (c), 0, 0, 0)
typedef short v4i16_t __attribute__((ext_vector_type(4)));
DI s16x4 vtr(const LAS unsigned char* p) { return __builtin_bit_cast(s16x4, __builtin_amdgcn_ds_read_tr16_b64_v4i16((LAS v4i16_t*)p)); }
constexpr float THR = 8.0f;

template <int DQK, int KP>
DI void qk_tile(f32x16& p0, f32x16& p1, const LAS unsigned char* kp, const bf16x8* qf) {
#pragma unroll
    for (int d0 = 0; d0 < DQK / 16; ++d0) {
        const bf16x8 a0 = *(const LAS bf16x8*)(kp + d0 * 32);
        const bf16x8 a1 = *(const LAS bf16x8*)(kp + 32 * KP + d0 * 32);
        p0 = MFMA32(a0, qf[d0], p0); p1 = MFMA32(a1, qf[d0], p1);
    }
}
template <int DV, int VP>
DI void softmax_pv(f32x16& p0, f32x16& p1, float& l, f32x16 (&o)[DV / 32], const LAS unsigned char* vp) {
    float s0 = 0.f, s1 = 0.f, s2 = 0.f, s3 = 0.f;
#pragma unroll
    for (int r = 0; r < 16; r += 4) {
        p0[r] = __builtin_amdgcn_exp2f(p0[r]); p0[r + 1] = __builtin_amdgcn_exp2f(p0[r + 1]); p0[r + 2] = __builtin_amdgcn_exp2f(p0[r + 2]); p0[r + 3] = __builtin_amdgcn_exp2f(p0[r + 3]);
        s0 += p0[r]; s1 += p0[r + 1]; s2 += p0[r + 2]; s3 += p0[r + 3];
    }
#pragma unroll
    for (int r = 0; r < 16; r += 4) {
        p1[r] = __builtin_amdgcn_exp2f(p1[r]); p1[r + 1] = __builtin_amdgcn_exp2f(p1[r + 1]); p1[r + 2] = __builtin_amdgcn_exp2f(p1[r + 2]); p1[r + 3] = __builtin_amdgcn_exp2f(p1[r + 3]);
        s0 += p1[r]; s1 += p1[r + 1]; s2 += p1[r + 2]; s3 += p1[r + 3];
    }
    l += (s0 + s1) + (s2 + s3);
    u32x4 pw[4];
    pw[0] = (u32x4){cvt_pk(p0[0], p0[1]), cvt_pk(p0[2], p0[3]), cvt_pk(p0[4], p0[5]), cvt_pk(p0[6], p0[7])};
    pw[1] = (u32x4){cvt_pk(p0[8], p0[9]), cvt_pk(p0[10], p0[11]), cvt_pk(p0[12], p0[13]), cvt_pk(p0[14], p0[15])};
    pw[2] = (u32x4){cvt_pk(p1[0], p1[1]), cvt_pk(p1[2], p1[3]), cvt_pk(p1[4], p1[5]), cvt_pk(p1[6], p1[7])};
    pw[3] = (u32x4){cvt_pk(p1[8], p1[9]), cvt_pk(p1[10], p1[11]), cvt_pk(p1[12], p1[13]), cvt_pk(p1[14], p1[15])};
#pragma unroll
    for (int d0 = 0; d0 < DV / 32; ++d0)
#pragma unroll
        for (int ks = 0; ks < 4; ++ks) {
            const s16x4 lo = vtr(vp + (16 * ks) * VP + d0 * 64);
            const s16x4 hh = vtr(vp + (16 * ks + 8) * VP + d0 * 64);
            const bf16x8 vf = (bf16x8){lo[0], lo[1], lo[2], lo[3], hh[0], hh[1], hh[2], hh[3]};
            o[d0] = MFMA32(vf, __builtin_bit_cast(bf16x8, pw[ks]), o[d0]);
        }
}

DI void exp_tile(f32x16& p0, f32x16& p1) {
#pragma unroll
    for (int r = 0; r < 16; ++r) p0[r] = __builtin_amdgcn_exp2f(p0[r]);
#pragma unroll
    for (int r = 0; r < 16; ++r) p1[r] = __builtin_amdgcn_exp2f(p1[r]);
}
DI void sum_pack(const f32x16& p0, const f32x16& p1, float& l, u32x4 (&pw)[4]) {
    float s0 = 0.f, s1 = 0.f, s2 = 0.f, s3 = 0.f;
#pragma unroll
    for (int r = 0; r < 16; r += 4) { s0 += p0[r]; s1 += p0[r + 1]; s2 += p0[r + 2]; s3 += p0[r + 3]; }
#pragma unroll
    for (int r = 0; r < 16; r += 4) { s0 += p1[r]; s1 += p1[r + 1]; s2 += p1[r + 2]; s3 += p1[r + 3]; }
    l += (s0 + s1) + (s2 + s3);
    pw[0] = (u32x4){cvt_pk(p0[0], p0[1]), cvt_pk(p0[2], p0[3]), cvt_pk(p0[4], p0[5]), cvt_pk(p0[6], p0[7])};
    pw[1] = (u32x4){cvt_pk(p0[8], p0[9]), cvt_pk(p0[10], p0[11]), cvt_pk(p0[12], p0[13]), cvt_pk(p0[14], p0[15])};
    pw[2] = (u32x4){cvt_pk(p1[0], p1[1]), cvt_pk(p1[2], p1[3]), cvt_pk(p1[4], p1[5]), cvt_pk(p1[6], p1[7])};
    pw[3] = (u32x4){cvt_pk(p1[8], p1[9]), cvt_pk(p1[10], p1[11]), cvt_pk(p1[12], p1[13]), cvt_pk(p1[14], p1[15])};
}
template <int DV, int VP>
DI void pv_tile(f32x16 (&o)[DV / 32], const u32x4 (&pw)[4], const LAS unsigned char* vp) {
#pragma unroll
    for (int kh = 0; kh < 2; ++kh) {
        bf16x8 vf[DV / 32][2];
#pragma unroll
        for (int d0 = 0; d0 < DV / 32; ++d0)
#pragma unroll
            for (int k2 = 0; k2 < 2; ++k2) { const int ks = 2 * kh + k2;
                const s16x4 lo = vtr(vp + (16 * ks) * VP + d0 * 64);
                const s16x4 hh = vtr(vp + (16 * ks + 8) * VP + d0 * 64);
                vf[d0][k2] = (bf16x8){lo[0], lo[1], lo[2], lo[3], hh[0], hh[1], hh[2], hh[3]}; }
#pragma unroll
        for (int k2 = 0; k2 < 2; ++k2)
#pragma unroll
            for (int d0 = 0; d0 < DV / 32; ++d0) o[d0] = MFMA32(vf[d0][k2], __builtin_bit_cast(bf16x8, pw[2 * kh + k2]), o[d0]);
    }
}

typedef __bf16 bf16x2_t __attribute__((ext_vector_type(2)));
DI float dot2_ones(unsigned packed, float c) { return __builtin_amdgcn_fdot2_f32_bf16(__builtin_bit_cast(bf16x2_t, packed), __builtin_bit_cast(bf16x2_t, 0x3f803f80u), c, false); }
DI void rowsum_pw(const u32x4 (&pw)[4], float (&ls)[4]) {
#pragma unroll
    for (int w = 0; w < 16; ++w) ls[w & 3] = dot2_ones(pw[w >> 2][w & 3], ls[w & 3]);
}
DI void pack_tile(const f32x16& p0, const f32x16& p1, u32x4 (&pw)[4]) {
    pw[0] = (u32x4){cvt_pk(p0[0], p0[1]), cvt_pk(p0[2], p0[3]), cvt_pk(p0[4], p0[5]), cvt_pk(p0[6], p0[7])};
    pw[1] = (u32x4){cvt_pk(p0[8], p0[9]), cvt_pk(p0[10], p0[11]), cvt_pk(p0[12], p0[13]), cvt_pk(p0[14], p0[15])};
    pw[2] = (u32x4){cvt_pk(p1[0], p1[1]), cvt_pk(p1[2], p1[3]), cvt_pk(p1[4], p1[5]), cvt_pk(p1[6], p1[7])};
    pw[3] = (u32x4){cvt_pk(p1[8], p1[9]), cvt_pk(p1[10], p1[11]), cvt_pk(p1[12], p1[13]), cvt_pk(p1[14], p1[15])};
}
template <int DQK, int KP, int DV, int VP, bool CONSTC, int KWIN = 8, bool ONES = false>
DI void tile_step(u32x4 (&pw)[4], f32x16& pn0, f32x16& pn1, const f32x16& cvec, float (&ls)[4], f32x16 (&o)[DV / 32], const bf16x8* qf,
                  const LAS unsigned char* kp, const LAS unsigned char* vp, f32x16* osum = nullptr, bf16x8 onesf = bf16x8{}) {
    constexpr int NKS = DQK / 16, NQK = 2 * NKS, ND0 = DV / 32, NPV = 4 * ND0, EPG = 32 / NPV, W = (DV > 64) ? 4 : 8;
#define SB_ __builtin_amdgcn_sched_barrier(0)
#define VFRAG(f) do { const int ks_ = (f) / ND0, d0_ = (f) % ND0; const s16x4 lo_ = vtr(vp + (16 * ks_) * VP + d0_ * 64); const s16x4 hh_ = vtr(vp + (16 * ks_ + 8) * VP + d0_ * 64); \
        vf[(f) % W] = (bf16x8){lo_[0], lo_[1], lo_[2], lo_[3], hh_[0], hh_[1], hh_[2], hh_[3]}; } while (0)
#define KFRAG(i) do { kf[(i) % KWIN] = *(const LAS bf16x8*)(kp + ((i) & 1) * 32 * KP + ((i) >> 1) * 32); } while (0)
#define PVAL(r) ((r) < 16 ? pn0[(r) & 15] : pn1[(r) & 15])
    bf16x8 kf[KWIN];
#pragma unroll
    for (int i = 0; i < KWIN; ++i) KFRAG(i);
    SB_;
    bf16x8 vf[W]; u32x4 pwn[4];
#pragma unroll
    for (int i = 0; i < NQK; ++i) {
        if (CONSTC && i < 2) { if (i == 0) pn0 = MFMA32(kf[0], qf[0], cvec); else pn1 = MFMA32(kf[1], qf[0], cvec); }
        else if ((i & 1) == 0) pn0 = MFMA32(kf[i % KWIN], qf[i >> 1], pn0); else pn1 = MFMA32(kf[i % KWIN], qf[i >> 1], pn1);
        if (i + KWIN < NQK) KFRAG(i + KWIN);
        if (i < W) VFRAG(i);
        if (!ONES && i < 8) { ls[(2 * i) & 3] = dot2_ones(pw[(2 * i) >> 2][(2 * i) & 3], ls[(2 * i) & 3]); ls[(2 * i + 1) & 3] = dot2_ones(pw[(2 * i + 1) >> 2][(2 * i + 1) & 3], ls[(2 * i + 1) & 3]); }
        SB_;
        if (ONES && (i & 1) && i < 8) { *osum = MFMA32(onesf, __builtin_bit_cast(bf16x8, pw[i >> 1]), *osum); SB_; }
    }
#pragma unroll
    for (int j = 0; j < NPV; ++j) {
        o[j % ND0] = MFMA32(vf[j % W], __builtin_bit_cast(bf16x8, pw[j / ND0]), o[j % ND0]);
        if (j + W < NPV) VFRAG(j + W);
#pragma unroll
        for (int e = 0; e < EPG; ++e) { const int r = j * EPG + e;
            if (r < 16) pn0[r] = __builtin_amdgcn_exp2f(pn0[r]); else pn1[r - 16] = __builtin_amdgcn_exp2f(pn1[r - 16]); }
        if (j > 0) {
#pragma unroll
            for (int e = 0; e < EPG; e += 2) { const int r = (j - 1) * EPG + e; pwn[(r >> 1) >> 2][(r >> 1) & 3] = cvt_pk(PVAL(r), PVAL(r + 1)); }
        }
        SB_;
    }
#pragma unroll
    for (int e = 0; e < EPG; e += 2) { const int r = (NPV - 1) * EPG + e; pwn[(r >> 1) >> 2][(r >> 1) & 3] = cvt_pk(PVAL(r), PVAL(r + 1)); }
#pragma unroll
    for (int k = 0; k < 4; ++k) pw[k] = pwn[k];
#undef PVAL
#undef KFRAG
#undef VFRAG
#undef SB_
}

template <int KW, int DQK, int DV, int MODE>
DI void attn_dense(LAS unsigned char* lds, const int tid, const bf16_t* Qw, int qpitch, const bf16_t* Kb, int kpitch, const bf16_t* Vb, int vpitch, int kco,
                   int qtok0, const LAS float* dtab, float nbound, int rot, f32x16 (&o)[DV / 32], float& l_out) {
    constexpr int KP = KW * 2 + 16, VP = DV * 2 + 64, KT = 64 * KP, VT = 64 * VP;
    constexpr int KCH = KW / 8, NKC = 64 * KCH, KPT = (NKC + 511) / 512, VCH = DV / 8, NVC = 64 * VCH, VPT = NVC / 512;
    const int lane = tid & 63, r32 = lane & 31, hi = lane >> 5;
    bf16x8 qf[DQK / 16];
#pragma unroll
    for (int d0 = 0; d0 < DQK / 16; ++d0) qf[d0] = *(const bf16x8*)(Qw + (size_t)r32 * qpitch + d0 * 16 + hi * 8);
    u32x4 kreg[KPT], vreg[VPT];
    unsigned kgo[KPT], klo[KPT], vgo[VPT], vlo[VPT];
#pragma unroll
    for (int i_ = 0; i_ < KPT; ++i_) { const int c_ = tid + i_ * 512; const int key_ = c_ / KCH, part_ = c_ % KCH; kgo[i_] = (unsigned)(key_ * kpitch + part_ * 8) * 2u; klo[i_] = (unsigned)(key_ * KP + part_ * 16); }
#pragma unroll
    for (int i_ = 0; i_ < VPT; ++i_) { const int c_ = tid + i_ * 512; const int key_ = c_ / VCH, part_ = c_ % VCH; vgo[i_] = (unsigned)(key_ * vpitch + part_ * 8) * 2u; vlo[i_] = (unsigned)(2 * KT + key_ * VP + part_ * 16); }
    const bool kact1 = (NKC % 512 == 0) || (tid + (KPT - 1) * 512 < NKC);
#define AD_TILE(t) (((t) + rot) & (S / 64 - 1))
#define AD_GLOAD_K(t) do { const char* kt_ = (const char*)Kb + (size_t)AD_TILE(t) * 64 * kpitch * 2; \
    _Pragma("unroll") for (int i_ = 0; i_ < KPT; ++i_) { if (MODE == 1) asm volatile("" : "+v"(kgo[i_])); if (i_ + 1 < KPT || kact1) kreg[i_] = *(const u32x4*)(kt_ + kgo[i_]); } } while (0)
#define AD_GLOAD_V(t) do { const char* vt_ = (const char*)Vb + (size_t)AD_TILE(t) * 64 * vpitch * 2; \
    _Pragma("unroll") for (int i_ = 0; i_ < VPT; ++i_) { if (MODE == 1) asm volatile("" : "+v"(vgo[i_])); vreg[i_] = *(const u32x4*)(vt_ + vgo[i_]); } } while (0)
#define AD_LSTORE_K(b) do { \
    _Pragma("unroll") for (int i_ = 0; i_ < KPT; ++i_) { if (i_ + 1 < KPT || kact1) *(LAS u32x4*)(lds + (b) * KT + klo[i_]) = kreg[i_]; } } while (0)
#define AD_LSTORE_V(b) do { \
    _Pragma("unroll") for (int i_ = 0; i_ < VPT; ++i_) *(LAS u32x4*)(lds + (b) * VT + vlo[i_]) = vreg[i_]; } while (0)
#define AD_CINIT(P0, P1, t) do { \
        if (MODE == 1) { \
            const int k0_ = AD_TILE(t) * 64, minrel_ = k0_ - (qtok0 + 31), maxrel_ = k0_ + 63 - qtok0; \
            if (minrel_ >= 559 || maxrel_ <= -559) { \
                const float c_ = (minrel_ >= 559 ? dtab[2046] : dtab[0]); \
                _Pragma("unroll") for (int r = 0; r < 16; ++r) { P0[r] = c_; P1[r] = c_; } \
            } else { \
                const LAS float* tp_ = dtab + (k0_ - qtok0 - r32 + 4 * hi + 1023); \
                _Pragma("unroll") for (int r = 0; r < 16; ++r) { P0[r] = tp_[(r & 3) + 8 * (r >> 2)]; P1[r] = tp_[32 + (r & 3) + 8 * (r >> 2)]; } \
            } \
        } else { \
            _Pragma("unroll") for (int r = 0; r < 16; ++r) { P0[r] = nbound; P1[r] = nbound; } \
        } } while (0)
    float l = 0.f;
#pragma unroll
    for (int d0 = 0; d0 < DV / 32; ++d0)
#pragma unroll
        for (int r = 0; r < 16; ++r) o[d0][r] = 0.f;
    constexpr int NT = S / 64;
    const int koff = r32 * KP + (kco + hi * 8) * 2;
    const int voff = 2 * KT + (4 * hi + ((lane & 15) >> 2)) * VP + (((lane >> 4) & 1) * 16 + (lane & 3) * 4) * 2;
    AD_GLOAD_K(0); AD_LSTORE_K(0);
    __syncthreads();
    AD_GLOAD_K(1); AD_GLOAD_V(0);
    u32x4 pw[4];
    { f32x16 pc0, pc1;
      AD_CINIT(pc0, pc1, 0);
      qk_tile<DQK, KP>(pc0, pc1, lds + koff, qf);
      exp_tile(pc0, pc1);
      pack_tile(pc0, pc1, pw); }
    AD_LSTORE_K(1); AD_LSTORE_V(0);
    __syncthreads();
    float ls[4] = {0.f, 0.f, 0.f, 0.f};
    f32x16 cvec;
#pragma unroll
    for (int r = 0; r < 16; ++r) cvec[r] = nbound;
    asm volatile("" : "+v"(cvec));
#define AD_STEP(CONSTC_, INIT_) do { \
        const int tn = (t + 1 < NT) ? t + 1 : NT - 1;         \
        AD_GLOAD_K(tn); \
        AD_GLOAD_V(t); \
        f32x16 pn0, pn1; \
        INIT_; \
        __builtin_amdgcn_sched_barrier(0); \
        tile_step<DQK, KP, DV, VP, CONSTC_, 4>(pw, pn0, pn1, cvec, ls, o, qf, lds + (t & 1) * KT + koff, lds + ((t - 1) & 1) * VT + voff); \
        AD_LSTORE_K((t + 1) & 1); \
        AD_LSTORE_V(t & 1); \
        __syncthreads(); } while (0)
    if (MODE == 1) {
        int t1 = (qtok0 - 622 >= 0) ? (qtok0 - 622) / 64 + 1 : 0; t1 = t1 < 1 ? 1 : (t1 > NT ? NT : t1);
        int t2 = (qtok0 + 590 + 63) / 64; t2 = t2 < t1 ? t1 : (t2 > NT ? NT : t2);
        int t = 1;
        { const float c_ = dtab[0];
#pragma unroll
          for (int r = 0; r < 16; ++r) cvec[r] = c_;
          asm volatile("" : "+v"(cvec)); }
        for (; t < t1; ++t) AD_STEP(true, (void)0);
        for (; t < t2; ++t) AD_STEP(false, AD_CINIT(pn0, pn1, t));
        { const float c_ = dtab[2046];
#pragma unroll
          for (int r = 0; r < 16; ++r) cvec[r] = c_;
          asm volatile("" : "+v"(cvec)); }
        for (; t < NT; ++t) AD_STEP(true, (void)0);
    } else {
        for (int t = 1; t < NT; ++t) AD_STEP(true, (void)0);
    }
#undef AD_STEP
    rowsum_pw(pw, ls);
    pv_tile<DV, VP>(o, pw, lds + ((NT - 1) & 1) * VT + voff);
    l = (ls[0] + ls[1]) + (ls[2] + ls[3]);
    __syncthreads();
#undef AD_GLOAD_K
#undef AD_TILE
#undef AD_GLOAD_V
#undef AD_LSTORE_K
#undef AD_LSTORE_V
#undef AD_CINIT
    l += shx(l, 32, lane);
    l_out = l;
}

template <int KW, int DQK, int DV>
DI void attn_dense_pair(LAS unsigned char* lds, const int tid, const bf16_t* Qw, int qpitch, const bf16_t* Kb, int kpitch, const bf16_t* Vb, int vpitch,
                        float nbound, f32x16 (&o)[DV / 32], float& l_out) {
    constexpr int KP = KW * 2 + 16, VP = DV * 2 + 64, KT = 64 * KP, VT = 64 * VP;
    constexpr int KCH = KW / 8, NKC = 64 * KCH, KPT = (NKC + 511) / 512, VCH = DV / 8, NVC = 64 * VCH, VPT = NVC / 512;
    const int lane = tid & 63, r32 = lane & 31, hi = lane >> 5;
    bf16x8 qf[DQK / 16];
#pragma unroll
    for (int d0 = 0; d0 < DQK / 16; ++d0) qf[d0] = *(const bf16x8*)(Qw + (size_t)r32 * qpitch + d0 * 16 + hi * 8);
    u32x4 kreg[2][KPT], vreg[2][VPT];
    unsigned kgo[KPT], klo[KPT], vgo[VPT], vlo[VPT];
#pragma unroll
    for (int i_ = 0; i_ < KPT; ++i_) { const int c_ = tid + i_ * 512; const int key_ = c_ / KCH, part_ = c_ % KCH; kgo[i_] = (unsigned)(key_ * kpitch + part_ * 8) * 2u; klo[i_] = (unsigned)(key_ * KP + part_ * 16); }
#pragma unroll
    for (int i_ = 0; i_ < VPT; ++i_) { const int c_ = tid + i_ * 512; const int key_ = c_ / VCH, part_ = c_ % VCH; vgo[i_] = (unsigned)(key_ * vpitch + part_ * 8) * 2u; vlo[i_] = (unsigned)(4 * KT + key_ * VP + part_ * 16); }
    const bool kact1 = (NKC % 512 == 0) || (tid + (KPT - 1) * 512 < NKC);
    constexpr int NT = S / 64;
#define AP_CL(t) ((t) < NT ? (t) : NT - 1)
#define AP_GLOAD_K(j, t) do { const char* kt_ = (const char*)Kb + (size_t)AP_CL(t) * 64 * kpitch * 2; \
    _Pragma("unroll") for (int i_ = 0; i_ < KPT; ++i_) { if (i_ + 1 < KPT || kact1) kreg[j][i_] = *(const u32x4*)(kt_ + kgo[i_]); } } while (0)
#define AP_GLOAD_V(j, t) do { const char* vt_ = (const char*)Vb + (size_t)AP_CL(t) * 64 * vpitch * 2; \
    _Pragma("unroll") for (int i_ = 0; i_ < VPT; ++i_) vreg[j][i_] = *(const u32x4*)(vt_ + vgo[i_]); } while (0)
#define AP_LSTORE_K(j, t) do { \
    _Pragma("unroll") for (int i_ = 0; i_ < KPT; ++i_) { if (i_ + 1 < KPT || kact1) *(LAS u32x4*)(lds + ((t) & 3) * KT + klo[i_]) = kreg[j][i_]; } } while (0)
#define AP_LSTORE_V(j, t) do { \
    _Pragma("unroll") for (int i_ = 0; i_ < VPT; ++i_) *(LAS u32x4*)(lds + ((t) & 3) * VT + vlo[i_]) = vreg[j][i_]; } while (0)
#pragma unroll
    for (int d0 = 0; d0 < DV / 32; ++d0)
#pragma unroll
        for (int r = 0; r < 16; ++r) o[d0][r] = 0.f;
    const int koff = r32 * KP + hi * 16;
    const int voff = 4 * KT + (4 * hi + ((lane & 15) >> 2)) * VP + (((lane >> 4) & 1) * 16 + (lane & 3) * 4) * 2;
    AP_GLOAD_K(0, 0); AP_LSTORE_K(0, 0);
    __syncthreads();
    AP_GLOAD_K(0, 1); AP_GLOAD_K(1, 2); AP_GLOAD_V(0, 0); AP_GLOAD_V(1, 1);
    u32x4 pw[4];
    { f32x16 pc0, pc1;
#pragma unroll
      for (int r = 0; r < 16; ++r) { pc0[r] = nbound; pc1[r] = nbound; }
      qk_tile<DQK, KP>(pc0, pc1, lds + koff, qf);
      exp_tile(pc0, pc1);
      pack_tile(pc0, pc1, pw); }
    AP_LSTORE_K(0, 1); AP_LSTORE_K(1, 2); AP_LSTORE_V(0, 0); AP_LSTORE_V(1, 1);
    __syncthreads();
    float ls[4] = {0.f, 0.f, 0.f, 0.f};
    f32x16 osum;
#pragma unroll
    for (int r = 0; r < 16; ++r) osum[r] = 0.f;
    bf16x8 onesf;
#pragma unroll
    for (int j = 0; j < 8; ++j) onesf[j] = (r32 == 0) ? (short)0x3f80 : (short)0;
    f32x16 cvec;
#pragma unroll
    for (int r = 0; r < 16; ++r) cvec[r] = nbound;
    asm volatile("" : "+v"(cvec));
    for (int t = 1; t + 1 < NT; t += 2) {
        AP_GLOAD_K(0, t + 2); AP_GLOAD_K(1, t + 3); AP_GLOAD_V(0, t + 1); AP_GLOAD_V(1, t + 2);
        f32x16 pn0, pn1;
        __builtin_amdgcn_sched_barrier(0);
        tile_step<DQK, KP, DV, VP, true, 4, true>(pw, pn0, pn1, cvec, ls, o, qf, lds + (t & 3) * KT + koff, lds + ((t - 1) & 3) * VT + voff, &osum, onesf);
        __builtin_amdgcn_sched_barrier(0);
        tile_step<DQK, KP, DV, VP, true, 4, true>(pw, pn0, pn1, cvec, ls, o, qf, lds + ((t + 1) & 3) * KT + koff, lds + (t & 3) * VT + voff, &osum, onesf);
        AP_LSTORE_K(0, t + 2); AP_LSTORE_K(1, t + 3); AP_LSTORE_V(0, t + 1); AP_LSTORE_V(1, t + 2);
        __syncthreads();
    }
    { f32x16 pn0, pn1;
      tile_step<DQK, KP, DV, VP, true, 4, true>(pw, pn0, pn1, cvec, ls, o, qf, lds + ((NT - 1) & 3) * KT + koff, lds + ((NT - 2) & 3) * VT + voff, &osum, onesf); }
    rowsum_pw(pw, ls);
    pv_tile<DV, VP>(o, pw, lds + ((NT - 1) & 3) * VT + voff);
    float l = (ls[0] + ls[1]) + (ls[2] + ls[3]);
    __syncthreads();
#undef AP_CL
#undef AP_GLOAD_K
#undef AP_GLOAD_V
#undef AP_LSTORE_K
#undef AP_LSTORE_V
    l += shx(l, 32, lane);
    l += __int_as_float(__builtin_amdgcn_ds_bpermute((lane & 31) << 2, __float_as_int(osum[0])));
    l_out = l;
}

DI float uni(float v) { return __int_as_float(__builtin_amdgcn_readfirstlane(__float_as_int(v))); }
DI float wave_absmax(const float* w, int n, int lane) {
    float m = 0.f;
    for (int i = lane; i < n; i += 64) m = fmaxf(m, fabsf(w[i]));
#pragma unroll
    for (int o = 1; o < 64; o <<= 1) m = fmaxf(m, shx(m, o, lane));
    return m;
}

DI void store_y64(const f32x16 (&o)[2], float linv, bf16_t* Y, const bf16_t* proj, int token, int ycol, int hi) {
#pragma unroll
    for (int d0 = 0; d0 < 2; ++d0)
#pragma unroll
        for (int g = 0; g < 4; ++g) {
            const int col = ycol + 32 * d0 + 8 * g + 4 * hi;
            const u32x2 gv = *(const u32x2*)(proj + (size_t)token * LDP + C_SILU + col);
            u32x2 w;
            w.x = cvt_pk(o[d0][4 * g + 0] * linv * bflo(gv.x), o[d0][4 * g + 1] * linv * bfhi(gv.x));
            w.y = cvt_pk(o[d0][4 * g + 2] * linv * bflo(gv.y), o[d0][4 * g + 3] * linv * bfhi(gv.y));
            *(u32x2*)(Y + (size_t)token * DM + col) = w;
        }
}

struct Params {
    const float* x; const float* norm_w; const float* w_in; const float* mla_q_norm; const float* mla_kv_norm; const float* mla_w_uq; const float* mla_w_ukv;
    const float* mla_qk_norm; const float* gqa_qk_norm; const float* dil_qk_norm; const float* diff_qk_norm; const float* diff_lambda; const float* diff_subnorm;
    const float* rel_bias; const float* w_branch; const float* w_out; float* out; unsigned char* ws;
};

DI float wave_sum(float v, int lane) {
#pragma unroll
    for (int o = 1; o < 64; o <<= 1) v += shx(v, o, lane);
    return v;
}
DI unsigned f2bf(float f) { unsigned u = __float_as_uint(f); return (u + 0x7fffu + ((u >> 16) & 1u)) >> 16; }
DI unsigned pk2(float lo, float hi) { return cvt_pk(lo, hi); }

DI void transpose_item(const float* W, int K, int N, bf16_t* WT, int ldk, const float* ksc, LAS float* scr, int item, int lane) {
    const int nblk = N / 32, kb = item / nblk, nb = item % nblk, k0 = 64 * kb, n0 = 32 * nb;
    { f32x4 v[8]; const int n4 = (lane & 7) * 4, kr = lane >> 3;
#pragma unroll
      for (int i = 0; i < 8; ++i) v[i] = *(const f32x4*)(W + (size_t)(k0 + 8 * i + kr) * N + n0 + n4);
#pragma unroll
      for (int i = 0; i < 8; ++i) { LAS float* d = scr + (8 * i + kr) * 33 + n4; d[0] = v[i].x; d[1] = v[i].y; d[2] = v[i].z; d[3] = v[i].w; } }
    const int c = lane & 7;
    f32x4 sc0 = (f32x4){1.f, 1.f, 1.f, 1.f}, sc1 = sc0;
    if (ksc) { sc0 = *(const f32x4*)(ksc + k0 + 8 * c); sc1 = *(const f32x4*)(ksc + k0 + 8 * c + 4); }
    asm volatile("s_waitcnt lgkmcnt(0)" ::: "memory");
#pragma unroll
    for (int j = 0; j < 4; ++j) { const int n = (lane >> 3) + 8 * j; const LAS float* s = scr + (8 * c) * 33 + n;
        u32x4 o; o.x = pk2(s[0 * 33] * sc0.x, s[1 * 33] * sc0.y); o.y = pk2(s[2 * 33] * sc0.z, s[3 * 33] * sc0.w); o.z = pk2(s[4 * 33] * sc1.x, s[5 * 33] * sc1.y); o.w = pk2(s[6 * 33] * sc1.z, s[7 * 33] * sc1.w);
        *(u32x4*)(WT + (size_t)(n0 + n) * ldk + k0 + 8 * c) = o; }
    asm volatile("s_waitcnt lgkmcnt(0)" ::: "memory");
}

DI void transpose_item_in(const float* W, bf16_t* WT, const float* ksc, LAS float* scr, int item, int lane) {
    constexpr int nblk = LDP / 32;
    const int kb = item / nblk, nb = item % nblk, k0 = 64 * kb, n0 = 32 * nb;
    { f32x4 v[8]; const int n4 = (lane & 7) * 4, kr = lane >> 3; const int sc = in_src_col(n0 + n4);
#pragma unroll
      for (int i = 0; i < 8; ++i) v[i] = sc >= 0 ? *(const f32x4*)(W + (size_t)(k0 + 8 * i + kr) * NIN + sc) : (f32x4){0.f, 0.f, 0.f, 0.f};
#pragma unroll
      for (int i = 0; i < 8; ++i) { LAS float* d = scr + (8 * i + kr) * 33 + n4; d[0] = v[i].x; d[1] = v[i].y; d[2] = v[i].z; d[3] = v[i].w; } }
    const int c = lane & 7;
    const f32x4 sc0 = *(const f32x4*)(ksc + k0 + 8 * c), sc1 = *(const f32x4*)(ksc + k0 + 8 * c + 4);
    asm volatile("s_waitcnt lgkmcnt(0)" ::: "memory");
#pragma unroll
    for (int j = 0; j < 4; ++j) { const int n = (lane >> 3) + 8 * j; const LAS float* s = scr + (8 * c) * 33 + n;
        u32x4 o; o.x = pk2(s[0 * 33] * sc0.x, s[1 * 33] * sc0.y); o.y = pk2(s[2 * 33] * sc0.z, s[3 * 33] * sc0.w); o.z = pk2(s[4 * 33] * sc1.x, s[5 * 33] * sc1.y); o.w = pk2(s[6 * 33] * sc1.z, s[7 * 33] * sc1.w);
        *(u32x4*)(WT + (size_t)(n0 + n) * DM + k0 + 8 * c) = o; }
    asm volatile("s_waitcnt lgkmcnt(0)" ::: "memory");
}

DI int rel_bucket(int rel) {
    const int side = rel > 0 ? 16 : 0; const int n = rel < 0 ? -rel : rel;
    const float nf = (float)(n > 1 ? n : 1);
    int large = 8 + (int)(logf(nf / 8.0f) / logf(128.0f) * 8.0f);
    large = large < 15 ? large : 15;
    return side + (n < 8 ? n : large);
}


#define XB_TMO      128
#define XB_XCNT(j)  (256  + 64 * (j))
#define XB_XSUB(j)  (1280 + 64 * (j))
#define XB_XGEN(j)  (2304 + 64 * (j))
#define XB_TOP      3328
#define XB_TOPGEN   3392
#define XCD_BAR_WORDS 3456
#define XB_SPIN_CAP (1u << 22)
DI unsigned xb_ld(unsigned* p)              { return __hip_atomic_load(p, __ATOMIC_RELAXED, __HIP_MEMORY_SCOPE_AGENT); }
DI unsigned xb_add(unsigned* p, unsigned v) { return __hip_atomic_fetch_add(p, v, __ATOMIC_RELAXED, __HIP_MEMORY_SCOPE_AGENT); }
DI unsigned xb_xcc_id() { return (unsigned)__builtin_amdgcn_s_getreg((3 << 11) | 20) & 0xFu; }
#define XB_SPIN(cond, bar) do { unsigned _sp = 0; while (cond) { __builtin_amdgcn_s_sleep(1); \
    if ((++_sp & 255u) == 0u) { if (xb_ld(&(bar)[XB_TMO])) break; if (_sp > XB_SPIN_CAP) { atomicAdd(&(bar)[XB_TMO], 1u); break; } } } } while (0)
DI void xcd_barrier_complete(unsigned* bar, unsigned x, unsigned& nloc, unsigned& nx) {
    const unsigned G = gridDim.x * gridDim.y * gridDim.z;
    unsigned sum, cnt, mine, sp = 0u;
    for (;;) {
        sum = 0u; cnt = 0u; mine = 0u;
#pragma unroll
        for (unsigned j = 0; j < 16; ++j) { const unsigned c = xb_ld(&bar[XB_XCNT(j)]); sum += c; cnt += (c > 0u) ? 1u : 0u; mine = (j == x) ? c : mine; }
        if (sum == G) break;
        __builtin_amdgcn_s_sleep(1);
        if ((++sp & 255u) == 0u) { if (xb_ld(&bar[XB_TMO])) break; if (sp > XB_SPIN_CAP) { atomicAdd(&bar[XB_TMO], 1u); break; } }
    }
    nloc = mine > 0u ? mine : 1u; nx = cnt > 0u ? cnt : 1u;
}
DI void xcd_barrier(unsigned* bar, volatile LAS unsigned* st, int wid0) {
    asm volatile("s_waitcnt vmcnt(0)" ::: "memory");
    __syncthreads();
    if (wid0 == 0 && __builtin_amdgcn_mbcnt_hi(~0u, __builtin_amdgcn_mbcnt_lo(~0u, 0u)) == 0u) {
        const unsigned x = xb_xcc_id();
        __builtin_amdgcn_s_waitcnt(0);
        unsigned nloc = st[0], nx = st[1];
        if (nloc == 0u) { xcd_barrier_complete(bar, x, nloc, nx); st[0] = nloc; st[1] = nx; }
        const unsigned old = xb_add(&bar[XB_XSUB(x)], 1u);
        const unsigned gen = old / nloc;
        if (old + 1u == (gen + 1u) * nloc) {
            __builtin_amdgcn_fence(__ATOMIC_RELEASE, "agent");
            asm volatile("s_waitcnt vmcnt(0)" ::: "memory");
            const unsigned og = xb_add(&bar[XB_TOP], 1u);
            const unsigned tg = og / nx;
            if (og + 1u == (tg + 1u) * nx) xb_add(&bar[XB_TOPGEN], 1u);
            else XB_SPIN(xb_ld(&bar[XB_TOPGEN]) == tg, bar);
            __builtin_amdgcn_fence(__ATOMIC_ACQUIRE, "agent");
            xb_add(&bar[XB_XGEN(x)], 1u);
            asm volatile("s_waitcnt vmcnt(0)" ::: "memory");
        } else {
            XB_SPIN(xb_ld(&bar[XB_XGEN(x)]) == gen, bar);
            __builtin_amdgcn_fence(__ATOMIC_ACQUIRE, "agent");
            asm volatile("s_waitcnt vmcnt(0)" ::: "memory");
        }
    }
    __syncthreads();
}

DI void xcd_arrive(unsigned* bar, volatile LAS unsigned* st, int wid0) {
    asm volatile("s_waitcnt vmcnt(0)" ::: "memory");
    __syncthreads();
    if (wid0 == 0 && __builtin_amdgcn_mbcnt_hi(~0u, __builtin_amdgcn_mbcnt_lo(~0u, 0u)) == 0u) {
        const unsigned x = xb_xcc_id();
        __builtin_amdgcn_s_waitcnt(0);
        const unsigned nloc = st[0], nx = st[1];
        const unsigned old = xb_add(&bar[XB_XSUB(x)], 1u);
        const unsigned gen = old / nloc;
        if (old + 1u == (gen + 1u) * nloc) {
            __builtin_amdgcn_fence(__ATOMIC_RELEASE, "agent");
            asm volatile("s_waitcnt vmcnt(0)" ::: "memory");
            const unsigned og = xb_add(&bar[XB_TOP], 1u);
            const unsigned tg = og / nx;
            if (og + 1u == (tg + 1u) * nx) xb_add(&bar[XB_TOPGEN], 1u);
        }
    }
}
DI void xcd_wait(unsigned* bar, unsigned target, int wid0) {
    if (wid0 == 0 && __builtin_amdgcn_mbcnt_hi(~0u, __builtin_amdgcn_mbcnt_lo(~0u, 0u)) == 0u) {
        XB_SPIN(xb_ld(&bar[XB_TOPGEN]) < target, bar);
        __builtin_amdgcn_fence(__ATOMIC_ACQUIRE, "agent");
        asm volatile("s_waitcnt vmcnt(0)" ::: "memory");
    }
    __syncthreads();
}

__global__ void __launch_bounds__(512) mega(Params P) {
    extern __shared__ __attribute__((aligned(16))) unsigned char lds_raw[];
    LAS unsigned char* lds = (LAS unsigned char*)lds_raw;
    cg::grid_group grid = cg::this_grid();
    volatile LAS unsigned* bst = (volatile LAS unsigned*)(lds + LDS_BYTES - 16);
    unsigned* barw = (unsigned*)(P.ws + WS_BAR);
    if (threadIdx.x == 0) { bst[0] = 0u; bst[1] = 0u; (void)xb_add(&barw[XB_XCNT(xb_xcc_id())], 1u); }
    __syncthreads();
#define GRID_SYNC() xcd_barrier(barw, bst, wid0)
#define XCD_ARRIVE() xcd_arrive(barw + XCD_BAR_WORDS, bst, wid0)
#define XCD_WAIT(g) xcd_wait(barw + XCD_BAR_WORDS, (unsigned)(g), wid0)
    const int wid0 = __builtin_amdgcn_readfirstlane((int)threadIdx.x >> 6);
#define RELANE(x) int x = (int)__builtin_amdgcn_mbcnt_hi(~0u, __builtin_amdgcn_mbcnt_lo(~0u, 0u)); asm volatile("" : "+v"(x));
#define PHASE_BEGIN \
    int wid = wid0; asm volatile("" : "+s"(wid)); \
    int lane = (int)__builtin_amdgcn_mbcnt_hi(~0u, __builtin_amdgcn_mbcnt_lo(~0u, 0u)); asm volatile("" : "+v"(lane)); \
    const int tid = wid * 64 + lane; \
    int bx = blockIdx.x; asm volatile("" : "+s"(bx)); \
    const int G = gridDim.x; \
    const int gw = bx * 8 + wid, NGW = G * 8, gt = bx * 512 + tid, NGT = G * 512; \
    const int vcu = (G % 8 == 0) ? (bx % 8) * (G / 8) + bx / 8 : bx; \
    size_t wsz_ = 0; asm volatile("" : "+s"(wsz_)); unsigned char* ws = P.ws + wsz_; \
    bf16_t* WinT = (bf16_t*)(ws + WS_WIN); bf16_t* WbT = (bf16_t*)(ws + WS_WB); bf16_t* WoT = (bf16_t*)(ws + WS_WO); \
    bf16_t* WuqT = (bf16_t*)(ws + WS_WUQ); bf16_t* WukvT = (bf16_t*)(ws + WS_WUKV); \
    float* cosT = (float*)(ws + WS_COS); float* sinT = (float*)(ws + WS_SIN); float* dtabG = (float*)(ws + WS_DTAB); float* ctabG = (float*)(ws + WS_CTAB); \
    bf16_t* Hb = (bf16_t*)(ws + WS_H); bf16_t* proj = (bf16_t*)(ws + WS_PROJ); bf16_t* qup = (bf16_t*)(ws + WS_QUP); bf16_t* kvup = (bf16_t*)(ws + WS_KVUP); \
    bf16_t* Qa = (bf16_t*)(ws + WS_QA); bf16_t* Ka = (bf16_t*)(ws + WS_KA); bf16_t* Va = (bf16_t*)(ws + WS_VA); \
    bf16_t* Qb = (bf16_t*)(ws + WS_QB); bf16_t* Kb = (bf16_t*)(ws + WS_KB); bf16_t* Qc = (bf16_t*)(ws + WS_QC); bf16_t* Kc = (bf16_t*)(ws + WS_KC); \
    bf16_t* Qd = (bf16_t*)(ws + WS_QD); bf16_t* Kd = (bf16_t*)(ws + WS_KD); bf16_t* Yb = (bf16_t*)(ws + WS_Y); \
    float* mixF = (float*)(ws + WS_MIXF); bf16_t* mixB = (bf16_t*)(ws + WS_MIXB); \
    (void)lane; (void)gw; (void)NGW; (void)gt; (void)NGT; (void)vcu; (void)WinT; (void)WbT; (void)WoT; (void)WuqT; (void)WukvT; (void)cosT; (void)sinT; (void)dtabG; (void)ctabG; \
    (void)Hb; (void)proj; (void)qup; (void)kvup; (void)Qa; (void)Ka; (void)Va; (void)Qb; (void)Kb; (void)Qc; (void)Kc; (void)Qd; (void)Kd; (void)Yb; (void)mixF; (void)mixB;

        for (int rep_ = 0; rep_ < ((REP_MASK >> 0) & 1) + 1; ++rep_) {
    {
        PHASE_BEGIN
        LAS float* scr = (LAS float*)(lds + wid * 16384);
        constexpr int I_IN = (DM / 64) * (LDP / 32), I_BR = (512 / 64) * (DM / 32), I_O = (DM / 64) * (DM / 32), I_UQ = (384 / 64) * (768 / 32), I_UKV = (128 / 64) * (1024 / 32);
        constexpr int PER_L = I_IN + 4 * I_BR + I_O + I_UQ + I_UKV;
        for (int it = gw; it < DEPTH * PER_L; it += NGW) {
            const int l = it / PER_L; int r = it % PER_L;
            if (r < I_IN) { transpose_item_in(P.w_in + (size_t)l * DM * NIN, WinT + (size_t)l * LDP * DM, P.norm_w + l * DM, scr, r, lane); continue; } r -= I_IN;
            if (r < 4 * I_BR) { const int n = r / I_BR; transpose_item(P.w_branch + ((size_t)l * 4 + n) * 512 * DM, 512, DM, WbT + (size_t)l * DM * DM + n * 512, DM, nullptr, scr, r % I_BR, lane); continue; } r -= 4 * I_BR;
            if (r < I_O) { transpose_item(P.w_out + (size_t)l * DM * DM, DM, DM, WoT + (size_t)l * DM * DM, DM, nullptr, scr, r, lane); continue; } r -= I_O;
            if (r < I_UQ) { transpose_item(P.mla_w_uq + (size_t)l * 384 * 768, 384, 768, WuqT + (size_t)l * 768 * 384, 384, P.mla_q_norm + l * 384, scr, r, lane); continue; } r -= I_UQ;
            transpose_item(P.mla_w_ukv + (size_t)l * 128 * 1024, 128, 1024, WukvT + (size_t)l * 1024 * 256, 256, P.mla_kv_norm + l * 128, scr, r, lane);
        }
        for (int i = gt; i < DEPTH * 1024 * 16; i += NGT) { const int row = i / 16, c = i % 16;
            *(u32x4*)(WukvT + (size_t)row * 256 + 128 + c * 8) = (u32x4){0u, 0u, 0u, 0u}; }
        { float* ssq = (float*)(ws + WS_SSQ);
          for (int i = gt; i < 4 * S; i += NGT) ssq[S + i] = 0.f;
          for (int row = gw; row < S; row += NGW) {
              const f32x4* xr = (const f32x4*)(P.x + (size_t)row * DM) + lane;
              u32x2* o8 = (u32x2*)(Hb + (size_t)row * DM) + lane; float ss = 0.f;
#pragma unroll
              for (int j = 0; j < 8; ++j) { const f32x4 v = xr[64 * j]; ss += (v.x * v.x + v.y * v.y) + (v.z * v.z + v.w * v.w);
                  u32x2 o; o.x = cvt_pk(v.x, v.y); o.y = cvt_pk(v.z, v.w); o8[64 * j] = o; }
              ss = wave_sum(ss, lane);
              if (lane == 0) ssq[row] = ss;
          } }
        for (int i = gt; i < S * 16; i += NGT) { const int pos = i >> 4, fi = i & 15;
            const float inv = powf(10000.0f, -(float)(2 * fi) / 32.0f);
            const float ang = (float)pos * inv;
            const double rev = (double)ang * 0.15915494309189535; const float fr = (float)(rev - rint(rev));
            cosT[i] = __builtin_amdgcn_cosf(fr); sinT[i] = __builtin_amdgcn_sinf(fr); }
        for (int i = gt; i < 4 * 2048; i += NGT) { const int h = i >> 11, k = i & 2047; const int rel = k - 1023;
            dtabG[i] = (k < 2047) ? P.rel_bias[rel_bucket(rel) * 28 + 24 + h] * LOG2E : 0.f; }
        for (int i = gt; i < 24 * 132; i += NGT) { const int gh = i / 132, j = i % 132; const int g = gh >> 3; const int dil = 1 << (2 * g);
            ctabG[i] = (j < 129) ? P.rel_bias[rel_bucket((j - 64) * dil) * 28 + gh] * LOG2E : 0.f; }
    }
    grid.sync();
        }

    for (int l = 0; l < DEPTH; ++l) {
        for (int rep_ = 0; rep_ < ((REP_MASK >> 2) & 1) + 1; ++rep_) {
        {
            PHASE_BEGIN
            pg8::SchedGrid sc{(const char*)Hb, (const char*)(WinT + (size_t)l * LDP * DM), S / 256, LDP / 256, G, bx, (size_t)256 * DM * 2, (size_t)256 * DM * 2};
            pg8::EpiProj ep{proj, (const float*)(ws + WS_SSQ) + (size_t)l * S, P.gqa_qk_norm + l * 128, P.dil_qk_norm + l * 384, P.diff_qk_norm + l * 128, cosT, sinT, Qb, Kb, Qc, Kc, Qd, Kd};
            pg8::gemm_phase(lds, tid, DM, DM, DM, sc, ep);
        }
        GRID_SYNC();
        }
        {
            PHASE_BEGIN
            { pg8::SchedGrid sc{(const char*)(proj + C_ACQ), (const char*)(WuqT + (size_t)l * 768 * 384), S / 256, 3, G, bx, (size_t)256 * LDP * 2, (size_t)256 * 384 * 2};
              pg8::EpiBf16 ep{qup, 768}; pg8::gemm_phase(lds, tid, 384, LDP, 384, sc, ep); }
            { pg8::SchedGrid sc{(const char*)(proj + C_ACKV), (const char*)(WukvT + (size_t)l * 1024 * 256), S / 256, 4, G, (bx + 128) % G, (size_t)256 * LDP * 2, (size_t)256 * 256 * 2};
              pg8::EpiBf16 ep{kvup, 1024}; pg8::gemm_phase(lds, tid, 256, LDP, 256, sc, ep); }
        }
        XCD_ARRIVE();
        {
            for (int rb_ = 0; rb_ < ((REP_MASK >> 9) & 1) + 1; ++rb_)
            { PHASE_BEGIN
            const float nbound = uni(-(64.0f * 0.125f * LOG2E * 1.02f) * wave_absmax(P.gqa_qk_norm + (l * 2 + 0) * 64, 64, lane) * wave_absmax(P.gqa_qk_norm + (l * 2 + 1) * 64, 64, lane));
            for (int u = vcu; u < 256; u += G) {
                const int h = u >> 5, qb = u & 31, q0 = qb * 256 + wid * 32, kv = h >> 2;
                f32x16 o[2]; float lsum;
                attn_dense_pair<64, 64, 64>(lds, tid, Qb + ((size_t)h * S + q0) * 64, 64, Kb + (size_t)kv * S * 64, 64, proj + C_BV + kv * 64, LDP, nbound, o, lsum);
                { RELANE(l2) int u2 = u; asm volatile("" : "+s"(u2)); const int h2 = u2 >> 5, q02 = (u2 & 31) * 256 + wid * 32;
                  store_y64(o, 1.0f / lsum, Yb, proj, q02 + (l2 & 31), 512 + h2 * 64, l2 >> 5); }
            } }
        }
        XCD_WAIT(2 * l + 1);
        {
            PHASE_BEGIN
            const float scl = 0.10206207261596575f * LOG2E;
            for (int it2 = gt; it2 < S * 16; it2 += NGT) {
              if (it2 < S * 8) {
                const int it = it2;
                const int t = it >> 3, h = it & 7;
                size_t wz_ = 0; asm volatile("" : "+s"(wz_)); const float* wq = P.mla_qk_norm + (l * 2 + 0) * 96 + wz_;
                const bf16_t* src = qup + (size_t)t * 768 + h * 96;
                u32x4 rc[6], rq[12];
#pragma unroll
                for (int i = 0; i < 6; ++i) rc[i] = *(const u32x4*)(proj + (size_t)t * LDP + C_ACQ + h * 48 + i * 8);
#pragma unroll
                for (int i = 0; i < 12; ++i) rq[i] = *(const u32x4*)(src + i * 8);
                float cs = 0.f;
#pragma unroll
                for (int i = 0; i < 6; ++i) { float c8[8]; unpack8(rc[i], c8);
#pragma unroll
                    for (int j = 0; j < 8; ++j) cs += c8[j] * c8[j]; }
                cs += shx(cs, 1, lane); cs += shx(cs, 2, lane); cs += shx(cs, 4, lane);
                const float rstd = rsqrtf(cs * (1.0f / 384.0f) + EPS);
                float ss = 0.f;
#pragma unroll
                for (int i = 0; i < 12; ++i) { float c8[8]; unpack8(rq[i], c8);
#pragma unroll
                    for (int j = 0; j < 8; ++j) { const float v = c8[j] * rstd; ss += v * v; } }
                const float rn = rsqrtf(ss * (1.0f / 96.0f) + EPS) * rstd;
                bf16_t* dst = Qa + ((size_t)h * S + t) * 96;
#pragma unroll
                for (int i = 0; i < 8; ++i) { float c8[8]; unpack8(rq[i], c8);
#pragma unroll
                    for (int j = 0; j < 8; ++j) c8[j] *= rn * wq[i * 8 + j] * scl;
                    *(u32x4*)(dst + 8 * i) = pack8(c8); }
#pragma unroll
                for (int i = 0; i < 2; ++i) { float a8[8], b8[8]; unpack8(rq[8 + i], a8); unpack8(rq[10 + i], b8);
#pragma unroll
                    for (int j = 0; j < 8; ++j) { const float a = a8[j] * rn * wq[64 + i * 8 + j], b = b8[j] * rn * wq[80 + i * 8 + j];
                        const float c = cosT[t * 16 + i * 8 + j], sn = sinT[t * 16 + i * 8 + j];
                        a8[j] = (a * c - b * sn) * scl; b8[j] = (a * sn + b * c) * scl; }
                    *(u32x4*)(dst + 64 + 8 * i) = pack8(a8); *(u32x4*)(dst + 80 + 8 * i) = pack8(b8); }
              } else {
                const int it = it2 - S * 8;
                const int t = it >> 3, h = it & 7;
                size_t wz_ = 0; asm volatile("" : "+s"(wz_)); const float* wk = P.mla_qk_norm + (l * 2 + 1) * 96 + wz_;
                const bf16_t* src = kvup + (size_t)t * 1024 + h * 128;
                const bf16_t* srcr = proj + (size_t)t * LDP + C_AKR;
                u32x4 rc[2], rk[8], rr[4], rv[8];
#pragma unroll
                for (int i = 0; i < 2; ++i) rc[i] = *(const u32x4*)(proj + (size_t)t * LDP + C_ACKV + h * 16 + i * 8);
#pragma unroll
                for (int i = 0; i < 8; ++i) { rk[i] = *(const u32x4*)(src + i * 8); rv[i] = *(const u32x4*)(src + 64 + i * 8); }
#pragma unroll
                for (int i = 0; i < 4; ++i) rr[i] = *(const u32x4*)(srcr + i * 8);
                float cs = 0.f;
#pragma unroll
                for (int i = 0; i < 2; ++i) { float c8[8]; unpack8(rc[i], c8);
#pragma unroll
                    for (int j = 0; j < 8; ++j) cs += c8[j] * c8[j]; }
                cs += shx(cs, 1, lane); cs += shx(cs, 2, lane); cs += shx(cs, 4, lane);
                const float rstd = rsqrtf(cs * (1.0f / 128.0f) + EPS);
                float ss = 0.f;
#pragma unroll
                for (int i = 0; i < 8; ++i) { float c8[8]; unpack8(rk[i], c8);
#pragma unroll
                    for (int j = 0; j < 8; ++j) { const float v = c8[j] * rstd; ss += v * v; } }
#pragma unroll
                for (int i = 0; i < 4; ++i) { float c8[8]; unpack8(rr[i], c8);
#pragma unroll
                    for (int j = 0; j < 8; ++j) ss += c8[j] * c8[j]; }
                const float rn = rsqrtf(ss * (1.0f / 96.0f) + EPS);
                bf16_t* dst = Ka + ((size_t)h * S + t) * 96;
#pragma unroll
                for (int i = 0; i < 8; ++i) { float c8[8]; unpack8(rk[i], c8);
#pragma unroll
                    for (int j = 0; j < 8; ++j) c8[j] *= rstd * rn * wk[i * 8 + j];
                    *(u32x4*)(dst + 8 * i) = pack8(c8); }
#pragma unroll
                for (int i = 0; i < 2; ++i) { float a8[8], b8[8]; unpack8(rr[i], a8); unpack8(rr[2 + i], b8);
#pragma unroll
                    for (int j = 0; j < 8; ++j) { const float a = a8[j] * rn * wk[64 + i * 8 + j], b = b8[j] * rn * wk[80 + i * 8 + j];
                        const float c = cosT[t * 16 + i * 8 + j], sn = sinT[t * 16 + i * 8 + j];
                        a8[j] = a * c - b * sn; b8[j] = a * sn + b * c; }
                    *(u32x4*)(dst + 64 + 8 * i) = pack8(a8); *(u32x4*)(dst + 80 + 8 * i) = pack8(b8); }
                bf16_t* dv = Va + ((size_t)h * S + t) * 64;
#pragma unroll
                for (int i = 0; i < 8; ++i) { float c8[8]; unpack8(rv[i], c8);
#pragma unroll
                    for (int j = 0; j < 8; ++j) c8[j] *= rstd;
                    *(u32x4*)(dv + 8 * i) = pack8(c8); }
              }
            }
        }
        XCD_ARRIVE();
        {
            for (int rd_ = 0; rd_ < ((REP_MASK >> 10) & 1) + 1; ++rd_)
            {
                PHASE_BEGIN
                float maxb = 0.f;
                for (int i = lane; i < 32 * 28; i += 64) maxb = fmaxf(maxb, fabsf(P.rel_bias[i]));
#pragma unroll
                for (int o_ = 1; o_ < 64; o_ <<= 1) maxb = fmaxf(maxb, shx(maxb, o_, lane));
                const float nbound = uni(-((64.0f * 0.125f * LOG2E * 1.02f) * wave_absmax(P.diff_qk_norm + (l * 2 + 0) * 64, 64, lane) * wave_absmax(P.diff_qk_norm + (l * 2 + 1) * 64, 64, lane) + maxb * LOG2E));
                constexpr int DBUF = 2 * (64 * (128 * 2 + 16) + 64 * (128 * 2 + 64));
                LAS float* dtab = (LAS float*)(lds + DBUF);
                LAS float* xch = (LAS float*)lds;
                for (int u = vcu; u < 256; u += G) {
                    const int h = u >> 6, qb = u & 63, map = wid >> 2, q0 = qb * 128 + (wid & 3) * 32;
                    for (int i = tid; i < 2048; i += 512) dtab[i] = dtabG[h * 2048 + i] + nbound;
                    __syncthreads();
                    f32x16 o[4]; float lsum;
                    attn_dense<128, 64, 128, 1>(lds, tid, Qd + ((size_t)h * S + q0) * 128 + map * 64, 128, Kd + (size_t)h * S * 128, 128, proj + C_DV + h * 128, LDP, map * 64, q0, dtab, nbound, 0, o, lsum);
                    const float linv = 1.0f / lsum;
                    RELANE(l2) int u2 = u; asm volatile("" : "+s"(u2));
                    const int h2 = u2 >> 6, q02 = (u2 & 63) * 128 + (wid & 3) * 32, hi2 = l2 >> 5;
                    if (map == 1) {
#pragma unroll
                        for (int d0 = 0; d0 < 4; ++d0)
#pragma unroll
                            for (int r = 0; r < 16; ++r) xch[(d0 * 16 + r) * 256 + (wid & 3) * 64 + l2] = o[d0][r] * linv;
                    }
                    __syncthreads();
                    if (map == 0) {
                        const float* lv = P.diff_lambda + l * 256;
                        const float d01 = wave_sum(lv[l2] * lv[64 + l2], l2), d23 = wave_sum(lv[128 + l2] * lv[192 + l2], l2);
                        const float lambda_init = 0.8f - 0.6f * expf(-0.3f * (float)l);
                        const float lam = expf(d01) - expf(d23) + lambda_init;
                        float ss = 0.f;
#pragma unroll
                        for (int d0 = 0; d0 < 4; ++d0)
#pragma unroll
                            for (int r = 0; r < 16; ++r) { const float v = o[d0][r] * linv - lam * xch[(d0 * 16 + r) * 256 + wid * 64 + l2]; o[d0][r] = v; ss += v * v; }
                        ss += shx(ss, 32, l2);
                        const float rn = rsqrtf(ss * (1.0f / 128.0f) + EPS) * (1.0f - lambda_init);
                        const int token = q02 + (l2 & 31); const float* sw = P.diff_subnorm + l * 128;
#pragma unroll
                        for (int d0 = 0; d0 < 4; ++d0) {
#pragma unroll
                            for (int g = 0; g < 4; ++g) {
                                const int dv = 32 * d0 + 8 * g + 4 * hi2, col = 1536 + h2 * 128 + dv;
                                const u32x2 gv = *(const u32x2*)(proj + (size_t)token * LDP + C_SILU + col);
                                const f32x4 w = *(const f32x4*)(sw + dv);
                                u32x2 ov;
                                ov.x = cvt_pk(o[d0][4 * g + 0] * rn * w.x * bflo(gv.x), o[d0][4 * g + 1] * rn * w.y * bfhi(gv.x));
                                ov.y = cvt_pk(o[d0][4 * g + 2] * rn * w.z * bflo(gv.y), o[d0][4 * g + 3] * rn * w.w * bfhi(gv.y));
                                *(u32x2*)(Yb + (size_t)token * DM + col) = ov;
                            }
                            asm volatile("" ::: "memory");
                        }
                    }
                    __syncthreads();
                }
            }
            for (int rc_ = 0; rc_ < ((REP_MASK >> 11) & 1) + 1; ++rc_)
            {
                PHASE_BEGIN const int r32 = lane & 31, hi = lane >> 5;
                float nbound;
                { RELANE(l6)
                  float maxb = 0.f;
                  for (int i = l6; i < 32 * 28; i += 64) maxb = fmaxf(maxb, fabsf(P.rel_bias[i]));
#pragma unroll
                  for (int o_ = 1; o_ < 64; o_ <<= 1) maxb = fmaxf(maxb, shx(maxb, o_, l6));
                  float wmax = 0.f;
                  for (int g_ = 0; g_ < 3; ++g_) wmax = fmaxf(wmax, wave_absmax(P.dil_qk_norm + ((l * 2 + 0) * 3 + g_) * 64, 64, l6) * wave_absmax(P.dil_qk_norm + ((l * 2 + 1) * 3 + g_) * 64, 64, l6));
                  nbound = uni(-((64.0f * 0.125f * LOG2E * 1.02f) * wmax + maxb * LOG2E)); }
                constexpr int CKP = 144, CVP = 144, CKT = 64 * CKP, CWB = CKT + 64 * CVP;
                constexpr int CR0 = 576, CR1 = 192, CR2 = 128, CT1 = 2 * CR0 + 1, CT2 = CT1 + 2 * CR1 + 1, CTN = CT2 + 2 * CR2 + 1;
                LAS float* ctab = (LAS float*)(lds + 8 * CWB);
                LAS unsigned char* wl = lds + wid * CWB;
                for (int u = vcu; u < 256; u += G) {
                    const int h = u >> 5, bb = (u >> 1) & 15, rh = u & 1, r16 = rh * 8 + wid, i0 = bb * 32;
                    __syncthreads();
                    RELANE(l5)
                    for (int i = wid * 64 + l5; i < CTN; i += 512) { const int g_ = i < CT1 ? 0 : (i < CT2 ? 1 : 2); const int rel = i - (g_ == 0 ? CR0 : (g_ == 1 ? CT1 + CR1 : CT2 + CR2));
                        ctab[i] = (rel >= -64 && rel <= 64) ? ctabG[(g_ * 8 + h) * 132 + rel + 64] + nbound : -INFINITY; }
                    __syncthreads();
                    float lsum = 0.f; f32x16 o[2];
#pragma unroll
                    for (int d0 = 0; d0 < 2; ++d0)
#pragma unroll
                        for (int r = 0; r < 16; ++r) o[d0][r] = 0.f;
                    bf16x8 qf[4]; u32x4 kreg[8], vreg[8];
                    float ls[4] = {0.f, 0.f, 0.f, 0.f};
                    const int koff = r32 * CKP + hi * 16;
                    const int voff = CKT + (4 * hi + ((lane & 15) >> 2)) * CVP + (((lane >> 4) & 1) * 16 + (lane & 3) * 4) * 2;
#define C_DECODE(T, g_, tt_) const int g_ = (T) < 10 ? 0 : ((T) < 14 ? 1 : 2); const int tt_ = (T) - (g_ == 0 ? 0 : (g_ == 1 ? 10 : 14));
#define C_GLOAD(T) do { C_DECODE(T, g__, tt__) const int sh__ = 2 * g__, e__ = 16 >> sh__, rc__ = r16 & ((1 << sh__) - 1), L__ = S >> sh__; const int kb__ = e__ * i0 - 64 + 64 * tt__; \
        const char* kg__ = (const char*)(Kc + (size_t)(g__ * 8 + h) * S * 64); const char* vg__ = (const char*)(proj + C_CV + (g__ * 8 + h) * 64); \
        if (kb__ >= 0 && kb__ + 64 <= L__) {        \
            const size_t tok0__ = (size_t)((kb__ << sh__) + rc__); const char* kt__ = kg__ + tok0__ * 128; const char* vt__ = vg__ + tok0__ * (LDP * 2); \
            _Pragma("unroll") for (int i_ = 0; i_ < 8; ++i_) { const unsigned dk_ = (unsigned)((key0 + 8 * i_) << sh__); \
                kreg[i_] = *(const u32x4*)(kt__ + dk_ * 128u + part16); vreg[i_] = *(const u32x4*)(vt__ + dk_ * (unsigned)(LDP * 2) + part16); } \
        } else { \
            _Pragma("unroll") for (int i_ = 0; i_ < 8; ++i_) { int ks_ = kb__ + key0 + 8 * i_; ks_ = ks_ < 0 ? 0 : ks_; ks_ = ks_ > L__ - 1 ? L__ - 1 : ks_; \
                const size_t tok_ = (size_t)((ks_ << sh__) + rc__); kreg[i_] = *(const u32x4*)(kg__ + tok_ * 128 + part16); vreg[i_] = *(const u32x4*)(vg__ + tok_ * (LDP * 2) + part16); } \
        } } while (0)
                    {
                        RELANE(l4) const int tid4 = wid * 64 + l4, r32g = l4 & 31, hig = l4 >> 5;
                        const int koffg = r32g * CKP + hig * 16;
                        const int voffg = CKT + (4 * hig + ((l4 & 15) >> 2)) * CVP + (((l4 >> 4) & 1) * 16 + (l4 & 3) * 4) * 2;
                        const int h0 = h;
                        const char* kg0 = (const char*)(Kc + (size_t)(0 * 8 + h0) * S * 64); const char* vg0 = (const char*)(proj + C_CV + (0 * 8 + h0) * 64);
                        const int skey = tid4 >> 3, spart16 = (tid4 & 7) * 16;
                        u32x4 kr0, vr0;
                        const bf16_t* qg = Qc + ((size_t)(0 * 8 + h0) * S + 16 * i0 + r16) * 64;
#pragma unroll
                        for (int d0 = 0; d0 < 4; ++d0) qf[d0] = *(const bf16x8*)(qg + (size_t)r32g * 1024 + d0 * 16 + hig * 8);
#define C0_GLOAD(tt_) do { int ks_ = 16 * i0 - 64 + 64 * (tt_) + skey; ks_ = ks_ < 0 ? 0 : ks_; ks_ = ks_ > S - 1 ? S - 1 : ks_; \
        kr0 = *(const u32x4*)(kg0 + (size_t)ks_ * 128 + spart16); vr0 = *(const u32x4*)(vg0 + (size_t)ks_ * (LDP * 2) + spart16); } while (0)
#define C0_LSTORE(b_) do { *(LAS u32x4*)(lds + (b_) * CWB + skey * CKP + spart16) = kr0; *(LAS u32x4*)(lds + (b_) * CWB + CKT + skey * CVP + spart16) = vr0; } while (0)
#define C0_GLOAD_K(tt_) do { int ks_ = 16 * i0 - 64 + 64 * (tt_) + skey; ks_ = ks_ < 0 ? 0 : ks_; ks_ = ks_ > S - 1 ? S - 1 : ks_; kr0 = *(const u32x4*)(kg0 + (size_t)ks_ * 128 + spart16); } while (0)
#define C0_GLOAD_V(tt_) do { int ks_ = 16 * i0 - 64 + 64 * (tt_) + skey; ks_ = ks_ < 0 ? 0 : ks_; ks_ = ks_ > S - 1 ? S - 1 : ks_; vr0 = *(const u32x4*)(vg0 + (size_t)ks_ * (LDP * 2) + spart16); } while (0)
#define C0_LSTORE_K(b_) do { *(LAS u32x4*)(lds + (b_) * CWB + skey * CKP + spart16) = kr0; } while (0)
#define C0_LSTORE_V(b_) do { *(LAS u32x4*)(lds + (b_) * CWB + CKT + skey * CVP + spart16) = vr0; } while (0)
#define C0_CINIT(P0, P1, tt_) do { const int kb_ = 16 * i0 - 64 + 64 * (tt_); const LAS float* tp_ = ctab + CR0 + (kb_ + 4 * hig - subq); \
        _Pragma("unroll") for (int r = 0; r < 16; ++r) { P0[r] = tp_[(r & 3) + 8 * (r >> 2)]; P1[r] = tp_[32 + (r & 3) + 8 * (r >> 2)]; } \
        if (kb_ < 0 || kb_ + 64 > S) { \
            _Pragma("unroll") for (int r = 0; r < 16; ++r) { const int ks0_ = kb_ + 4 * hig + (r & 3) + 8 * (r >> 2); \
                if ((unsigned)ks0_ >= (unsigned)S) P0[r] = -INFINITY; \
                if ((unsigned)(ks0_ + 32) >= (unsigned)S) P1[r] = -INFINITY; } } } while (0)
                        const int subq = 16 * (i0 + r32g) + r16;
                        C0_GLOAD_K(0); C0_LSTORE_K(0);
                        __syncthreads();
                        C0_GLOAD_K(1); C0_GLOAD_V(0);
                        u32x4 pw0_[4];
                        { f32x16 pc0, pc1; C0_CINIT(pc0, pc1, 0);
                          qk_tile<64, CKP>(pc0, pc1, lds + koffg, qf); exp_tile(pc0, pc1); pack_tile(pc0, pc1, pw0_); }
                        C0_LSTORE_K(1); C0_LSTORE_V(0);
                        __syncthreads();
                        f32x16 cdummy;
#pragma unroll
                        for (int r = 0; r < 16; ++r) cdummy[r] = 0.f;
                        for (int tt = 1; tt < 10; ++tt) {
                            C0_GLOAD_K(tt + 1 < 10 ? tt + 1 : 9); C0_GLOAD_V(tt);
                            f32x16 pn0, pn1; C0_CINIT(pn0, pn1, tt);
                            __builtin_amdgcn_sched_barrier(0);
                            tile_step<64, CKP, 64, CVP, false>(pw0_, pn0, pn1, cdummy, ls, o, qf, lds + (tt & 1) * CWB + koffg, lds + ((tt - 1) & 1) * CWB + voffg);
                            C0_LSTORE_K((tt + 1) & 1); C0_LSTORE_V(tt & 1);
                            __syncthreads();
                        }
                        rowsum_pw(pw0_, ls);
                        pv_tile<64, CVP>(o, pw0_, lds + (9 & 1) * CWB + voffg);
                        __syncthreads();
#undef C0_GLOAD_K
#undef C0_GLOAD_V
#undef C0_LSTORE_K
#undef C0_LSTORE_V
#undef C0_CINIT
#undef C0_GLOAD
#undef C0_LSTORE
                    }
                    RELANE(l3) const int key0 = l3 >> 3, part16 = (l3 & 7) * 16;
                    size_t z3_ = 0; asm volatile("" : "+s"(z3_)); const bf16_t* Kc_ = Kc + z3_; const bf16_t* Qc_ = Qc + z3_; const bf16_t* proj_ = proj + z3_;
                    int u3_ = u; asm volatile("" : "+s"(u3_));
                    const int h_ = u3_ >> 5, i0_w = ((u3_ >> 1) & 15) * 32, r16_ = (u3_ & 1) * 8 + wid, r32_ = l3 & 31, hi_ = l3 >> 5;
                    const int koff_ = r32_ * CKP + hi_ * 16;
                    const int voff_ = CKT + (4 * hi_ + ((l3 & 15) >> 2)) * CVP + (((l3 >> 4) & 1) * 16 + (l3 & 3) * 4) * 2;
#define Kc Kc_
#define Qc Qc_
#define proj proj_
#define h h_
#define i0 i0_w
#define r16 r16_
#define r32 r32_
#define hi hi_
#define koff koff_
#define voff voff_
                    C_GLOAD(10);
                    for (int T = 10; T < 17; ++T) {
                        C_DECODE(T, g, tt)
                        const int sh = 2 * g, e = 16 >> sh, L = S >> sh;
                        if (tt == 0) {
                            const bf16_t* qg = Qc + ((size_t)(g * 8 + h) * S + 16 * i0 + r16) * 64;
#pragma unroll
                            for (int d0 = 0; d0 < 4; ++d0) qf[d0] = *(const bf16x8*)(qg + (size_t)r32 * 1024 + d0 * 16 + hi * 8);
                        }
#pragma unroll
                        for (int i_ = 0; i_ < 8; ++i_) { *(LAS u32x4*)(wl + (key0 + 8 * i_) * CKP + part16) = kreg[i_]; *(LAS u32x4*)(wl + CKT + (key0 + 8 * i_) * CVP + part16) = vreg[i_]; }
                        if (T + 1 < 17) C_GLOAD(T + 1);
                        const int kb = e * i0 - 64 + 64 * tt;
                        const int subq = e * (i0 + r32) + (r16 >> sh);
                        const LAS float* tp = ctab + (g == 0 ? CR0 : (g == 1 ? CT1 + CR1 : CT2 + CR2)) + (kb + 4 * hi - subq);
                        f32x16 p0, p1;
#pragma unroll
                        for (int r = 0; r < 16; ++r) { p0[r] = tp[(r & 3) + 8 * (r >> 2)]; p1[r] = tp[32 + (r & 3) + 8 * (r >> 2)]; }
                        if (kb < 0 || kb + 64 > L) {
#pragma unroll
                            for (int r = 0; r < 16; ++r) { const int ks0 = kb + 4 * hi + (r & 3) + 8 * (r >> 2);
                                if ((unsigned)ks0 >= (unsigned)L) p0[r] = -INFINITY;
                                if ((unsigned)(ks0 + 32) >= (unsigned)L) p1[r] = -INFINITY; }
                        }
                        qk_tile<64, CKP>(p0, p1, wl + koff, qf);
                        exp_tile(p0, p1);
                        u32x4 pw_[4]; pack_tile(p0, p1, pw_); rowsum_pw(pw_, ls);
                        pv_tile<64, CVP>(o, pw_, wl + voff);
                    }
                    lsum = (ls[0] + ls[1]) + (ls[2] + ls[3]);
#undef Kc
#undef Qc
#undef proj
#undef h
#undef i0
#undef r16
#undef r32
#undef hi
#undef koff
#undef voff
#undef C_GLOAD
#undef C_DECODE
                    { RELANE(l2) lsum += shx(lsum, 32, l2); int u2 = u; asm volatile("" : "+s"(u2)); const int h2 = u2 >> 5, i02 = ((u2 >> 1) & 15) * 32, r162 = (u2 & 1) * 8 + wid;
                      store_y64(o, 1.0f / lsum, Yb, proj, 16 * (i02 + (l2 & 31)) + r162, 1024 + h2 * 64, l2 >> 5); }
                }
                __syncthreads();
            }
        }
        XCD_WAIT(2 * l + 2);
        {
            for (int ra_ = 0; ra_ < ((REP_MASK >> 8) & 1) + 1; ++ra_)
            { PHASE_BEGIN
            const float nbound = uni(-(96.0f * 0.10206207261596575f * LOG2E * 1.02f) * wave_absmax(P.mla_qk_norm + (l * 2 + 0) * 96, 96, lane) * wave_absmax(P.mla_qk_norm + (l * 2 + 1) * 96, 96, lane));
            for (int u = vcu; u < 256; u += G) {
                const int h = u >> 5, qb = u & 31, q0 = qb * 256 + wid * 32;
                f32x16 o[2]; float lsum;
                attn_dense<96, 96, 64, 0>(lds, tid, Qa + ((size_t)h * S + q0) * 96, 96, Ka + (size_t)h * S * 96, 96, Va + (size_t)h * S * 64, 64, 0, 0, nullptr, nbound, 0, o, lsum);
                { RELANE(l2) int u2 = u; asm volatile("" : "+s"(u2)); const int h2 = u2 >> 5, q02 = (u2 & 31) * 256 + wid * 32;
                  store_y64(o, 1.0f / lsum, Yb, proj, q02 + (l2 & 31), 0 + h2 * 64, l2 >> 5); }
            } }
        }
        GRID_SYNC();
        for (int rep_ = 0; rep_ < ((REP_MASK >> 6) & 1) + 1; ++rep_) {
        {
            PHASE_BEGIN
            pg8::SchedGrid sc{(const char*)Yb, (const char*)(WbT + (size_t)l * DM * DM), S / 256, DM / 256, G, bx, (size_t)256 * DM * 2, (size_t)256 * DM * 2};
            pg8::EpiBranch ep{mixB, proj + C_GATE};
            pg8::gemm_phase(lds, tid, DM, DM, DM, sc, ep);
        }
        GRID_SYNC();
        }
        if (REP_MASK & 128) { for (int k_ = 0; k_ < 8; ++k_) grid.sync(); }
        {
            PHASE_BEGIN
            const float* xin = (l == 0) ? P.x : P.out;
            pg8::SchedGrid sc{(const char*)mixB, (const char*)(WoT + (size_t)l * DM * DM), S / 256, DM / 256, G, bx, (size_t)256 * DM * 2, (size_t)256 * DM * 2};
            if (l + 1 < DEPTH) { pg8::EpiOut<true> ep{xin, P.out, Hb, (float*)(ws + WS_SSQ) + (size_t)(l + 1) * S}; pg8::gemm_phase(lds, tid, DM, DM, DM, sc, ep); }
            else { pg8::EpiOut<false> ep{xin, P.out, nullptr, nullptr}; pg8::gemm_phase(lds, tid, DM, DM, DM, sc, ep); }
        }
        GRID_SYNC();
    }
}

extern "C" void kernel_launch(void* const* d_in, const int* in_sizes, int n_in, void* d_out, int out_size, void* d_ws, size_t ws_size, hipStream_t stream) {
    static int grid = 0;
    if (grid == 0) {
        int dev = 0, cus = 0, per_cu = 0;
        hipGetDevice(&dev);
        hipDeviceGetAttribute(&cus, hipDeviceAttributeMultiprocessorCount, dev);
        hipFuncSetAttribute((const void*)mega, hipFuncAttributeMaxDynamicSharedMemorySize, LDS_BYTES);
        hipOccupancyMaxActiveBlocksPerMultiprocessor(&per_cu, (const void*)mega, 512, LDS_BYTES);
        if (per_cu < 1) per_cu = 1;
        grid = cus * 1;
        (void)hipGetLastError();
        if (ws_size < WS_END) { fprintf(stderr, "kernel_launch: workspace too small (%zu < %zu)\n", ws_size, (size_t)WS_END); grid = -1; }
    }
    if (grid < 0) return;
    Params p{};
    p.x = (const float*)d_in[0]; p.norm_w = (const float*)d_in[1]; p.w_in = (const float*)d_in[2]; p.mla_q_norm = (const float*)d_in[3];
    p.mla_kv_norm = (const float*)d_in[4]; p.mla_w_uq = (const float*)d_in[5]; p.mla_w_ukv = (const float*)d_in[6]; p.mla_qk_norm = (const float*)d_in[7];
    p.gqa_qk_norm = (const float*)d_in[8]; p.dil_qk_norm = (const float*)d_in[9]; p.diff_qk_norm = (const float*)d_in[10]; p.diff_lambda = (const float*)d_in[11];
    p.diff_subnorm = (const float*)d_in[12]; p.rel_bias = (const float*)d_in[13]; p.w_branch = (const float*)d_in[14]; p.w_out = (const float*)d_in[15];
    p.out = (float*)d_out; p.ws = (unsigned char*)d_ws;
    (void)hipMemsetAsync((char*)d_ws + WS_BAR, 0, 2 * XCD_BAR_WORDS * 4, stream);
    void* args[] = {&p};
    hipError_t e = hipLaunchCooperativeKernel((const void*)mega, dim3(grid), dim3(512), args, LDS_BYTES, stream);
    if (e != hipSuccess) fprintf(stderr, "cooperative launch failed: %s (grid %d)\n", hipGetErrorString(e), grid);
}
```

```cpp
#include <hip/hip_runtime.h>
#include <hip/hip_cooperative_groups.h>
#include <cstdio>
#include <cstdint>
namespace cg = cooperative_groups;

#define LAS __attribute__((address_space(3)))
#define DI __device__ __forceinline__
typedef unsigned short bf16_t;
typedef short bf16x8 __attribute__((ext_vector_type(8)));
typedef short s16x4 __attribute__((ext_vector_type(4)));
typedef float f32x4 __attribute__((ext_vector_type(4)));
typedef float f32x16 __attribute__((ext_vector_type(16)));
typedef unsigned u32x4 __attribute__((ext_vector_type(4)));
typedef unsigned u32x2 __attribute__((ext_vector_type(2)));

constexpr int S = 8192, DM = 2048, DEPTH = 4, NIN = 17696, LDP = 17920;
constexpr int NHT = 19, C_ACQ = 4864, C_ACKV = 5248, C_AKR = 5376, C_BV = 5408, C_CV = 5536, C_DV = 7072, C_SILU = 7584, C_GATE = 9632, C_END = 17824;
constexpr int SRC_BQ = 544, SRC_BK = 1056, SRC_BV = 1184, SRC_CQ = 1312, SRC_CK = 2848, SRC_CV = 4384, SRC_DQ = 5920, SRC_DK = 6432, SRC_DV = 6944, SRC_SILU = 7456, SRC_GATE = 9504;
__host__ __device__ inline int head_src(int idx) { return idx < 8 ? SRC_BQ + 64 * idx : idx < 10 ? SRC_BK + 64 * (idx - 8) : idx < 34 ? SRC_CQ + 64 * (idx - 10) : idx < 58 ? SRC_CK + 64 * (idx - 34)
                                                        : idx < 66 ? SRC_DQ + 64 * (idx - 58) : SRC_DK + 64 * (idx - 66); }
__host__ __device__ inline int in_src_col(int c) {
    if (c < NHT * 256) { const int T = c >> 8, ct = c & 255, bj = ct >> 7, wc = (ct >> 5) & 3, o = ct & 31, fq = o >> 3, n = (o >> 2) & 1, hs = 4 * T + wc;
        return hs < 74 ? head_src(hs) + 32 * bj + 16 * n + 4 * fq : -1; }
    const int r = c - NHT * 256;
    return r < 544 ? r : r < 672 ? SRC_BV + (r - 544) : r < 2208 ? SRC_CV + (r - 672) : r < 2720 ? SRC_DV + (r - 2208) : r < 4768 ? SRC_SILU + (r - 2720) : r < 12960 ? SRC_GATE + (r - 4768) : -1;
}
constexpr float EPS = 1e-6f;
constexpr float LOG2E = 1.4426950408889634f;

constexpr size_t MiB = 1u << 20;
constexpr size_t WS_WIN = 0;
constexpr size_t SZ_WIN1 = (size_t)LDP * DM * 2;
constexpr size_t WS_WB = WS_WIN + 4 * SZ_WIN1;
constexpr size_t SZ_WB1 = (size_t)4 * 2048 * 512 * 2;
constexpr size_t WS_WO = WS_WB + 4 * SZ_WB1;
constexpr size_t SZ_WO1 = (size_t)2048 * 2048 * 2;
constexpr size_t WS_WUQ = WS_WO + 4 * SZ_WO1;
constexpr size_t SZ_WUQ1 = (size_t)768 * 384 * 2;
constexpr size_t WS_WUKV = WS_WUQ + 4 * MiB;
constexpr size_t SZ_WUKV1 = (size_t)1024 * 256 * 2;
constexpr size_t WS_COS = WS_WUKV + 4 * MiB;
constexpr size_t WS_SIN = WS_COS + MiB;
constexpr size_t WS_DTAB = WS_SIN + MiB;
constexpr size_t WS_CTAB = WS_DTAB + MiB;
constexpr size_t WS_H = WS_CTAB + MiB;
constexpr size_t WS_PROJ = WS_H + 32 * MiB;
constexpr size_t WS_QUP = WS_PROJ + (size_t)S * LDP * 2;
constexpr size_t WS_KVUP = WS_QUP + 12 * MiB;
constexpr size_t WS_QA = WS_KVUP + 16 * MiB;
constexpr size_t WS_KA = WS_QA + 12 * MiB;
constexpr size_t WS_VA = WS_KA + 12 * MiB;
constexpr size_t WS_QB = WS_VA + 8 * MiB;
constexpr size_t WS_KB = WS_QB + 8 * MiB;
constexpr size_t WS_QC = WS_KB + 2 * MiB;
constexpr size_t WS_KC = WS_QC + 24 * MiB;
constexpr size_t WS_QD = WS_KC + 24 * MiB;
constexpr size_t WS_KD = WS_QD + 8 * MiB;
constexpr size_t WS_Y = WS_KD + 8 * MiB;
constexpr size_t WS_MIXF = WS_Y + 32 * MiB;
constexpr size_t WS_MIXB = WS_MIXF + 64 * MiB;
constexpr size_t WS_BAR = WS_MIXB + 32 * MiB;
constexpr size_t WS_SSQ = WS_BAR + MiB;
constexpr size_t WS_END = WS_SSQ + MiB;

constexpr int LDS_BYTES = 155648;
#ifndef REP_MASK
#define REP_MASK 0
#endif

DI unsigned cvt_pk(float lo, float hi) {
    typedef float f2 __attribute__((ext_vector_type(2))); typedef __bf16 b2 __attribute__((ext_vector_type(2)));
    f2 v = {lo, hi}; b2 b = __builtin_convertvector(v, b2); return __builtin_bit_cast(unsigned, b);
}
DI float bflo(unsigned u) { return __uint_as_float(u << 16); }
DI float bfhi(unsigned u) { return __uint_as_float(u & 0xffff0000u); }
DI void unpack8(const u32x4 v, float* x) { x[0] = bflo(v.x); x[1] = bfhi(v.x); x[2] = bflo(v.y); x[3] = bfhi(v.y); x[4] = bflo(v.z); x[5] = bfhi(v.z); x[6] = bflo(v.w); x[7] = bfhi(v.w); }
DI u32x4 pack8(const float* x) { u32x4 v; v.x = cvt_pk(x[0], x[1]); v.y = cvt_pk(x[2], x[3]); v.z = cvt_pk(x[4], x[5]); v.w = cvt_pk(x[6], x[7]); return v; }
DI float sigmoidf_(float v) { return __builtin_amdgcn_rcpf(1.0f + __expf(-v)); }
DI int crow(int r, int hi) { return (r & 3) + 8 * (r >> 2) + 4 * hi; }
DI float shx(float v, int m, int lane) { return __int_as_float(__builtin_amdgcn_ds_bpermute((lane ^ m) << 2, __float_as_int(v))); }

namespace pg8 {
constexpr int BM = 256, BK = 64, HALF = 128, HTB = HALF * BK * 2, STAGE_BYTES = 8 * HTB, NXCD = 8, WGM = 8;
DI int lds_byte(int r, int c) { const int st = (r >> 4) * 2 + (c >> 5), rr = r & 15, cc = c & 31, ob = rr * 64 + cc * 2; return st * 1024 + (ob ^ (((ob >> 9) & 1) << 5)); }
DI void stage_rc(int b, int& R, int& C) { const int st = b / 1024, sb = b % 1024, swz = sb ^ (((sb >> 9) & 1) << 5); R = (st >> 1) * 16 + swz / 64; C = (st & 1) * 32 + (swz % 64) / 2; }
DI int perm32(int rho) { const int n = rho >> 4, i = rho & 15; return 8 * (i >> 2) + 4 * n + (i & 3); }

struct Unit { int pm, pn, tag; const char* a; const char* b; };

DI void static_order(int L, int nM, int nN, int& pm, int& pn) {
    const int nwg = nM * nN; int wgid = L;
    { const int q = nwg / NXCD, r = nwg % NXCD, xcd = wgid % NXCD, off = wgid / NXCD; wgid = (xcd < r ? xcd * (q + 1) : r * (q + 1) + (xcd - r) * q) + off; }
    const int nig = WGM * nN, gid = wgid / nig, fm = gid * WGM, gsz = (nM - fm) < WGM ? (nM - fm) : WGM;
    pm = fm + ((wgid % nig) % gsz); pn = (wgid % nig) / gsz;
}
struct SchedGrid {
    const char* A; const char* B; int nM, nN, G, c; size_t tstepA, tstepB;
    DI bool next(int i, Unit& u) const {
        const long L = (long)i * G + c; if (L >= (long)nM * nN) return false;
        static_order((int)L, nM, nN, u.pm, u.pn); u.tag = 0; u.a = A + (size_t)u.pm * tstepA; u.b = B + (size_t)u.pn * tstepB; return true;
    }
};
struct SchedBranch {
    const char* A; const char* B; int nM, nN, G, c; size_t tstepA, tstepB, bstepA, bstepB;
    DI bool next(int i, Unit& u) const {
        const long L = (long)(i >> 2) * G + c; if (L >= (long)nM * nN) return false;
        static_order((int)L, nM, nN, u.pm, u.pn); u.tag = i & 3;
        u.a = A + (size_t)u.pm * tstepA + (size_t)u.tag * bstepA; u.b = B + (size_t)u.pn * tstepB + (size_t)u.tag * bstepB; return true;
    }
};

struct EpiBf16 {
    static constexpr bool HOOK = false;
    bf16_t* O; int ldc;
    DI void operator()(const f32x4 (&acc)[2][2][4][2], const Unit& u, int wr, int wc, int fr, int fq) const {
        const int row0 = u.pm * BM + wr * 64 + fr, col0 = u.pn * BM + wc * 32 + 8 * fq;
#pragma unroll
        for (int ai = 0; ai < 2; ++ai)
#pragma unroll
            for (int m = 0; m < 4; ++m) { bf16_t* rowp = O + (size_t)(row0 + ai * HALF + m * 16) * ldc + col0;
#pragma unroll
                for (int bj = 0; bj < 2; ++bj) { const f32x4 v0 = acc[ai][bj][m][0], v1 = acc[ai][bj][m][1];
                    u32x4 w; w.x = cvt_pk(v0[0], v0[1]); w.y = cvt_pk(v0[2], v0[3]); w.z = cvt_pk(v1[0], v1[1]); w.w = cvt_pk(v1[2], v1[3]);
                    *(u32x4*)(rowp + bj * HALF) = w; } }
    }
};
struct HeadInfo { const float* wv; bf16_t* dst; int dstride; float scale; bool rope; };
struct EpiProj {
    static constexpr bool HOOK = false;
    bf16_t* O; const float* ssq;
    const float* gqa_n; const float* dil_n; const float* diff_n;
    const float* cosT; const float* sinT;
    bf16_t* Qb; bf16_t* Kb; bf16_t* Qc; bf16_t* Kc; bf16_t* Qd; bf16_t* Kd;
    DI HeadInfo head(int idx) const {
        HeadInfo h; h.dstride = 64; h.scale = 1.f; h.rope = false;
        if (idx < 8) { h.wv = gqa_n; h.dst = Qb + (size_t)idx * S * 64; h.scale = 0.125f * LOG2E; h.rope = true; }
        else if (idx < 10) { h.wv = gqa_n + 64; h.dst = Kb + (size_t)(idx - 8) * S * 64; h.rope = true; }
        else if (idx < 34) { const int j = idx - 10; h.wv = dil_n + (j >> 3) * 64; h.dst = Qc + (size_t)j * S * 64; h.scale = 0.125f * LOG2E; }
        else if (idx < 58) { const int j = idx - 34; h.wv = dil_n + (3 + (j >> 3)) * 64; h.dst = Kc + (size_t)j * S * 64; }
        else if (idx < 66) { const int j = idx - 58; h.wv = diff_n; h.dst = Qd + (size_t)(j >> 1) * S * 128 + (j & 1) * 64; h.dstride = 128; h.scale = 0.125f * LOG2E; }
        else { const int j = idx - 66; h.wv = diff_n + 64; h.dst = Kd + (size_t)(j >> 1) * S * 128 + (j & 1) * 64; h.dstride = 128; }
        return h;
    }
    DI void operator()(const f32x4 (&acc)[2][2][4][2], const Unit& u, int wr, int wc, int fr, int fq) const {
        int row0 = u.pm * BM + wr * 64 + fr, col0 = u.pn * BM + wc * 32 + 8 * fq;
        asm volatile("" : "+v"(row0), "+v"(col0));
        float rstd[2][4];
#pragma unroll
        for (int ai = 0; ai < 2; ++ai)
#pragma unroll
            for (int m = 0; m < 4; ++m) rstd[ai][m] = rsqrtf(ssq[row0 + ai * HALF + m * 16] * (1.0f / DM) + EPS);
        if (u.pn < NHT) {
            const int hs = 4 * u.pn + wc;
            if (hs >= 74) return;
            const HeadInfo hd = head(hs);
            const int lane = fq * 16 + fr;
            f32x4 w[2][2];
#pragma unroll
            for (int bj = 0; bj < 2; ++bj)
#pragma unroll
                for (int n = 0; n < 2; ++n) w[bj][n] = *(const f32x4*)(hd.wv + 32 * bj + 16 * n + 4 * fq) * hd.scale;
#pragma unroll
            for (int ai = 0; ai < 2; ++ai)
#pragma unroll
                for (int m = 0; m < 4; ++m) {
                    const int t = row0 + ai * HALF + m * 16;
                    f32x4 x[2][2]; float ss = 0.f;
#pragma unroll
                    for (int bj = 0; bj < 2; ++bj)
#pragma unroll
                        for (int n = 0; n < 2; ++n) { x[bj][n] = acc[ai][bj][m][n] * rstd[ai][m]; const f32x4 q = x[bj][n] * x[bj][n]; ss += (q[0] + q[1]) + (q[2] + q[3]); }
                    ss += shx(ss, 16, lane); ss += shx(ss, 32, lane);
                    const float rn = rsqrtf(ss * (1.0f / 64.0f) + EPS);
#pragma unroll
                    for (int bj = 0; bj < 2; ++bj) {
                        f32x4 x1 = x[bj][0] * rn * w[bj][0], x2 = x[bj][1] * rn * w[bj][1];
                        if (hd.rope) {
                            const int pos = bj == 0 ? (t >> 6) : (t & 63);
                            const f32x4 c = *(const f32x4*)(cosT + pos * 16 + 4 * fq), sn = *(const f32x4*)(sinT + pos * 16 + 4 * fq);
                            const f32x4 y1 = x1 * c - x2 * sn, y2 = x1 * sn + x2 * c; x1 = y1; x2 = y2;
                        }
                        bf16_t* d = hd.dst + (size_t)t * hd.dstride + 32 * bj + 4 * fq;
                        u32x2 o1, o2; o1.x = cvt_pk(x1[0], x1[1]); o1.y = cvt_pk(x1[2], x1[3]); o2.x = cvt_pk(x2[0], x2[1]); o2.y = cvt_pk(x2[2], x2[3]);
                        *(u32x2*)d = o1; *(u32x2*)(d + 16) = o2;
                    }
                }
            return;
        }
#pragma unroll
        for (int bj = 0; bj < 2; ++bj) {
            const int colw = u.pn * BM + bj * HALF + wc * 32;
            const int act = colw < C_SILU ? 0 : (colw < C_GATE ? 1 : 2);
#pragma unroll
            for (int ai = 0; ai < 2; ++ai)
#pragma unroll
                for (int m = 0; m < 4; ++m) {
                    float v[8];
#pragma unroll
                    for (int j = 0; j < 4; ++j) { v[j] = acc[ai][bj][m][0][j] * rstd[ai][m]; v[4 + j] = acc[ai][bj][m][1][j] * rstd[ai][m]; }
                    if (act) {
#pragma unroll
                        for (int j = 0; j < 8; ++j) { const float sg = sigmoidf_(v[j]); v[j] = act == 1 ? v[j] * sg : sg; }
                    }
                    *(u32x4*)(O + (size_t)(row0 + ai * HALF + m * 16) * LDP + col0 + bj * HALF) = pack8(v);
                }
        }
    }
};
struct EpiBranch {
    static constexpr bool HOOK = true;
    bf16_t* MB; const bf16_t* G;
    DI void hook(f32x4 (&acc)[2][2][4][2], const Unit& u, int n, int wr, int wc, int fr, int fq) const {
        int row0 = u.pm * BM + wr * 64 + fr, col0 = u.pn * BM + wc * 32 + 8 * fq;
        asm volatile("" : "+v"(row0), "+v"(col0));
#pragma unroll
        for (int ai = 0; ai < 2; ++ai) {
#pragma unroll
            for (int m = 0; m < 4; ++m) { const size_t row = (size_t)(row0 + ai * HALF + m * 16);
#pragma unroll
                for (int bj = 0; bj < 2; ++bj) { const int col = col0 + bj * HALF;
                    float gp[8], gc[8]; unpack8(*(const u32x4*)(G + row * LDP + (size_t)(n - 1) * DM + col), gp); unpack8(*(const u32x4*)(G + row * LDP + (size_t)n * DM + col), gc);
#pragma unroll
                    for (int j = 0; j < 4; ++j) { acc[ai][bj][m][0][j] *= fmaxf(gp[j], 1e-30f) * __builtin_amdgcn_rcpf(fmaxf(gc[j], 1e-30f));
                                                  acc[ai][bj][m][1][j] *= fmaxf(gp[4 + j], 1e-30f) * __builtin_amdgcn_rcpf(fmaxf(gc[4 + j], 1e-30f)); } }
                if (m & 1) asm volatile("" ::: "memory"); }
        }
    }
    DI void operator()(const f32x4 (&acc)[2][2][4][2], const Unit& u, int wr, int wc, int fr, int fq) const {
        int row0 = u.pm * BM + wr * 64 + fr, col0 = u.pn * BM + wc * 32 + 8 * fq;
        asm volatile("" : "+v"(row0), "+v"(col0));
#pragma unroll
        for (int ai = 0; ai < 2; ++ai)
#pragma unroll
            for (int m = 0; m < 4; ++m) { const size_t row = (size_t)(row0 + ai * HALF + m * 16);
#pragma unroll
                for (int bj = 0; bj < 2; ++bj) { const int col = col0 + bj * HALF;
                    float g[8]; unpack8(*(const u32x4*)(G + row * LDP + (size_t)3 * DM + col), g);
                    const f32x4 v0 = acc[ai][bj][m][0], v1 = acc[ai][bj][m][1];
                    u32x4 w; w.x = cvt_pk(v0[0] * fmaxf(g[0], 1e-30f), v0[1] * fmaxf(g[1], 1e-30f)); w.y = cvt_pk(v0[2] * fmaxf(g[2], 1e-30f), v0[3] * fmaxf(g[3], 1e-30f));
                    w.z = cvt_pk(v1[0] * fmaxf(g[4], 1e-30f), v1[1] * fmaxf(g[5], 1e-30f)); w.w = cvt_pk(v1[2] * fmaxf(g[6], 1e-30f), v1[3] * fmaxf(g[7], 1e-30f));
                    *(u32x4*)(MB + row * DM + col) = w; } }
    }
};
template <bool NEXT>
struct EpiOut {
    static constexpr bool HOOK = false;
    const float* Xin; float* Xout; bf16_t* XB; float* ssq;
    DI void operator()(const f32x4 (&acc)[2][2][4][2], const Unit& u, int wr, int wc, int fr, int fq) const {
        int row0 = u.pm * BM + wr * 64 + fr, col0 = u.pn * BM + wc * 32 + 8 * fq; const int lane = fq * 16 + fr;
        asm volatile("" : "+v"(row0), "+v"(col0));
#pragma unroll
        for (int ai = 0; ai < 2; ++ai) {
            f32x4 xa[4][2][2];
#pragma unroll
            for (int m = 0; m < 4; ++m)
#pragma unroll
                for (int bj = 0; bj < 2; ++bj) { const size_t off = (size_t)(row0 + ai * HALF + m * 16) * DM + col0 + bj * HALF;
                    xa[m][bj][0] = *(const f32x4*)(Xin + off); xa[m][bj][1] = *(const f32x4*)(Xin + off + 4); }
#pragma unroll
            for (int m = 0; m < 4; ++m) { const int row = row0 + ai * HALF + m * 16; float ss = 0.f;
#pragma unroll
                for (int bj = 0; bj < 2; ++bj) { const size_t off = (size_t)row * DM + col0 + bj * HALF;
                    const f32x4 a = xa[m][bj][0] + acc[ai][bj][m][0], b = xa[m][bj][1] + acc[ai][bj][m][1];
                    *(f32x4*)(Xout + off) = a; *(f32x4*)(Xout + off + 4) = b;
                    if (NEXT) { u32x4 w; w.x = cvt_pk(a[0], a[1]); w.y = cvt_pk(a[2], a[3]); w.z = cvt_pk(b[0], b[1]); w.w = cvt_pk(b[2], b[3]); *(u32x4*)(XB + off) = w;
                        ss += (a[0] * a[0] + a[1] * a[1]) + (a[2] * a[2] + a[3] * a[3]) + (b[0] * b[0] + b[1] * b[1]) + (b[2] * b[2] + b[3] * b[3]); } }
                if (NEXT) { ss += shx(ss, 16, lane); ss += shx(ss, 32, lane); if (fq == 0) atomicAdd(ssq + row, ss); } }
            asm volatile("" ::: "memory");
        }
    }
};

template <class Epi, class Sched>
DI void gemm_phase(LAS unsigned char* lds, const int tid, const int K, const int lda, const int ldb, const Sched& S_, const Epi& E) {
    const int wid = __builtin_amdgcn_readfirstlane(tid >> 6), lane = tid & 63, wr = wid >> 2, wc = wid & 3, fr = lane & 15, fq = lane >> 4;
    const int nt = K / BK;
    unsigned voffA[2], voffB[2];
#pragma unroll
    for (int i = 0; i < 2; ++i) { int R, C; stage_rc(tid * 16 + i * 8192, R, C); const int Rb = (R & ~31) + perm32(R & 31);
        voffA[i] = (unsigned)(R * lda + C) * 2u; voffB[i] = (unsigned)(Rb * ldb + C) * 2u; }
    const size_t kstep = (size_t)(BK * 2);
    const size_t hstepA = (size_t)HALF * lda * 2, hstepB = (size_t)HALF * ldb * 2;
    const unsigned ldsw = (unsigned)wid * 1024u;
    const int aoff = lds_byte(wr * 64 + fr, fq * 8), boff = lds_byte(wc * 32 + fr, fq * 8);
#define PG8_SA(b, h) (((b) * 2 + (h)) * HTB)
#define PG8_SB(b, h) ((4 + (b) * 2 + (h)) * HTB)
#define PG8_STAGE(bufoff, gbase, voff) do { _Pragma("unroll") for (int _i = 0; _i < 2; ++_i) \
        __builtin_amdgcn_global_load_lds((const unsigned*)((const char*)(gbase) + (voff)[_i]), (LAS unsigned*)(lds + (bufoff) + ldsw + _i * 8192), 16, 0, 0); } while (0)
#define PG8_LDA(dst, b, h) do { _Pragma("unroll") for (int m = 0; m < 4; ++m) _Pragma("unroll") for (int k = 0; k < 2; ++k) dst[m][k] = *(const LAS bf16x8*)(lds + PG8_SA(b, h) + aoff + m * 2048 + k * 1024); } while (0)
#define PG8_LDB(dst, b, h) do { _Pragma("unroll") for (int n = 0; n < 2; ++n) _Pragma("unroll") for (int k = 0; k < 2; ++k) dst[n][k] = *(const LAS bf16x8*)(lds + PG8_SB(b, h) + boff + n * 2048 + k * 1024); } while (0)
#define PG8_MMA(ai, bj, At, Bt) do { __builtin_amdgcn_s_setprio(1); _Pragma("unroll") for (int m = 0; m < 4; ++m) _Pragma("unroll") for (int n = 0; n < 2; ++n) _Pragma("unroll") for (int k = 0; k < 2; ++k) \
        acc[ai][bj][m][n] = __builtin_amdgcn_mfma_f32_16x16x32_bf16(Bt[n][k], At[m][k], acc[ai][bj][m][n], 0, 0, 0); __builtin_amdgcn_s_setprio(0); } while (0)
#define PG8_WAIT_V(n) asm volatile("s_waitcnt vmcnt(" #n ")" ::: "memory")
#define PG8_WAIT_L(n) asm volatile("s_waitcnt lgkmcnt(" #n ")" ::: "memory")
#define PG8_BAR __builtin_amdgcn_s_barrier()
#define PG8_SCHED __builtin_amdgcn_sched_barrier(0)
    Unit cur, nxt; int ui = 0;
    if (!S_.next(0, cur)) return;
    f32x4 acc[2][2][4][2];
#pragma unroll
    for (int a = 0; a < 2; ++a)
#pragma unroll
        for (int b = 0; b < 2; ++b)
#pragma unroll
            for (int m = 0; m < 4; ++m)
#pragma unroll
                for (int n = 0; n < 2; ++n) acc[a][b][m][n] = (f32x4){0.f, 0.f, 0.f, 0.f};
    bf16x8 At[4][2], B0[2][2], B1[2][2];
    const char* cA = cur.a; const char* cB = cur.b;
    PG8_STAGE(PG8_SB(0, 0), cB, voffB); PG8_STAGE(PG8_SB(0, 1), cB + hstepB, voffB); PG8_STAGE(PG8_SA(0, 0), cA, voffA); PG8_STAGE(PG8_SA(0, 1), cA + hstepA, voffA);
    if (wr == 1) PG8_BAR;
    PG8_WAIT_V(2); PG8_BAR;
    PG8_STAGE(PG8_SB(1, 0), cB + kstep, voffB); PG8_STAGE(PG8_SA(1, 0), cA + kstep, voffA); PG8_STAGE(PG8_SB(1, 1), cB + hstepB + kstep, voffB);
    PG8_WAIT_V(6); PG8_BAR;
    for (;;) {
        const bool has_next = S_.next(ui + 1, nxt);
        const char* nA = has_next ? nxt.a : cA; const char* nB = has_next ? nxt.b : cB;
        for (int t = 0; t < nt; t += 2) {
            const bool last = (t == nt - 2);
            const char* a1 = cA + (size_t)(t + 1) * kstep;
            const char* a2 = last ? nA : cA + (size_t)(t + 2) * kstep; const char* b2 = last ? nB : cB + (size_t)(t + 2) * kstep;
            const char* a3 = a2 + kstep; const char* b3 = b2 + kstep;
            PG8_LDB(B0, 0, 0); PG8_LDB(B1, 0, 1); PG8_SCHED; PG8_LDA(At, 0, 0); PG8_STAGE(PG8_SA(1, 1), a1 + hstepA, voffA);
            PG8_WAIT_V(8); PG8_WAIT_L(0); PG8_BAR; PG8_MMA(0, 0, At, B0); PG8_MMA(0, 1, At, B1); PG8_BAR; PG8_SCHED;
            PG8_LDA(At, 0, 1); PG8_STAGE(PG8_SB(0, 0), b2, voffB); PG8_STAGE(PG8_SB(0, 1), b2 + hstepB, voffB); PG8_STAGE(PG8_SA(0, 0), a2, voffA);
            PG8_WAIT_V(8); PG8_WAIT_L(0); PG8_BAR; PG8_MMA(1, 0, At, B0); PG8_MMA(1, 1, At, B1); PG8_BAR; PG8_SCHED;
            PG8_LDB(B0, 1, 0); PG8_LDB(B1, 1, 1); PG8_SCHED; PG8_LDA(At, 1, 0); PG8_STAGE(PG8_SA(0, 1), a2 + hstepA, voffA);
            PG8_WAIT_V(8); PG8_WAIT_L(0); PG8_BAR; PG8_MMA(0, 0, At, B0); PG8_MMA(0, 1, At, B1); PG8_BAR; PG8_SCHED;
            PG8_LDA(At, 1, 1); PG8_STAGE(PG8_SB(1, 0), b3, voffB); PG8_STAGE(PG8_SB(1, 1), b3 + hstepB, voffB); PG8_STAGE(PG8_SA(1, 0), a3, voffA);
            PG8_WAIT_V(8); PG8_WAIT_L(0); PG8_BAR; PG8_MMA(1, 0, At, B0); PG8_MMA(1, 1, At, B1); PG8_BAR; PG8_SCHED;
            if constexpr (Epi::HOOK) { if (((t + 2) & 7) == 0 && !last) { E.hook(acc, cur, (t + 2) >> 3, wr, wc, fr, fq); PG8_SCHED; } }
        }
        if (wr == 0) PG8_BAR;
        E(acc, cur, wr, wc, fr, fq);
        if (!has_next) break;
#pragma unroll
        for (int a = 0; a < 2; ++a)
#pragma unroll
            for (int b = 0; b < 2; ++b)
#pragma unroll
                for (int m = 0; m < 4; ++m)
#pragma unroll
                    for (int n = 0; n < 2; ++n) acc[a][b][m][n] = (f32x4){0.f, 0.f, 0.f, 0.f};
        cur = nxt; cA = nA; cB = nB; ++ui;
        if (wr == 1) PG8_BAR;
    }
    PG8_WAIT_V(0);
    PG8_BAR;
#undef PG8_SA
#undef PG8_SB
#undef PG8_STAGE
#undef PG8_LDA
#undef PG8_LDB
#undef PG8_MMA
#undef PG8_WAIT_V
#undef PG8_WAIT_L
#undef PG8_BAR
#undef PG8_SCHED
}
}

#define MFMA32(a, b, c) __builtin_amdgcn_mfma_f32_32x32x16_bf16((a), (b), (c), 0, 0, 0)
typedef short v4i16_t __attribute__((ext_vector_type(4)));
DI s16x4 vtr(const LAS unsigned char* p) { return __builtin_bit_cast(s16x4, __builtin_amdgcn_ds_read_tr16_b64_v4i16((LAS v4i16_t*)p)); }
constexpr float THR = 8.0f;

template <int DQK, int KP>
DI void qk_tile(f32x16& p0, f32x16& p1, const LAS unsigned char* kp, const bf16x8* qf) {
#pragma unroll
    for (int d0 = 0; d0 < DQK / 16; ++d0) {
        const bf16x8 a0 = *(const LAS bf16x8*)(kp + d0 * 32);
        const bf16x8 a1 = *(const LAS bf16x8*)(kp + 32 * KP + d0 * 32);
        p0 = MFMA32(a0, qf[d0], p0); p1 = MFMA32(a1, qf[d0], p1);
    }
}
template <int DV, int VP>
DI void softmax_pv(f32x16& p0, f32x16& p1, float& l, f32x16 (&o)[DV / 32], const LAS unsigned char* vp) {
    float s0 = 0.f, s1 = 0.f, s2 = 0.f, s3 = 0.f;
#pragma unroll
    for (int r = 0; r < 16; r += 4) {
        p0[r] = __builtin_amdgcn_exp2f(p0[r]); p0[r + 1] = __builtin_amdgcn_exp2f(p0[r + 1]); p0[r + 2] = __builtin_amdgcn_exp2f(p0[r + 2]); p0[r + 3] = __builtin_amdgcn_exp2f(p0[r + 3]);
        s0 += p0[r]; s1 += p0[r + 1]; s2 += p0[r + 2]; s3 += p0[r + 3];
    }
#pragma unroll
    for (int r = 0; r < 16; r += 4) {
        p1[r] = __builtin_amdgcn_exp2f(p1[r]); p1[r + 1] = __builtin_amdgcn_exp2f(p1[r + 1]); p1[r + 2] = __builtin_amdgcn_exp2f(p1[r + 2]); p1[r + 3] = __builtin_amdgcn_exp2f(p1[r + 3]);
        s0 += p1[r]; s1 += p1[r + 1]; s2 += p1[r + 2]; s3 += p1[r + 3];
    }
    l += (s0 + s1) + (s2 + s3);
    u32x4 pw[4];
    pw[0] = (u32x4){cvt_pk(p0[0], p0[1]), cvt_pk(p0[2], p0[3]), cvt_pk(p0[4], p0[5]), cvt_pk(p0[6], p0[7])};
    pw[1] = (u32x4){cvt_pk(p0[8], p0[9]), cvt_pk(p0[10], p0[11]), cvt_pk(p0[12], p0[13]), cvt_pk(p0[14], p0[15])};
    pw[2] = (u32x4){cvt_pk(p1[0], p1[1]), cvt_pk(p1[2], p1[3]), cvt_pk(p1[4], p1[5]), cvt_pk(p1[6], p1[7])};
    pw[3] = (u32x4){cvt_pk(p1[8], p1[9]), cvt_pk(p1[10], p1[11]), cvt_pk(p1[12], p1[13]), cvt_pk(p1[14], p1[15])};
#pragma unroll
    for (int d0 = 0; d0 < DV / 32; ++d0)
#pragma unroll
        for (int ks = 0; ks < 4; ++ks) {
            const s16x4 lo = vtr(vp + (16 * ks) * VP + d0 * 64);
            const s16x4 hh = vtr(vp + (16 * ks + 8) * VP + d0 * 64);
            const bf16x8 vf = (bf16x8){lo[0], lo[1], lo[2], lo[3], hh[0], hh[1], hh[2], hh[3]};
            o[d0] = MFMA32(vf, __builtin_bit_cast(bf16x8, pw[ks]), o[d0]);
        }
}

DI void exp_tile(f32x16& p0, f32x16& p1) {
#pragma unroll
    for (int r = 0; r < 16; ++r) p0[r] = __builtin_amdgcn_exp2f(p0[r]);
#pragma unroll
    for (int r = 0; r < 16; ++r) p1[r] = __builtin_amdgcn_exp2f(p1[r]);
}
DI void sum_pack(const f32x16& p0, const f32x16& p1, float& l, u32x4 (&pw)[4]) {
    float s0 = 0.f, s1 = 0.f, s2 = 0.f, s3 = 0.f;
#pragma unroll
    for (int r = 0; r < 16; r += 4) { s0 += p0[r]; s1 += p0[r + 1]; s2 += p0[r + 2]; s3 += p0[r + 3]; }
#pragma unroll
    for (int r = 0; r < 16; r += 4) { s0 += p1[r]; s1 += p1[r + 1]; s2 += p1[r + 2]; s3 += p1[r + 3]; }
    l += (s0 + s1) + (s2 + s3);
    pw[0] = (u32x4){cvt_pk(p0[0], p0[1]), cvt_pk(p0[2], p0[3]), cvt_pk(p0[4], p0[5]), cvt_pk(p0[6], p0[7])};
    pw[1] = (u32x4){cvt_pk(p0[8], p0[9]), cvt_pk(p0[10], p0[11]), cvt_pk(p0[12], p0[13]), cvt_pk(p0[14], p0[15])};
    pw[2] = (u32x4){cvt_pk(p1[0], p1[1]), cvt_pk(p1[2], p1[3]), cvt_pk(p1[4], p1[5]), cvt_pk(p1[6], p1[7])};
    pw[3] = (u32x4){cvt_pk(p1[8], p1[9]), cvt_pk(p1[10], p1[11]), cvt_pk(p1[12], p1[13]), cvt_pk(p1[14], p1[15])};
}
template <int DV, int VP>
DI void pv_tile(f32x16 (&o)[DV / 32], const u32x4 (&pw)[4], const LAS unsigned char* vp) {
#pragma unroll
    for (int kh = 0; kh < 2; ++kh) {
        bf16x8 vf[DV / 32][2];
#pragma unroll
        for (int d0 = 0; d0 < DV / 32; ++d0)
#pragma unroll
            for (int k2 = 0; k2 < 2; ++k2) { const int ks = 2 * kh + k2;
                const s16x4 lo = vtr(vp + (16 * ks) * VP + d0 * 64);
                const s16x4 hh = vtr(vp + (16 * ks + 8) * VP + d0 * 64);
                vf[d0][k2] = (bf16x8){lo[0], lo[1], lo[2], lo[3], hh[0], hh[1], hh[2], hh[3]}; }
#pragma unroll
        for (int k2 = 0; k2 < 2; ++k2)
#pragma unroll
            for (int d0 = 0; d0 < DV / 32; ++d0) o[d0] = MFMA32(vf[d0][k2], __builtin_bit_cast(bf16x8, pw[2 * kh + k2]), o[d0]);
    }
}

typedef __bf16 bf16x2_t __attribute__((ext_vector_type(2)));
DI float dot2_ones(unsigned packed, float c) { return __builtin_amdgcn_fdot2_f32_bf16(__builtin_bit_cast(bf16x2_t, packed), __builtin_bit_cast(bf16x2_t, 0x3f803f80u), c, false); }
DI void rowsum_pw(const u32x4 (&pw)[4], float (&ls)[4]) {
#pragma unroll
    for (int w = 0; w < 16; ++w) ls[w & 3] = dot2_ones(pw[w >> 2][w & 3], ls[w & 3]);
}
DI void pack_tile(const f32x16& p0, const f32x16& p1, u32x4 (&pw)[4]) {
    pw[0] = (u32x4){cvt_pk(p0[0], p0[1]), cvt_pk(p0[2], p0[3]), cvt_pk(p0[4], p0[5]), cvt_pk(p0[6], p0[7])};
    pw[1] = (u32x4){cvt_pk(p0[8], p0[9]), cvt_pk(p0[10], p0[11]), cvt_pk(p0[12], p0[13]), cvt_pk(p0[14], p0[15])};
    pw[2] = (u32x4){cvt_pk(p1[0], p1[1]), cvt_pk(p1[2], p1[3]), cvt_pk(p1[4], p1[5]), cvt_pk(p1[6], p1[7])};
    pw[3] = (u32x4){cvt_pk(p1[8], p1[9]), cvt_pk(p1[10], p1[11]), cvt_pk(p1[12], p1[13]), cvt_pk(p1[14], p1[15])};
}
template <int DQK, int KP, int DV, int VP, bool CONSTC, int KWIN = 8, bool ONES = false>
DI void tile_step(u32x4 (&pw)[4], f32x16& pn0, f32x16& pn1, const f32x16& cvec, float (&ls)[4], f32x16 (&o)[DV / 32], const bf16x8* qf,
                  const LAS unsigned char* kp, const LAS unsigned char* vp, f32x16* osum = nullptr, bf16x8 onesf = bf16x8{}) {
    constexpr int NKS = DQK / 16, NQK = 2 * NKS, ND0 = DV / 32, NPV = 4 * ND0, EPG = 32 / NPV, W = (DV > 64) ? 4 : 8;
#define SB_ __builtin_amdgcn_sched_barrier(0)
#define VFRAG(f) do { const int ks_ = (f) / ND0, d0_ = (f) % ND0; const s16x4 lo_ = vtr(vp + (16 * ks_) * VP + d0_ * 64); const s16x4 hh_ = vtr(vp + (16 * ks_ + 8) * VP + d0_ * 64); \
        vf[(f) % W] = (bf16x8){lo_[0], lo_[1], lo_[2], lo_[3], hh_[0], hh_[1], hh_[2], hh_[3]}; } while (0)
#define KFRAG(i) do { kf[(i) % KWIN] = *(const LAS bf16x8*)(kp + ((i) & 1) * 32 * KP + ((i) >> 1) * 32); } while (0)
#define PVAL(r) ((r) < 16 ? pn0[(r) & 15] : pn1[(r) & 15])
    bf16x8 kf[KWIN];
#pragma unroll
    for (int i = 0; i < KWIN; ++i) KFRAG(i);
    SB_;
    bf16x8 vf[W]; u32x4 pwn[4];
#pragma unroll
    for (int i = 0; i < NQK; ++i) {
        if (CONSTC && i < 2) { if (i == 0) pn0 = MFMA32(kf[0], qf[0], cvec); else pn1 = MFMA32(kf[1], qf[0], cvec); }
        else if ((i & 1) == 0) pn0 = MFMA32(kf[i % KWIN], qf[i >> 1], pn0); else pn1 = MFMA32(kf[i % KWIN], qf[i >> 1], pn1);
        if (i + KWIN < NQK) KFRAG(i + KWIN);
        if (i < W) VFRAG(i);
        if (!ONES && i < 8) { ls[(2 * i) & 3] = dot2_ones(pw[(2 * i) >> 2][(2 * i) & 3], ls[(2 * i) & 3]); ls[(2 * i + 1) & 3] = dot2_ones(pw[(2 * i + 1) >> 2][(2 * i + 1) & 3], ls[(2 * i + 1) & 3]); }
        SB_;
        if (ONES && (i & 1) && i < 8) { *osum = MFMA32(onesf, __builtin_bit_cast(bf16x8, pw[i >> 1]), *osum); SB_; }
    }
#pragma unroll
    for (int j = 0; j < NPV; ++j) {
        o[j % ND0] = MFMA32(vf[j % W], __builtin_bit_cast(bf16x8, pw[j / ND0]), o[j % ND0]);
        if (j + W < NPV) VFRAG(j + W);
#pragma unroll
        for (int e = 0; e < EPG; ++e) { const int r = j * EPG + e;
            if (r < 16) pn0[r] = __builtin_amdgcn_exp2f(pn0[r]); else pn1[r - 16] = __builtin_amdgcn_exp2f(pn1[r - 16]); }
        if (j > 0) {
#pragma unroll
            for (int e = 0; e < EPG; e += 2) { const int r = (j - 1) * EPG + e; pwn[(r >> 1) >> 2][(r >> 1) & 3] = cvt_pk(PVAL(r), PVAL(r + 1)); }
        }
        SB_;
    }
#pragma unroll
    for (int e = 0; e < EPG; e += 2) { const int r = (NPV - 1) * EPG + e; pwn[(r >> 1) >> 2][(r >> 1) & 3] = cvt_pk(PVAL(r), PVAL(r + 1)); }
#pragma unroll
    for (int k = 0; k < 4; ++k) pw[k] = pwn[k];
#undef PVAL
#undef KFRAG
#undef VFRAG
#undef SB_
}

template <int KW, int DQK, int DV, int MODE>
DI void attn_dense(LAS unsigned char* lds, const int tid, const bf16_t* Qw, int qpitch, const bf16_t* Kb, int kpitch, const bf16_t* Vb, int vpitch, int kco,
                   int qtok0, const LAS float* dtab, float nbound, int rot, f32x16 (&o)[DV / 32], float& l_out) {
    constexpr int KP = KW * 2 + 16, VP = DV * 2 + 64, KT = 64 * KP, VT = 64 * VP;
    constexpr int KCH = KW / 8, NKC = 64 * KCH, KPT = (NKC + 511) / 512, VCH = DV / 8, NVC = 64 * VCH, VPT = NVC / 512;
    const int lane = tid & 63, r32 = lane & 31, hi = lane >> 5;
    bf16x8 qf[DQK / 16];
#pragma unroll
    for (int d0 = 0; d0 < DQK / 16; ++d0) qf[d0] = *(const bf16x8*)(Qw + (size_t)r32 * qpitch + d0 * 16 + hi * 8);
    u32x4 kreg[KPT], vreg[VPT];
    unsigned kgo[KPT], klo[KPT], vgo[VPT], vlo[VPT];
#pragma unroll
    for (int i_ = 0; i_ < KPT; ++i_) { const int c_ = tid + i_ * 512; const int key_ = c_ / KCH, part_ = c_ % KCH; kgo[i_] = (unsigned)(key_ * kpitch + part_ * 8) * 2u; klo[i_] = (unsigned)(key_ * KP + part_ * 16); }
#pragma unroll
    for (int i_ = 0; i_ < VPT; ++i_) { const int c_ = tid + i_ * 512; const int key_ = c_ / VCH, part_ = c_ % VCH; vgo[i_] = (unsigned)(key_ * vpitch + part_ * 8) * 2u; vlo[i_] = (unsigned)(2 * KT + key_ * VP + part_ * 16); }
    const bool kact1 = (NKC % 512 == 0) || (tid + (KPT - 1) * 512 < NKC);
#define AD_TILE(t) (((t) + rot) & (S / 64 - 1))
#define AD_GLOAD_K(t) do { const char* kt_ = (const char*)Kb + (size_t)AD_TILE(t) * 64 * kpitch * 2; \
    _Pragma("unroll") for (int i_ = 0; i_ < KPT; ++i_) { if (MODE == 1) asm volatile("" : "+v"(kgo[i_])); if (i_ + 1 < KPT || kact1) kreg[i_] = *(const u32x4*)(kt_ + kgo[i_]); } } while (0)
#define AD_GLOAD_V(t) do { const char* vt_ = (const char*)Vb + (size_t)AD_TILE(t) * 64 * vpitch * 2; \
    _Pragma("unroll") for (int i_ = 0; i_ < VPT; ++i_) { if (MODE == 1) asm volatile("" : "+v"(vgo[i_])); vreg[i_] = *(const u32x4*)(vt_ + vgo[i_]); } } while (0)
#define AD_LSTORE_K(b) do { \
    _Pragma("unroll") for (int i_ = 0; i_ < KPT; ++i_) { if (i_ + 1 < KPT || kact1) *(LAS u32x4*)(lds + (b) * KT + klo[i_]) = kreg[i_]; } } while (0)
#define AD_LSTORE_V(b) do { \
    _Pragma("unroll") for (int i_ = 0; i_ < VPT; ++i_) *(LAS u32x4*)(lds + (b) * VT + vlo[i_]) = vreg[i_]; } while (0)
#define AD_CINIT(P0, P1, t) do { \
        if (MODE == 1) { \
            const int k0_ = AD_TILE(t) * 64, minrel_ = k0_ - (qtok0 + 31), maxrel_ = k0_ + 63 - qtok0; \
            if (minrel_ >= 559 || maxrel_ <= -559) { \
                const float c_ = (minrel_ >= 559 ? dtab[2046] : dtab[0]); \
                _Pragma("unroll") for (int r = 0; r < 16; ++r) { P0[r] = c_; P1[r] = c_; } \
            } else { \
                const LAS float* tp_ = dtab + (k0_ - qtok0 - r32 + 4 * hi + 1023); \
                _Pragma("unroll") for (int r = 0; r < 16; ++r) { P0[r] = tp_[(r & 3) + 8 * (r >> 2)]; P1[r] = tp_[32 + (r & 3) + 8 * (r >> 2)]; } \
            } \
        } else { \
            _Pragma("unroll") for (int r = 0; r < 16; ++r) { P0[r] = nbound; P1[r] = nbound; } \
        } } while (0)
    float l = 0.f;
#pragma unroll
    for (int d0 = 0; d0 < DV / 32; ++d0)
#pragma unroll
        for (int r = 0; r < 16; ++r) o[d0][r] = 0.f;
    constexpr int NT = S / 64;
    const int koff = r32 * KP + (kco + hi * 8) * 2;
    const int voff = 2 * KT + (4 * hi + ((lane & 15) >> 2)) * VP + (((lane >> 4) & 1) * 16 + (lane & 3) * 4) * 2;
    AD_GLOAD_K(0); AD_LSTORE_K(0);
    __syncthreads();
    AD_GLOAD_K(1); AD_GLOAD_V(0);
    u32x4 pw[4];
    { f32x16 pc0, pc1;
      AD_CINIT(pc0, pc1, 0);
      qk_tile<DQK, KP>(pc0, pc1, lds + koff, qf);
      exp_tile(pc0, pc1);
      pack_tile(pc0, pc1, pw); }
    AD_LSTORE_K(1); AD_LSTORE_V(0);
    __syncthreads();
    float ls[4] = {0.f, 0.f, 0.f, 0.f};
    f32x16 osum;
#pragma unroll
    for (int r = 0; r < 16; ++r) osum[r] = 0.f;
    bf16x8 onesf;
#pragma unroll
    for (int j = 0; j < 8; ++j) onesf[j] = (r32 == 0) ? (short)0x3f80 : (short)0;
    f32x16 cvec;
#pragma unroll
    for (int r = 0; r < 16; ++r) cvec[r] = nbound;
    asm volatile("" : "+v"(cvec));
#define AD_STEP(CONSTC_, INIT_) do { \
        const int tn = (t + 1 < NT) ? t + 1 : NT - 1;         \
        AD_GLOAD_K(tn); \
        AD_GLOAD_V(t); \
        f32x16 pn0, pn1; \
        INIT_; \
        __builtin_amdgcn_sched_barrier(0); \
        tile_step<DQK, KP, DV, VP, CONSTC_, 4, MODE == 0>(pw, pn0, pn1, cvec, ls, o, qf, lds + (t & 1) * KT + koff, lds + ((t - 1) & 1) * VT + voff, &osum, onesf); \
        AD_LSTORE_K((t + 1) & 1); \
        AD_LSTORE_V(t & 1); \
        __syncthreads(); } while (0)
    if (MODE == 1) {
        int t1 = (qtok0 - 622 >= 0) ? (qtok0 - 622) / 64 + 1 : 0; t1 = t1 < 1 ? 1 : (t1 > NT ? NT : t1);
        int t2 = (qtok0 + 590 + 63) / 64; t2 = t2 < t1 ? t1 : (t2 > NT ? NT : t2);
        int t = 1;
        { const float c_ = dtab[0];
#pragma unroll
          for (int r = 0; r < 16; ++r) cvec[r] = c_;
          asm volatile("" : "+v"(cvec)); }
        for (; t < t1; ++t) AD_STEP(true, (void)0);
        for (; t < t2; ++t) AD_STEP(false, AD_CINIT(pn0, pn1, t));
        { const float c_ = dtab[2046];
#pragma unroll
          for (int r = 0; r < 16; ++r) cvec[r] = c_;
          asm volatile("" : "+v"(cvec)); }
        for (; t < NT; ++t) AD_STEP(true, (void)0);
    } else {
        for (int t = 1; t < NT; ++t) AD_STEP(true, (void)0);
    }
#undef AD_STEP
    rowsum_pw(pw, ls);
    pv_tile<DV, VP>(o, pw, lds + ((NT - 1) & 1) * VT + voff);
    l = (ls[0] + ls[1]) + (ls[2] + ls[3]);
    __syncthreads();
#undef AD_GLOAD_K
#undef AD_TILE
#undef AD_GLOAD_V
#undef AD_LSTORE_K
#undef AD_LSTORE_V
#undef AD_CINIT
    l += shx(l, 32, lane);
    if (MODE == 0) l += __int_as_float(__builtin_amdgcn_ds_bpermute((lane & 31) << 2, __float_as_int(osum[0])));
    l_out = l;
}

template <int KW, int DQK, int DV>
DI void attn_dense_pair(LAS unsigned char* lds, const int tid, const bf16_t* Qw, int qpitch, const bf16_t* Kb, int kpitch, const bf16_t* Vb, int vpitch,
                        float nbound, f32x16 (&o)[DV / 32], float& l_out) {
    constexpr int KP = KW * 2 + 16, VP = DV * 2 + 64, KT = 64 * KP, VT = 64 * VP;
    constexpr int KCH = KW / 8, NKC = 64 * KCH, KPT = (NKC + 511) / 512, VCH = DV / 8, NVC = 64 * VCH, VPT = NVC / 512;
    const int lane = tid & 63, r32 = lane & 31, hi = lane >> 5;
    bf16x8 qf[DQK / 16];
#pragma unroll
    for (int d0 = 0; d0 < DQK / 16; ++d0) qf[d0] = *(const bf16x8*)(Qw + (size_t)r32 * qpitch + d0 * 16 + hi * 8);
    u32x4 kreg[2][KPT], vreg[2][VPT];
    unsigned kgo[KPT], klo[KPT], vgo[VPT], vlo[VPT];
#pragma unroll
    for (int i_ = 0; i_ < KPT; ++i_) { const int c_ = tid + i_ * 512; const int key_ = c_ / KCH, part_ = c_ % KCH; kgo[i_] = (unsigned)(key_ * kpitch + part_ * 8) * 2u; klo[i_] = (unsigned)(key_ * KP + part_ * 16); }
#pragma unroll
    for (int i_ = 0; i_ < VPT; ++i_) { const int c_ = tid + i_ * 512; const int key_ = c_ / VCH, part_ = c_ % VCH; vgo[i_] = (unsigned)(key_ * vpitch + part_ * 8) * 2u; vlo[i_] = (unsigned)(4 * KT + key_ * VP + part_ * 16); }
    const bool kact1 = (NKC % 512 == 0) || (tid + (KPT - 1) * 512 < NKC);
    constexpr int NT = S / 64;
#define AP_CL(t) ((t) < NT ? (t) : NT - 1)
#define AP_GLOAD_K(j, t) do { const char* kt_ = (const char*)Kb + (size_t)AP_CL(t) * 64 * kpitch * 2; \
    _Pragma("unroll") for (int i_ = 0; i_ < KPT; ++i_) { if (i_ + 1 < KPT || kact1) kreg[j][i_] = *(const u32x4*)(kt_ + kgo[i_]); } } while (0)
#define AP_GLOAD_V(j, t) do { const char* vt_ = (const char*)Vb + (size_t)AP_CL(t) * 64 * vpitch * 2; \
    _Pragma("unroll") for (int i_ = 0; i_ < VPT; ++i_) vreg[j][i_] = *(const u32x4*)(vt_ + vgo[i_]); } while (0)
#define AP_LSTORE_K(j, t) do { \
    _Pragma("unroll") for (int i_ = 0; i_ < KPT; ++i_) { if (i_ + 1 < KPT || kact1) *(LAS u32x4*)(lds + ((t) & 3) * KT + klo[i_]) = kreg[j][i_]; } } while (0)
#define AP_LSTORE_V(j, t) do { \
    _Pragma("unroll") for (int i_ = 0; i_ < VPT; ++i_) *(LAS u32x4*)(lds + ((t) & 3) * VT + vlo[i_]) = vreg[j][i_]; } while (0)
#pragma unroll
    for (int d0 = 0; d0 < DV / 32; ++d0)
#pragma unroll
        for (int r = 0; r < 16; ++r) o[d0][r] = 0.f;
    const int koff = r32 * KP + hi * 16;
    const int voff = 4 * KT + (4 * hi + ((lane & 15) >> 2)) * VP + (((lane >> 4) & 1) * 16 + (lane & 3) * 4) * 2;
    AP_GLOAD_K(0, 0); AP_LSTORE_K(0, 0);
    __syncthreads();
    AP_GLOAD_K(0, 1); AP_GLOAD_K(1, 2); AP_GLOAD_V(0, 0); AP_GLOAD_V(1, 1);
    u32x4 pw[4];
    { f32x16 pc0, pc1;
#pragma unroll
      for (int r = 0; r < 16; ++r) { pc0[r] = nbound; pc1[r] = nbound; }
      qk_tile<DQK, KP>(pc0, pc1, lds + koff, qf);
      exp_tile(pc0, pc1);
      pack_tile(pc0, pc1, pw); }
    AP_LSTORE_K(0, 1); AP_LSTORE_K(1, 2); AP_LSTORE_V(0, 0); AP_LSTORE_V(1, 1);
    __syncthreads();
    float ls[4] = {0.f, 0.f, 0.f, 0.f};
    f32x16 osum;
#pragma unroll
    for (int r = 0; r < 16; ++r) osum[r] = 0.f;
    bf16x8 onesf;
#pragma unroll
    for (int j = 0; j < 8; ++j) onesf[j] = (r32 == 0) ? (short)0x3f80 : (short)0;
    f32x16 cvec;
#pragma unroll
    for (int r = 0; r < 16; ++r) cvec[r] = nbound;
    asm volatile("" : "+v"(cvec));
    for (int t = 1; t + 1 < NT; t += 2) {
        AP_GLOAD_K(0, t + 2); AP_GLOAD_K(1, t + 3); AP_GLOAD_V(0, t + 1); AP_GLOAD_V(1, t + 2);
        f32x16 pn0, pn1;
        __builtin_amdgcn_sched_barrier(0);
        tile_step<DQK, KP, DV, VP, true, 4, true>(pw, pn0, pn1, cvec, ls, o, qf, lds + (t & 3) * KT + koff, lds + ((t - 1) & 3) * VT + voff, &osum, onesf);
        __builtin_amdgcn_sched_barrier(0);
        tile_step<DQK, KP, DV, VP, true, 4, true>(pw, pn0, pn1, cvec, ls, o, qf, lds + ((t + 1) & 3) * KT + koff, lds + (t & 3) * VT + voff, &osum, onesf);
        AP_LSTORE_K(0, t + 2); AP_LSTORE_K(1, t + 3); AP_LSTORE_V(0, t + 1); AP_LSTORE_V(1, t + 2);
        __syncthreads();
    }
    { f32x16 pn0, pn1;
      tile_step<DQK, KP, DV, VP, true, 4, true>(pw, pn0, pn1, cvec, ls, o, qf, lds + ((NT - 1) & 3) * KT + koff, lds + ((NT - 2) & 3) * VT + voff, &osum, onesf); }
    rowsum_pw(pw, ls);
    pv_tile<DV, VP>(o, pw, lds + ((NT - 1) & 3) * VT + voff);
    float l = (ls[0] + ls[1]) + (ls[2] + ls[3]);
    __syncthreads();
#undef AP_CL
#undef AP_GLOAD_K
#undef AP_GLOAD_V
#undef AP_LSTORE_K
#undef AP_LSTORE_V
    l += shx(l, 32, lane);
    l += __int_as_float(__builtin_amdgcn_ds_bpermute((lane & 31) << 2, __float_as_int(osum[0])));
    l_out = l;
}

DI float uni(float v) { return __int_as_float(__builtin_amdgcn_readfirstlane(__float_as_int(v))); }
DI float wave_absmax(const float* w, int n, int lane) {
    float m = 0.f;
    for (int i = lane; i < n; i += 64) m = fmaxf(m, fabsf(w[i]));
#pragma unroll
    for (int o = 1; o < 64; o <<= 1) m = fmaxf(m, shx(m, o, lane));
    return m;
}

DI void store_y64(const f32x16 (&o)[2], float linv, bf16_t* Y, const bf16_t* proj, int token, int ycol, int hi) {
#pragma unroll
    for (int d0 = 0; d0 < 2; ++d0)
#pragma unroll
        for (int g = 0; g < 4; ++g) {
            const int col = ycol + 32 * d0 + 8 * g + 4 * hi;
            const u32x2 gv = *(const u32x2*)(proj + (size_t)token * LDP + C_SILU + col);
            u32x2 w;
            w.x = cvt_pk(o[d0][4 * g + 0] * linv * bflo(gv.x), o[d0][4 * g + 1] * linv * bfhi(gv.x));
            w.y = cvt_pk(o[d0][4 * g + 2] * linv * bflo(gv.y), o[d0][4 * g + 3] * linv * bfhi(gv.y));
            *(u32x2*)(Y + (size_t)token * DM + col) = w;
        }
}

struct Params {
    const float* x; const float* norm_w; const float* w_in; const float* mla_q_norm; const float* mla_kv_norm; const float* mla_w_uq; const float* mla_w_ukv;
    const float* mla_qk_norm; const float* gqa_qk_norm; const float* dil_qk_norm; const float* diff_qk_norm; const float* diff_lambda; const float* diff_subnorm;
    const float* rel_bias; const float* w_branch; const float* w_out; float* out; unsigned char* ws;
};

DI float wave_sum(float v, int lane) {
#pragma unroll
    for (int o = 1; o < 64; o <<= 1) v += shx(v, o, lane);
    return v;
}
DI unsigned f2bf(float f) { unsigned u = __float_as_uint(f); return (u + 0x7fffu + ((u >> 16) & 1u)) >> 16; }
DI unsigned pk2(float lo, float hi) { return cvt_pk(lo, hi); }

DI void transpose_item(const float* W, int K, int N, bf16_t* WT, int ldk, const float* ksc, LAS float* scr, int item, int lane) {
    const int nblk = N / 32, kb = item / nblk, nb = item % nblk, k0 = 64 * kb, n0 = 32 * nb;
    { f32x4 v[8]; const int n4 = (lane & 7) * 4, kr = lane >> 3;
#pragma unroll
      for (int i = 0; i < 8; ++i) v[i] = *(const f32x4*)(W + (size_t)(k0 + 8 * i + kr) * N + n0 + n4);
#pragma unroll
      for (int i = 0; i < 8; ++i) { LAS float* d = scr + (8 * i + kr) * 33 + n4; d[0] = v[i].x; d[1] = v[i].y; d[2] = v[i].z; d[3] = v[i].w; } }
    const int c = lane & 7;
    f32x4 sc0 = (f32x4){1.f, 1.f, 1.f, 1.f}, sc1 = sc0;
    if (ksc) { sc0 = *(const f32x4*)(ksc + k0 + 8 * c); sc1 = *(const f32x4*)(ksc + k0 + 8 * c + 4); }
    asm volatile("s_waitcnt lgkmcnt(0)" ::: "memory");
#pragma unroll
    for (int j = 0; j < 4; ++j) { const int n = (lane >> 3) + 8 * j; const LAS float* s = scr + (8 * c) * 33 + n;
        u32x4 o; o.x = pk2(s[0 * 33] * sc0.x, s[1 * 33] * sc0.y); o.y = pk2(s[2 * 33] * sc0.z, s[3 * 33] * sc0.w); o.z = pk2(s[4 * 33] * sc1.x, s[5 * 33] * sc1.y); o.w = pk2(s[6 * 33] * sc1.z, s[7 * 33] * sc1.w);
        *(u32x4*)(WT + (size_t)(n0 + n) * ldk + k0 + 8 * c) = o; }
    asm volatile("s_waitcnt lgkmcnt(0)" ::: "memory");
}

DI void transpose_item_in(const float* W, bf16_t* WT, const float* ksc, LAS float* scr, int item, int lane) {
    constexpr int nblk = LDP / 32;
    const int kb = item / nblk, nb = item % nblk, k0 = 64 * kb, n0 = 32 * nb;
    { f32x4 v[8]; const int n4 = (lane & 7) * 4, kr = lane >> 3; const int sc = in_src_col(n0 + n4);
#pragma unroll
      for (int i = 0; i < 8; ++i) v[i] = sc >= 0 ? *(const f32x4*)(W + (size_t)(k0 + 8 * i + kr) * NIN + sc) : (f32x4){0.f, 0.f, 0.f, 0.f};
#pragma unroll
      for (int i = 0; i < 8; ++i) { LAS float* d = scr + (8 * i + kr) * 33 + n4; d[0] = v[i].x; d[1] = v[i].y; d[2] = v[i].z; d[3] = v[i].w; } }
    const int c = lane & 7;
    const f32x4 sc0 = *(const f32x4*)(ksc + k0 + 8 * c), sc1 = *(const f32x4*)(ksc + k0 + 8 * c + 4);
    asm volatile("s_waitcnt lgkmcnt(0)" ::: "memory");
#pragma unroll
    for (int j = 0; j < 4; ++j) { const int n = (lane >> 3) + 8 * j; const LAS float* s = scr + (8 * c) * 33 + n;
        u32x4 o; o.x = pk2(s[0 * 33] * sc0.x, s[1 * 33] * sc0.y); o.y = pk2(s[2 * 33] * sc0.z, s[3 * 33] * sc0.w); o.z = pk2(s[4 * 33] * sc1.x, s[5 * 33] * sc1.y); o.w = pk2(s[6 * 33] * sc1.z, s[7 * 33] * sc1.w);
        *(u32x4*)(WT + (size_t)(n0 + n) * DM + k0 + 8 * c) = o; }
    asm volatile("s_waitcnt lgkmcnt(0)" ::: "memory");
}

DI int rel_bucket(int rel) {
    const int side = rel > 0 ? 16 : 0; const int n = rel < 0 ? -rel : rel;
    const float nf = (float)(n > 1 ? n : 1);
    int large = 8 + (int)(logf(nf / 8.0f) / logf(128.0f) * 8.0f);
    large = large < 15 ? large : 15;
    return side + (n < 8 ? n : large);
}


#define XB_TMO      128
#define XB_XCNT(j)  (256  + 64 * (j))
#define XB_XSUB(j)  (1280 + 64 * (j))
#define XB_XGEN(j)  (2304 + 64 * (j))
#define XB_TOP      3328
#define XB_TOPGEN   3392
#define XCD_BAR_WORDS 3456
#define XB_SPIN_CAP (1u << 22)
DI unsigned xb_ld(unsigned* p)              { return __hip_atomic_load(p, __ATOMIC_RELAXED, __HIP_MEMORY_SCOPE_AGENT); }
DI unsigned xb_add(unsigned* p, unsigned v) { return __hip_atomic_fetch_add(p, v, __ATOMIC_RELAXED, __HIP_MEMORY_SCOPE_AGENT); }
DI unsigned xb_xcc_id() { return (unsigned)__builtin_amdgcn_s_getreg((3 << 11) | 20) & 0xFu; }
#define XB_SPIN(cond, bar) do { unsigned _sp = 0; while (cond) { __builtin_amdgcn_s_sleep(1); \
    if ((++_sp & 255u) == 0u) { if (xb_ld(&(bar)[XB_TMO])) break; if (_sp > XB_SPIN_CAP) { atomicAdd(&(bar)[XB_TMO], 1u); break; } } } } while (0)
DI void xcd_barrier_complete(unsigned* bar, unsigned x, unsigned& nloc, unsigned& nx) {
    const unsigned G = gridDim.x * gridDim.y * gridDim.z;
    unsigned sum, cnt, mine, sp = 0u;
    for (;;) {
        sum = 0u; cnt = 0u; mine = 0u;
#pragma unroll
        for (unsigned j = 0; j < 16; ++j) { const unsigned c = xb_ld(&bar[XB_XCNT(j)]); sum += c; cnt += (c > 0u) ? 1u : 0u; mine = (j == x) ? c : mine; }
        if (sum == G) break;
        __builtin_amdgcn_s_sleep(1);
        if ((++sp & 255u) == 0u) { if (xb_ld(&bar[XB_TMO])) break; if (sp > XB_SPIN_CAP) { atomicAdd(&bar[XB_TMO], 1u); break; } }
    }
    nloc = mine > 0u ? mine : 1u; nx = cnt > 0u ? cnt : 1u;
}
DI void xcd_barrier(unsigned* bar, volatile LAS unsigned* st, int wid0) {
    asm volatile("s_waitcnt vmcnt(0)" ::: "memory");
    __syncthreads();
    if (wid0 == 0 && __builtin_amdgcn_mbcnt_hi(~0u, __builtin_amdgcn_mbcnt_lo(~0u, 0u)) == 0u) {
        const unsigned x = xb_xcc_id();
        __builtin_amdgcn_s_waitcnt(0);
        unsigned nloc = st[0], nx = st[1];
        if (nloc == 0u) { xcd_barrier_complete(bar, x, nloc, nx); st[0] = nloc; st[1] = nx; }
        const unsigned old = xb_add(&bar[XB_XSUB(x)], 1u);
        const unsigned gen = old / nloc;
        if (old + 1u == (gen + 1u) * nloc) {
            __builtin_amdgcn_fence(__ATOMIC_RELEASE, "agent");
            asm volatile("s_waitcnt vmcnt(0)" ::: "memory");
            const unsigned og = xb_add(&bar[XB_TOP], 1u);
            const unsigned tg = og / nx;
            if (og + 1u == (tg + 1u) * nx) xb_add(&bar[XB_TOPGEN], 1u);
            else XB_SPIN(xb_ld(&bar[XB_TOPGEN]) == tg, bar);
            __builtin_amdgcn_fence(__ATOMIC_ACQUIRE, "agent");
            xb_add(&bar[XB_XGEN(x)], 1u);
            asm volatile("s_waitcnt vmcnt(0)" ::: "memory");
        } else {
            XB_SPIN(xb_ld(&bar[XB_XGEN(x)]) == gen, bar);
            __builtin_amdgcn_fence(__ATOMIC_ACQUIRE, "agent");
            asm volatile("s_waitcnt vmcnt(0)" ::: "memory");
        }
    }
    __syncthreads();
}

DI void xcd_arrive(unsigned* bar, volatile LAS unsigned* st, int wid0) {
    asm volatile("s_waitcnt vmcnt(0)" ::: "memory");
    __syncthreads();
    if (wid0 == 0 && __builtin_amdgcn_mbcnt_hi(~0u, __builtin_amdgcn_mbcnt_lo(~0u, 0u)) == 0u) {
        const unsigned x = xb_xcc_id();
        __builtin_amdgcn_s_waitcnt(0);
        const unsigned nloc = st[0], nx = st[1];
        const unsigned old = xb_add(&bar[XB_XSUB(x)], 1u);
        const unsigned gen = old / nloc;
        if (old + 1u == (gen + 1u) * nloc) {
            __builtin_amdgcn_fence(__ATOMIC_RELEASE, "agent");
            asm volatile("s_waitcnt vmcnt(0)" ::: "memory");
            const unsigned og = xb_add(&bar[XB_TOP], 1u);
            const unsigned tg = og / nx;
            if (og + 1u == (tg + 1u) * nx) xb_add(&bar[XB_TOPGEN], 1u);
        }
    }
}
DI void xcd_wait(unsigned* bar, unsigned target, int wid0) {
    if (wid0 == 0 && __builtin_amdgcn_mbcnt_hi(~0u, __builtin_amdgcn_mbcnt_lo(~0u, 0u)) == 0u) {
        XB_SPIN(xb_ld(&bar[XB_TOPGEN]) < target, bar);
        __builtin_amdgcn_fence(__ATOMIC_ACQUIRE, "agent");
        asm volatile("s_waitcnt vmcnt(0)" ::: "memory");
    }
    __syncthreads();
}

__global__ void __launch_bounds__(512) mega(Params P) {
    extern __shared__ __attribute__((aligned(16))) unsigned char lds_raw[];
    LAS unsigned char* lds = (LAS unsigned char*)lds_raw;
    cg::grid_group grid = cg::this_grid();
    volatile LAS unsigned* bst = (volatile LAS unsigned*)(lds + LDS_BYTES - 16);
    unsigned* barw = (unsigned*)(P.ws + WS_BAR);
    if (threadIdx.x == 0) { bst[0] = 0u; bst[1] = 0u; (void)xb_add(&barw[XB_XCNT(xb_xcc_id())], 1u); }
    __syncthreads();
#define GRID_SYNC() xcd_barrier(barw, bst, wid0)
#define XCD_ARRIVE() xcd_arrive(barw + XCD_BAR_WORDS, bst, wid0)
#define XCD_WAIT(g) xcd_wait(barw + XCD_BAR_WORDS, (unsigned)(g), wid0)
    const int wid0 = __builtin_amdgcn_readfirstlane((int)threadIdx.x >> 6);
#define RELANE(x) int x = (int)__builtin_amdgcn_mbcnt_hi(~0u, __builtin_amdgcn_mbcnt_lo(~0u, 0u)); asm volatile("" : "+v"(x));
#define PHASE_BEGIN \
    int wid = wid0; asm volatile("" : "+s"(wid)); \
    int lane = (int)__builtin_amdgcn_mbcnt_hi(~0u, __builtin_amdgcn_mbcnt_lo(~0u, 0u)); asm volatile("" : "+v"(lane)); \
    const int tid = wid * 64 + lane; \
    int bx = blockIdx.x; asm volatile("" : "+s"(bx)); \
    const int G = gridDim.x; \
    const int gw = bx * 8 + wid, NGW = G * 8, gt = bx * 512 + tid, NGT = G * 512; \
    const int vcu = (G % 8 == 0) ? (bx % 8) * (G / 8) + bx / 8 : bx; \
    size_t wsz_ = 0; asm volatile("" : "+s"(wsz_)); unsigned char* ws = P.ws + wsz_; \
    bf16_t* WinT = (bf16_t*)(ws + WS_WIN); bf16_t* WbT = (bf16_t*)(ws + WS_WB); bf16_t* WoT = (bf16_t*)(ws + WS_WO); \
    bf16_t* WuqT = (bf16_t*)(ws + WS_WUQ); bf16_t* WukvT = (bf16_t*)(ws + WS_WUKV); \
    float* cosT = (float*)(ws + WS_COS); float* sinT = (float*)(ws + WS_SIN); float* dtabG = (float*)(ws + WS_DTAB); float* ctabG = (float*)(ws + WS_CTAB); \
    bf16_t* Hb = (bf16_t*)(ws + WS_H); bf16_t* proj = (bf16_t*)(ws + WS_PROJ); bf16_t* qup = (bf16_t*)(ws + WS_QUP); bf16_t* kvup = (bf16_t*)(ws + WS_KVUP); \
    bf16_t* Qa = (bf16_t*)(ws + WS_QA); bf16_t* Ka = (bf16_t*)(ws + WS_KA); bf16_t* Va = (bf16_t*)(ws + WS_VA); \
    bf16_t* Qb = (bf16_t*)(ws + WS_QB); bf16_t* Kb = (bf16_t*)(ws + WS_KB); bf16_t* Qc = (bf16_t*)(ws + WS_QC); bf16_t* Kc = (bf16_t*)(ws + WS_KC); \
    bf16_t* Qd = (bf16_t*)(ws + WS_QD); bf16_t* Kd = (bf16_t*)(ws + WS_KD); bf16_t* Yb = (bf16_t*)(ws + WS_Y); \
    float* mixF = (float*)(ws + WS_MIXF); bf16_t* mixB = (bf16_t*)(ws + WS_MIXB); \
    (void)lane; (void)gw; (void)NGW; (void)gt; (void)NGT; (void)vcu; (void)WinT; (void)WbT; (void)WoT; (void)WuqT; (void)WukvT; (void)cosT; (void)sinT; (void)dtabG; (void)ctabG; \
    (void)Hb; (void)proj; (void)qup; (void)kvup; (void)Qa; (void)Ka; (void)Va; (void)Qb; (void)Kb; (void)Qc; (void)Kc; (void)Qd; (void)Kd; (void)Yb; (void)mixF; (void)mixB;

        for (int rep_ = 0; rep_ < ((REP_MASK >> 0) & 1) + 1; ++rep_) {
    {
        PHASE_BEGIN
        LAS float* scr = (LAS float*)(lds + wid * 16384);
        constexpr int I_IN = (DM / 64) * (LDP / 32), I_BR = (512 / 64) * (DM / 32), I_O = (DM / 64) * (DM / 32), I_UQ = (384 / 64) * (768 / 32), I_UKV = (128 / 64) * (1024 / 32);
        constexpr int PER_L = I_IN + 4 * I_BR + I_O + I_UQ + I_UKV;
        for (int it = gw; it < DEPTH * PER_L; it += NGW) {
            const int l = it / PER_L; int r = it % PER_L;
            if (r < I_IN) { transpose_item_in(P.w_in + (size_t)l * DM * NIN, WinT + (size_t)l * LDP * DM, P.norm_w + l * DM, scr, r, lane); continue; } r -= I_IN;
            if (r < 4 * I_BR) { const int n = r / I_BR; transpose_item(P.w_branch + ((size_t)l * 4 + n) * 512 * DM, 512, DM, WbT + (size_t)l * DM * DM + n * 512, DM, nullptr, scr, r % I_BR, lane); continue; } r -= 4 * I_BR;
            if (r < I_O) { transpose_item(P.w_out + (size_t)l * DM * DM, DM, DM, WoT + (size_t)l * DM * DM, DM, nullptr, scr, r, lane); continue; } r -= I_O;
            if (r < I_UQ) { transpose_item(P.mla_w_uq + (size_t)l * 384 * 768, 384, 768, WuqT + (size_t)l * 768 * 384, 384, P.mla_q_norm + l * 384, scr, r, lane); continue; } r -= I_UQ;
            transpose_item(P.mla_w_ukv + (size_t)l * 128 * 1024, 128, 1024, WukvT + (size_t)l * 1024 * 256, 256, P.mla_kv_norm + l * 128, scr, r, lane);
        }
        for (int i = gt; i < DEPTH * 1024 * 16; i += NGT) { const int row = i / 16, c = i % 16;
            *(u32x4*)(WukvT + (size_t)row * 256 + 128 + c * 8) = (u32x4){0u, 0u, 0u, 0u}; }
        { float* ssq = (float*)(ws + WS_SSQ);
          for (int i = gt; i < 4 * S; i += NGT) ssq[S + i] = 0.f;
          for (int row = gw; row < S; row += NGW) {
              const f32x4* xr = (const f32x4*)(P.x + (size_t)row * DM) + lane;
              u32x2* o8 = (u32x2*)(Hb + (size_t)row * DM) + lane; float ss = 0.f;
#pragma unroll
              for (int j = 0; j < 8; ++j) { const f32x4 v = xr[64 * j]; ss += (v.x * v.x + v.y * v.y) + (v.z * v.z + v.w * v.w);
                  u32x2 o; o.x = cvt_pk(v.x, v.y); o.y = cvt_pk(v.z, v.w); o8[64 * j] = o; }
              ss = wave_sum(ss, lane);
              if (lane == 0) ssq[row] = ss;
          } }
        for (int i = gt; i < S * 16; i += NGT) { const int pos = i >> 4, fi = i & 15;
            const float inv = powf(10000.0f, -(float)(2 * fi) / 32.0f);
            const float ang = (float)pos * inv;
            const double rev = (double)ang * 0.15915494309189535; const float fr = (float)(rev - rint(rev));
            cosT[i] = __builtin_amdgcn_cosf(fr); sinT[i] = __builtin_amdgcn_sinf(fr); }
        for (int i = gt; i < 4 * 2048; i += NGT) { const int h = i >> 11, k = i & 2047; const int rel = k - 1023;
            dtabG[i] = (k < 2047) ? P.rel_bias[rel_bucket(rel) * 28 + 24 + h] * LOG2E : 0.f; }
        for (int i = gt; i < 24 * 132; i += NGT) { const int gh = i / 132, j = i % 132; const int g = gh >> 3; const int dil = 1 << (2 * g);
            ctabG[i] = (j < 129) ? P.rel_bias[rel_bucket((j - 64) * dil) * 28 + gh] * LOG2E : 0.f; }
    }
    grid.sync();
        }

    for (int l = 0; l < DEPTH; ++l) {
        for (int rep_ = 0; rep_ < ((REP_MASK >> 2) & 1) + 1; ++rep_) {
        {
            PHASE_BEGIN
            pg8::SchedGrid sc{(const char*)Hb, (const char*)(WinT + (size_t)l * LDP * DM), S / 256, LDP / 256, G, bx, (size_t)256 * DM * 2, (size_t)256 * DM * 2};
            pg8::EpiProj ep{proj, (const float*)(ws + WS_SSQ) + (size_t)l * S, P.gqa_qk_norm + l * 128, P.dil_qk_norm + l * 384, P.diff_qk_norm + l * 128, cosT, sinT, Qb, Kb, Qc, Kc, Qd, Kd};
            pg8::gemm_phase(lds, tid, DM, DM, DM, sc, ep);
        }
        GRID_SYNC();
        }
        {
            PHASE_BEGIN
            { pg8::SchedGrid sc{(const char*)(proj + C_ACQ), (const char*)(WuqT + (size_t)l * 768 * 384), S / 256, 3, G, bx, (size_t)256 * LDP * 2, (size_t)256 * 384 * 2};
              pg8::EpiBf16 ep{qup, 768}; pg8::gemm_phase(lds, tid, 384, LDP, 384, sc, ep); }
            { pg8::SchedGrid sc{(const char*)(proj + C_ACKV), (const char*)(WukvT + (size_t)l * 1024 * 256), S / 256, 4, G, (bx + 128) % G, (size_t)256 * LDP * 2, (size_t)256 * 256 * 2};
              pg8::EpiBf16 ep{kvup, 1024}; pg8::gemm_phase(lds, tid, 256, LDP, 256, sc, ep); }
        }
        XCD_ARRIVE();
        {
            for (int rb_ = 0; rb_ < ((REP_MASK >> 9) & 1) + 1; ++rb_)
            { PHASE_BEGIN
            const float nbound = uni(-(64.0f * 0.125f * LOG2E * 1.02f) * wave_absmax(P.gqa_qk_norm + (l * 2 + 0) * 64, 64, lane) * wave_absmax(P.gqa_qk_norm + (l * 2 + 1) * 64, 64, lane));
            for (int u = vcu; u < 256; u += G) {
                const int h = u >> 5, qb = u & 31, q0 = qb * 256 + wid * 32, kv = h >> 2;
                f32x16 o[2]; float lsum;
                attn_dense_pair<64, 64, 64>(lds, tid, Qb + ((size_t)h * S + q0) * 64, 64, Kb + (size_t)kv * S * 64, 64, proj + C_BV + kv * 64, LDP, nbound, o, lsum);
                { RELANE(l2) int u2 = u; asm volatile("" : "+s"(u2)); const int h2 = u2 >> 5, q02 = (u2 & 31) * 256 + wid * 32;
                  store_y64(o, 1.0f / lsum, Yb, proj, q02 + (l2 & 31), 512 + h2 * 64, l2 >> 5); }
            } }
        }
        XCD_WAIT(2 * l + 1);
        {
            PHASE_BEGIN
            const float scl = 0.10206207261596575f * LOG2E;
            for (int it2 = gt; it2 < S * 16; it2 += NGT) {
              if (it2 < S * 8) {
                const int it = it2;
                const int t = it >> 3, h = it & 7;
                size_t wz_ = 0; asm volatile("" : "+s"(wz_)); const float* wq = P.mla_qk_norm + (l * 2 + 0) * 96 + wz_;
                const bf16_t* src = qup + (size_t)t * 768 + h * 96;
                u32x4 rc[6], rq[12];
#pragma unroll
                for (int i = 0; i < 6; ++i) rc[i] = *(const u32x4*)(proj + (size_t)t * LDP + C_ACQ + h * 48 + i * 8);
#pragma unroll
                for (int i = 0; i < 12; ++i) rq[i] = *(const u32x4*)(src + i * 8);
                float cs = 0.f;
#pragma unroll
                for (int i = 0; i < 6; ++i) { float c8[8]; unpack8(rc[i], c8);
#pragma unroll
                    for (int j = 0; j < 8; ++j) cs += c8[j] * c8[j]; }
                cs += shx(cs, 1, lane); cs += shx(cs, 2, lane); cs += shx(cs, 4, lane);
                const float rstd = rsqrtf(cs * (1.0f / 384.0f) + EPS);
                float ss = 0.f;
#pragma unroll
                for (int i = 0; i < 12; ++i) { float c8[8]; unpack8(rq[i], c8);
#pragma unroll
                    for (int j = 0; j < 8; ++j) { const float v = c8[j] * rstd; ss += v * v; } }
                const float rn = rsqrtf(ss * (1.0f / 96.0f) + EPS) * rstd;
                bf16_t* dst = Qa + ((size_t)h * S + t) * 96;
#pragma unroll
                for (int i = 0; i < 8; ++i) { float c8[8]; unpack8(rq[i], c8);
#pragma unroll
                    for (int j = 0; j < 8; ++j) c8[j] *= rn * wq[i * 8 + j] * scl;
                    *(u32x4*)(dst + 8 * i) = pack8(c8); }
#pragma unroll
                for (int i = 0; i < 2; ++i) { float a8[8], b8[8]; unpack8(rq[8 + i], a8); unpack8(rq[10 + i], b8);
#pragma unroll
                    for (int j = 0; j < 8; ++j) { const float a = a8[j] * rn * wq[64 + i * 8 + j], b = b8[j] * rn * wq[80 + i * 8 + j];
                        const float c = cosT[t * 16 + i * 8 + j], sn = sinT[t * 16 + i * 8 + j];
                        a8[j] = (a * c - b * sn) * scl; b8[j] = (a * sn + b * c) * scl; }
                    *(u32x4*)(dst + 64 + 8 * i) = pack8(a8); *(u32x4*)(dst + 80 + 8 * i) = pack8(b8); }
              } else {
                const int it = it2 - S * 8;
                const int t = it >> 3, h = it & 7;
                size_t wz_ = 0; asm volatile("" : "+s"(wz_)); const float* wk = P.mla_qk_norm + (l * 2 + 1) * 96 + wz_;
                const bf16_t* src = kvup + (size_t)t * 1024 + h * 128;
                const bf16_t* srcr = proj + (size_t)t * LDP + C_AKR;
                u32x4 rc[2], rk[8], rr[4], rv[8];
#pragma unroll
                for (int i = 0; i < 2; ++i) rc[i] = *(const u32x4*)(proj + (size_t)t * LDP + C_ACKV + h * 16 + i * 8);
#pragma unroll
                for (int i = 0; i < 8; ++i) { rk[i] = *(const u32x4*)(src + i * 8); rv[i] = *(const u32x4*)(src + 64 + i * 8); }
#pragma unroll
                for (int i = 0; i < 4; ++i) rr[i] = *(const u32x4*)(srcr + i * 8);
                float cs = 0.f;
#pragma unroll
                for (int i = 0; i < 2; ++i) { float c8[8]; unpack8(rc[i], c8);
#pragma unroll
                    for (int j = 0; j < 8; ++j) cs += c8[j] * c8[j]; }
                cs += shx(cs, 1, lane); cs += shx(cs, 2, lane); cs += shx(cs, 4, lane);
                const float rstd = rsqrtf(cs * (1.0f / 128.0f) + EPS);
                float ss = 0.f;
#pragma unroll
                for (int i = 0; i < 8; ++i) { float c8[8]; unpack8(rk[i], c8);
#pragma unroll
                    for (int j = 0; j < 8; ++j) { const float v = c8[j] * rstd; ss += v * v; } }
#pragma unroll
                for (int i = 0; i < 4; ++i) { float c8[8]; unpack8(rr[i], c8);
#pragma unroll
                    for (int j = 0; j < 8; ++j) ss += c8[j] * c8[j]; }
                const float rn = rsqrtf(ss * (1.0f / 96.0f) + EPS);
                bf16_t* dst = Ka + ((size_t)h * S + t) * 96;
#pragma unroll
                for (int i = 0; i < 8; ++i) { float c8[8]; unpack8(rk[i], c8);
#pragma unroll
                    for (int j = 0; j < 8; ++j) c8[j] *= rstd * rn * wk[i * 8 + j];
                    *(u32x4*)(dst + 8 * i) = pack8(c8); }
#pragma unroll
                for (int i = 0; i < 2; ++i) { float a8[8], b8[8]; unpack8(rr[i], a8); unpack8(rr[2 + i], b8);
#pragma unroll
                    for (int j = 0; j < 8; ++j) { const float a = a8[j] * rn * wk[64 + i * 8 + j], b = b8[j] * rn * wk[80 + i * 8 + j];
                        const float c = cosT[t * 16 + i * 8 + j], sn = sinT[t * 16 + i * 8 + j];
                        a8[j] = a * c - b * sn; b8[j] = a * sn + b * c; }
                    *(u32x4*)(dst + 64 + 8 * i) = pack8(a8); *(u32x4*)(dst + 80 + 8 * i) = pack8(b8); }
                bf16_t* dv = Va + ((size_t)h * S + t) * 64;
#pragma unroll
                for (int i = 0; i < 8; ++i) { float c8[8]; unpack8(rv[i], c8);
#pragma unroll
                    for (int j = 0; j < 8; ++j) c8[j] *= rstd;
                    *(u32x4*)(dv + 8 * i) = pack8(c8); }
              }
            }
        }
        XCD_ARRIVE();
        {
            for (int rd_ = 0; rd_ < ((REP_MASK >> 10) & 1) + 1; ++rd_)
            {
                PHASE_BEGIN
                float maxb = 0.f;
                for (int i = lane; i < 32 * 28; i += 64) maxb = fmaxf(maxb, fabsf(P.rel_bias[i]));
#pragma unroll
                for (int o_ = 1; o_ < 64; o_ <<= 1) maxb = fmaxf(maxb, shx(maxb, o_, lane));
                const float nbound = uni(-((64.0f * 0.125f * LOG2E * 1.02f) * wave_absmax(P.diff_qk_norm + (l * 2 + 0) * 64, 64, lane) * wave_absmax(P.diff_qk_norm + (l * 2 + 1) * 64, 64, lane) + maxb * LOG2E));
                constexpr int DBUF = 2 * (64 * (128 * 2 + 16) + 64 * (128 * 2 + 64));
                LAS float* dtab = (LAS float*)(lds + DBUF);
                LAS float* xch = (LAS float*)lds;
                for (int u = vcu; u < 256; u += G) {
                    const int h = u >> 6, qb = u & 63, map = wid >> 2, q0 = qb * 128 + (wid & 3) * 32;
                    for (int i = tid; i < 2048; i += 512) dtab[i] = dtabG[h * 2048 + i] + nbound;
                    __syncthreads();
                    f32x16 o[4]; float lsum;
                    attn_dense<128, 64, 128, 1>(lds, tid, Qd + ((size_t)h * S + q0) * 128 + map * 64, 128, Kd + (size_t)h * S * 128, 128, proj + C_DV + h * 128, LDP, map * 64, q0, dtab, nbound, 0, o, lsum);
                    const float linv = 1.0f / lsum;
                    RELANE(l2) int u2 = u; asm volatile("" : "+s"(u2));
                    const int h2 = u2 >> 6, q02 = (u2 & 63) * 128 + (wid & 3) * 32, hi2 = l2 >> 5;
                    if (map == 1) {
#pragma unroll
                        for (int d0 = 0; d0 < 4; ++d0)
#pragma unroll
                            for (int r = 0; r < 16; ++r) xch[(d0 * 16 + r) * 256 + (wid & 3) * 64 + l2] = o[d0][r] * linv;
                    }
                    __syncthreads();
                    if (map == 0) {
                        const float* lv = P.diff_lambda + l * 256;
                        const float d01 = wave_sum(lv[l2] * lv[64 + l2], l2), d23 = wave_sum(lv[128 + l2] * lv[192 + l2], l2);
                        const float lambda_init = 0.8f - 0.6f * expf(-0.3f * (float)l);
                        const float lam = expf(d01) - expf(d23) + lambda_init;
                        float ss = 0.f;
#pragma unroll
                        for (int d0 = 0; d0 < 4; ++d0)
#pragma unroll
                            for (int r = 0; r < 16; ++r) { const float v = o[d0][r] * linv - lam * xch[(d0 * 16 + r) * 256 + wid * 64 + l2]; o[d0][r] = v; ss += v * v; }
                        ss += shx(ss, 32, l2);
                        const float rn = rsqrtf(ss * (1.0f / 128.0f) + EPS) * (1.0f - lambda_init);
                        const int token = q02 + (l2 & 31); const float* sw = P.diff_subnorm + l * 128;
#pragma unroll
                        for (int d0 = 0; d0 < 4; ++d0) {
#pragma unroll
                            for (int g = 0; g < 4; ++g) {
                                const int dv = 32 * d0 + 8 * g + 4 * hi2, col = 1536 + h2 * 128 + dv;
                                const u32x2 gv = *(const u32x2*)(proj + (size_t)token * LDP + C_SILU + col);
                                const f32x4 w = *(const f32x4*)(sw + dv);
                                u32x2 ov;
                                ov.x = cvt_pk(o[d0][4 * g + 0] * rn * w.x * bflo(gv.x), o[d0][4 * g + 1] * rn * w.y * bfhi(gv.x));
                                ov.y = cvt_pk(o[d0][4 * g + 2] * rn * w.z * bflo(gv.y), o[d0][4 * g + 3] * rn * w.w * bfhi(gv.y));
                                *(u32x2*)(Yb + (size_t)token * DM + col) = ov;
                            }
                            asm volatile("" ::: "memory");
                        }
                    }
                    __syncthreads();
                }
            }
            for (int rc_ = 0; rc_ < ((REP_MASK >> 11) & 1) + 1; ++rc_)
            {
                PHASE_BEGIN const int r32 = lane & 31, hi = lane >> 5;
                float nbound;
                { RELANE(l6)
                  float maxb = 0.f;
                  for (int i = l6; i < 32 * 28; i += 64) maxb = fmaxf(maxb, fabsf(P.rel_bias[i]));
#pragma unroll
                  for (int o_ = 1; o_ < 64; o_ <<= 1) maxb = fmaxf(maxb, shx(maxb, o_, l6));
                  float wmax = 0.f;
                  for (int g_ = 0; g_ < 3; ++g_) wmax = fmaxf(wmax, wave_absmax(P.dil_qk_norm + ((l * 2 + 0) * 3 + g_) * 64, 64, l6) * wave_absmax(P.dil_qk_norm + ((l * 2 + 1) * 3 + g_) * 64, 64, l6));
                  nbound = uni(-((64.0f * 0.125f * LOG2E * 1.02f) * wmax + maxb * LOG2E)); }
                constexpr int CKP = 144, CVP = 144, CKT = 64 * CKP, CWB = CKT + 64 * CVP;
                constexpr int CR0 = 576, CR1 = 192, CR2 = 128, CT1 = 2 * CR0 + 1, CT2 = CT1 + 2 * CR1 + 1, CTN = CT2 + 2 * CR2 + 1;
                LAS float* ctab = (LAS float*)(lds + 8 * CWB);
                LAS unsigned char* wl = lds + wid * CWB;
                for (int u = vcu; u < 256; u += G) {
                    const int h = u >> 5, bb = (u >> 1) & 15, rh = u & 1, r16 = rh * 8 + wid, i0 = bb * 32;
                    __syncthreads();
                    RELANE(l5)
                    for (int i = wid * 64 + l5; i < CTN; i += 512) { const int g_ = i < CT1 ? 0 : (i < CT2 ? 1 : 2); const int rel = i - (g_ == 0 ? CR0 : (g_ == 1 ? CT1 + CR1 : CT2 + CR2));
                        ctab[i] = (rel >= -64 && rel <= 64) ? ctabG[(g_ * 8 + h) * 132 + rel + 64] + nbound : -INFINITY; }
                    __syncthreads();
                    float lsum = 0.f; f32x16 o[2];
#pragma unroll
                    for (int d0 = 0; d0 < 2; ++d0)
#pragma unroll
                        for (int r = 0; r < 16; ++r) o[d0][r] = 0.f;
                    bf16x8 qf[4]; u32x4 kreg[8], vreg[8];
                    float ls[4] = {0.f, 0.f, 0.f, 0.f};
                    const int koff = r32 * CKP + hi * 16;
                    const int voff = CKT + (4 * hi + ((lane & 15) >> 2)) * CVP + (((lane >> 4) & 1) * 16 + (lane & 3) * 4) * 2;
#define C_DECODE(T, g_, tt_) const int g_ = (T) < 10 ? 0 : ((T) < 14 ? 1 : 2); const int tt_ = (T) - (g_ == 0 ? 0 : (g_ == 1 ? 10 : 14));
#define C_GLOAD(T) do { C_DECODE(T, g__, tt__) const int sh__ = 2 * g__, e__ = 16 >> sh__, rc__ = r16 & ((1 << sh__) - 1), L__ = S >> sh__; const int kb__ = e__ * i0 - 64 + 64 * tt__; \
        const char* kg__ = (const char*)(Kc + (size_t)(g__ * 8 + h) * S * 64); const char* vg__ = (const char*)(proj + C_CV + (g__ * 8 + h) * 64); \
        if (kb__ >= 0 && kb__ + 64 <= L__) {        \
            const size_t tok0__ = (size_t)((kb__ << sh__) + rc__); const char* kt__ = kg__ + tok0__ * 128; const char* vt__ = vg__ + tok0__ * (LDP * 2); \
            _Pragma("unroll") for (int i_ = 0; i_ < 8; ++i_) { const unsigned dk_ = (unsigned)((key0 + 8 * i_) << sh__); \
                kreg[i_] = *(const u32x4*)(kt__ + dk_ * 128u + part16); vreg[i_] = *(const u32x4*)(vt__ + dk_ * (unsigned)(LDP * 2) + part16); } \
        } else { \
            _Pragma("unroll") for (int i_ = 0; i_ < 8; ++i_) { int ks_ = kb__ + key0 + 8 * i_; ks_ = ks_ < 0 ? 0 : ks_; ks_ = ks_ > L__ - 1 ? L__ - 1 : ks_; \
                const size_t tok_ = (size_t)((ks_ << sh__) + rc__); kreg[i_] = *(const u32x4*)(kg__ + tok_ * 128 + part16); vreg[i_] = *(const u32x4*)(vg__ + tok_ * (LDP * 2) + part16); } \
        } } while (0)
                    {
                        RELANE(l4) const int tid4 = wid * 64 + l4, r32g = l4 & 31, hig = l4 >> 5;
                        const int koffg = r32g * CKP + hig * 16;
                        const int voffg = CKT + (4 * hig + ((l4 & 15) >> 2)) * CVP + (((l4 >> 4) & 1) * 16 + (l4 & 3) * 4) * 2;
                        const int h0 = h;
                        const char* kg0 = (const char*)(Kc + (size_t)(0 * 8 + h0) * S * 64); const char* vg0 = (const char*)(proj + C_CV + (0 * 8 + h0) * 64);
                        const int skey = tid4 >> 3, spart16 = (tid4 & 7) * 16;
                        u32x4 kr0, vr0;
                        const bf16_t* qg = Qc + ((size_t)(0 * 8 + h0) * S + 16 * i0 + r16) * 64;
#pragma unroll
                        for (int d0 = 0; d0 < 4; ++d0) qf[d0] = *(const bf16x8*)(qg + (size_t)r32g * 1024 + d0 * 16 + hig * 8);
#define C0_GLOAD(tt_) do { int ks_ = 16 * i0 - 64 + 64 * (tt_) + skey; ks_ = ks_ < 0 ? 0 : ks_; ks_ = ks_ > S - 1 ? S - 1 : ks_; \
        kr0 = *(const u32x4*)(kg0 + (size_t)ks_ * 128 + spart16); vr0 = *(const u32x4*)(vg0 + (size_t)ks_ * (LDP * 2) + spart16); } while (0)
#define C0_LSTORE(b_) do { *(LAS u32x4*)(lds + (b_) * CWB + skey * CKP + spart16) = kr0; *(LAS u32x4*)(lds + (b_) * CWB + CKT + skey * CVP + spart16) = vr0; } while (0)
#define C0_GLOAD_K(tt_) do { int ks_ = 16 * i0 - 64 + 64 * (tt_) + skey; ks_ = ks_ < 0 ? 0 : ks_; ks_ = ks_ > S - 1 ? S - 1 : ks_; kr0 = *(const u32x4*)(kg0 + (size_t)ks_ * 128 + spart16); } while (0)
#define C0_GLOAD_V(tt_) do { int ks_ = 16 * i0 - 64 + 64 * (tt_) + skey; ks_ = ks_ < 0 ? 0 : ks_; ks_ = ks_ > S - 1 ? S - 1 : ks_; vr0 = *(const u32x4*)(vg0 + (size_t)ks_ * (LDP * 2) + spart16); } while (0)
#define C0_LSTORE_K(b_) do { *(LAS u32x4*)(lds + (b_) * CWB + skey * CKP + spart16) = kr0; } while (0)
#define C0_LSTORE_V(b_) do { *(LAS u32x4*)(lds + (b_) * CWB + CKT + skey * CVP + spart16) = vr0; } while (0)
#define C0_CINIT(P0, P1, tt_) do { const int kb_ = 16 * i0 - 64 + 64 * (tt_); const LAS float* tp_ = ctab + CR0 + (kb_ + 4 * hig - subq); \
        _Pragma("unroll") for (int r = 0; r < 16; ++r) { P0[r] = tp_[(r & 3) + 8 * (r >> 2)]; P1[r] = tp_[32 + (r & 3) + 8 * (r >> 2)]; } \
        if (kb_ < 0 || kb_ + 64 > S) { \
            _Pragma("unroll") for (int r = 0; r < 16; ++r) { const int ks0_ = kb_ + 4 * hig + (r & 3) + 8 * (r >> 2); \
                if ((unsigned)ks0_ >= (unsigned)S) P0[r] = -INFINITY; \
                if ((unsigned)(ks0_ + 32) >= (unsigned)S) P1[r] = -INFINITY; } } } while (0)
                        const int subq = 16 * (i0 + r32g) + r16;
                        C0_GLOAD_K(0); C0_LSTORE_K(0);
                        __syncthreads();
                        C0_GLOAD_K(1); C0_GLOAD_V(0);
                        u32x4 pw0_[4];
                        { f32x16 pc0, pc1; C0_CINIT(pc0, pc1, 0);
                          qk_tile<64, CKP>(pc0, pc1, lds + koffg, qf); exp_tile(pc0, pc1); pack_tile(pc0, pc1, pw0_); }
                        C0_LSTORE_K(1); C0_LSTORE_V(0);
                        __syncthreads();
                        f32x16 cdummy;
#pragma unroll
                        for (int r = 0; r < 16; ++r) cdummy[r] = 0.f;
                        for (int tt = 1; tt < 10; ++tt) {
                            C0_GLOAD_K(tt + 1 < 10 ? tt + 1 : 9); C0_GLOAD_V(tt);
                            f32x16 pn0, pn1; C0_CINIT(pn0, pn1, tt);
                            __builtin_amdgcn_sched_barrier(0);
                            tile_step<64, CKP, 64, CVP, false>(pw0_, pn0, pn1, cdummy, ls, o, qf, lds + (tt & 1) * CWB + koffg, lds + ((tt - 1) & 1) * CWB + voffg);
                            C0_LSTORE_K((tt + 1) & 1); C0_LSTORE_V(tt & 1);
                            __syncthreads();
                        }
                        rowsum_pw(pw0_, ls);
                        pv_tile<64, CVP>(o, pw0_, lds + (9 & 1) * CWB + voffg);
                        __syncthreads();
#undef C0_GLOAD_K
#undef C0_GLOAD_V
#undef C0_LSTORE_K
#undef C0_LSTORE_V
#undef C0_CINIT
#undef C0_GLOAD
#undef C0_LSTORE
                    }
                    RELANE(l3) const int key0 = l3 >> 3, part16 = (l3 & 7) * 16;
                    size_t z3_ = 0; asm volatile("" : "+s"(z3_)); const bf16_t* Kc_ = Kc + z3_; const bf16_t* Qc_ = Qc + z3_; const bf16_t* proj_ = proj + z3_;
                    int u3_ = u; asm volatile("" : "+s"(u3_));
                    const int h_ = u3_ >> 5, i0_w = ((u3_ >> 1) & 15) * 32, r16_ = (u3_ & 1) * 8 + wid, r32_ = l3 & 31, hi_ = l3 >> 5;
                    const int koff_ = r32_ * CKP + hi_ * 16;
                    const int voff_ = CKT + (4 * hi_ + ((l3 & 15) >> 2)) * CVP + (((l3 >> 4) & 1) * 16 + (l3 & 3) * 4) * 2;
#define Kc Kc_
#define Qc Qc_
#define proj proj_
#define h h_
#define i0 i0_w
#define r16 r16_
#define r32 r32_
#define hi hi_
#define koff koff_
#define voff voff_
                    C_GLOAD(10);
                    for (int T = 10; T < 17; ++T) {
                        C_DECODE(T, g, tt)
                        const int sh = 2 * g, e = 16 >> sh, L = S >> sh;
                        if (tt == 0) {
                            const bf16_t* qg = Qc + ((size_t)(g * 8 + h) * S + 16 * i0 + r16) * 64;
#pragma unroll
                            for (int d0 = 0; d0 < 4; ++d0) qf[d0] = *(const bf16x8*)(qg + (size_t)r32 * 1024 + d0 * 16 + hi * 8);
                        }
#pragma unroll
                        for (int i_ = 0; i_ < 8; ++i_) { *(LAS u32x4*)(wl + (key0 + 8 * i_) * CKP + part16) = kreg[i_]; *(LAS u32x4*)(wl + CKT + (key0 + 8 * i_) * CVP + part16) = vreg[i_]; }
                        if (T + 1 < 17) C_GLOAD(T + 1);
                        const int kb = e * i0 - 64 + 64 * tt;
                        const int subq = e * (i0 + r32) + (r16 >> sh);
                        const LAS float* tp = ctab + (g == 0 ? CR0 : (g == 1 ? CT1 + CR1 : CT2 + CR2)) + (kb + 4 * hi - subq);
                        f32x16 p0, p1;
#pragma unroll
                        for (int r = 0; r < 16; ++r) { p0[r] = tp[(r & 3) + 8 * (r >> 2)]; p1[r] = tp[32 + (r & 3) + 8 * (r >> 2)]; }
                        if (kb < 0 || kb + 64 > L) {
#pragma unroll
                            for (int r = 0; r < 16; ++r) { const int ks0 = kb + 4 * hi + (r & 3) + 8 * (r >> 2);
                                if ((unsigned)ks0 >= (unsigned)L) p0[r] = -INFINITY;
                                if ((unsigned)(ks0 + 32) >= (unsigned)L) p1[r] = -INFINITY; }
                        }
                        qk_tile<64, CKP>(p0, p1, wl + koff, qf);
                        exp_tile(p0, p1);
                        u32x4 pw_[4]; pack_tile(p0, p1, pw_); rowsum_pw(pw_, ls);
                        pv_tile<64, CVP>(o, pw_, wl + voff);
                    }
                    lsum = (ls[0] + ls[1]) + (ls[2] + ls[3]);
#undef Kc
#undef Qc
#undef proj
#undef h
#undef i0
#undef r16
#undef r32
#undef hi
#undef koff
#undef voff
#undef C_GLOAD
#undef C_DECODE
                    { RELANE(l2) lsum += shx(lsum, 32, l2); int u2 = u; asm volatile("" : "+s"(u2)); const int h2 = u2 >> 5, i02 = ((u2 >> 1) & 15) * 32, r162 = (u2 & 1) * 8 + wid;
                      store_y64(o, 1.0f / lsum, Yb, proj, 16 * (i02 + (l2 & 31)) + r162, 1024 + h2 * 64, l2 >> 5); }
                }
                __syncthreads();
            }
        }
        XCD_WAIT(2 * l + 2);
        {
            for (int ra_ = 0; ra_ < ((REP_MASK >> 8) & 1) + 1; ++ra_)
            { PHASE_BEGIN
            const float nbound = uni(-(96.0f * 0.10206207261596575f * LOG2E * 1.02f) * wave_absmax(P.mla_qk_norm + (l * 2 + 0) * 96, 96, lane) * wave_absmax(P.mla_qk_norm + (l * 2 + 1) * 96, 96, lane));
            for (int u = vcu; u < 256; u += G) {
                const int h = u >> 5, qb = u & 31, q0 = qb * 256 + wid * 32;
                f32x16 o[2]; float lsum;
                attn_dense<96, 96, 64, 0>(lds, tid, Qa + ((size_t)h * S + q0) * 96, 96, Ka + (size_t)h * S * 96, 96, Va + (size_t)h * S * 64, 64, 0, 0, nullptr, nbound, 0, o, lsum);
                { RELANE(l2) int u2 = u; asm volatile("" : "+s"(u2)); const int h2 = u2 >> 5, q02 = (u2 & 31) * 256 + wid * 32;
                  store_y64(o, 1.0f / lsum, Yb, proj, q02 + (l2 & 31), 0 + h2 * 64, l2 >> 5); }
            } }
        }
        GRID_SYNC();
        for (int rep_ = 0; rep_ < ((REP_MASK >> 6) & 1) + 1; ++rep_) {
        {
            PHASE_BEGIN
            pg8::SchedGrid sc{(const char*)Yb, (const char*)(WbT + (size_t)l * DM * DM), S / 256, DM / 256, G, bx, (size_t)256 * DM * 2, (size_t)256 * DM * 2};
            pg8::EpiBranch ep{mixB, proj + C_GATE};
            pg8::gemm_phase(lds, tid, DM, DM, DM, sc, ep);
        }
        GRID_SYNC();
        }
        if (REP_MASK & 128) { for (int k_ = 0; k_ < 8; ++k_) grid.sync(); }
        {
            PHASE_BEGIN
            const float* xin = (l == 0) ? P.x : P.out;
            pg8::SchedGrid sc{(const char*)mixB, (const char*)(WoT + (size_t)l * DM * DM), S / 256, DM / 256, G, bx, (size_t)256 * DM * 2, (size_t)256 * DM * 2};
            if (l + 1 < DEPTH) { pg8::EpiOut<true> ep{xin, P.out, Hb, (float*)(ws + WS_SSQ) + (size_t)(l + 1) * S}; pg8::gemm_phase(lds, tid, DM, DM, DM, sc, ep); }
            else { pg8::EpiOut<false> ep{xin, P.out, nullptr, nullptr}; pg8::gemm_phase(lds, tid, DM, DM, DM, sc, ep); }
        }
        GRID_SYNC();
    }
}

extern "C" void kernel_launch(void* const* d_in, const int* in_sizes, int n_in, void* d_out, int out_size, void* d_ws, size_t ws_size, hipStream_t stream) {
    static int grid = 0;
    if (grid == 0) {
        int dev = 0, cus = 0, per_cu = 0;
        hipGetDevice(&dev);
        hipDeviceGetAttribute(&cus, hipDeviceAttributeMultiprocessorCount, dev);
        hipFuncSetAttribute((const void*)mega, hipFuncAttributeMaxDynamicSharedMemorySize, LDS_BYTES);
        hipOccupancyMaxActiveBlocksPerMultiprocessor(&per_cu, (const void*)mega, 512, LDS_BYTES);
        if (per_cu < 1) per_cu = 1;
        grid = cus * 1;
        (void)hipGetLastError();
        if (ws_size < WS_END) { fprintf(stderr, "kernel_launch: workspace too small (%zu < %zu)\n", ws_size, (size_t)WS_END); grid = -1; }
    }
    if (grid < 0) return;
    Params p{};
    p.x = (const float*)d_in[0]; p.norm_w = (const float*)d_in[1]; p.w_in = (const float*)d_in[2]; p.mla_q_norm = (const float*)d_in[3];
    p.mla_kv_norm = (const float*)d_in[4]; p.mla_w_uq = (const float*)d_in[5]; p.mla_w_ukv = (const float*)d_in[6]; p.mla_qk_norm = (const float*)d_in[7];
    p.gqa_qk_norm = (const float*)d_in[8]; p.dil_qk_norm = (const float*)d_in[9]; p.diff_qk_norm = (const float*)d_in[10]; p.diff_lambda = (const float*)d_in[11];
    p.diff_subnorm = (const float*)d_in[12]; p.rel_bias = (const float*)d_in[13]; p.w_branch = (const float*)d_in[14]; p.w_out = (const float*)d_in[15];
    p.out = (float*)d_out; p.ws = (unsigned char*)d_ws;
    (void)hipMemsetAsync((char*)d_ws + WS_BAR, 0, 2 * XCD_BAR_WORDS * 4, stream);
    void* args[] = {&p};
    hipError_t e = hipLaunchCooperativeKernel((const void*)mega, dim3(grid), dim3(512), args, LDS_BYTES, stream);
    if (e != hipSuccess) fprintf(stderr, "cooperative launch failed: %s (grid %d)\n", hipGetErrorString(e), grid);
}
```

```cpp
#include <hip/hip_runtime.h>
#include <hip/hip_cooperative_groups.h>
#include <cstdio>
#include <cstdint>
namespace cg = cooperative_groups;

#define LAS __attribute__((address_space(3)))
#define DI __device__ __forceinline__
typedef unsigned short bf16_t;
typedef short bf16x8 __attribute__((ext_vector_type(8)));
typedef short s16x4 __attribute__((ext_vector_type(4)));
typedef float f32x4 __attribute__((ext_vector_type(4)));
typedef float f32x16 __attribute__((ext_vector_type(16)));
typedef unsigned u32x4 __attribute__((ext_vector_type(4)));
typedef unsigned u32x2 __attribute__((ext_vector_type(2)));

constexpr int S = 8192, DM = 2048, DEPTH = 4, NIN = 17696, LDP = 17920;
constexpr int NHT = 19, C_ACQ = 4864, C_ACKV = 5248, C_AKR = 5376, C_BV = 5408, C_CV = 5536, C_DV = 7072, C_SILU = 7584, C_GATE = 9632, C_END = 17824;
constexpr int SRC_BQ = 544, SRC_BK = 1056, SRC_BV = 1184, SRC_CQ = 1312, SRC_CK = 2848, SRC_CV = 4384, SRC_DQ = 5920, SRC_DK = 6432, SRC_DV = 6944, SRC_SILU = 7456, SRC_GATE = 9504;
__host__ __device__ inline int head_src(int idx) { return idx < 8 ? SRC_BQ + 64 * idx : idx < 10 ? SRC_BK + 64 * (idx - 8) : idx < 34 ? SRC_CQ + 64 * (idx - 10) : idx < 58 ? SRC_CK + 64 * (idx - 34)
                                                        : idx < 66 ? SRC_DQ + 64 * (idx - 58) : SRC_DK + 64 * (idx - 66); }
__host__ __device__ inline int in_src_col(int c) {
    if (c < NHT * 256) { const int T = c >> 8, ct = c & 255, bj = ct >> 7, wc = (ct >> 5) & 3, o = ct & 31, fq = o >> 3, n = (o >> 2) & 1, hs = 4 * T + wc;
        return hs < 74 ? head_src(hs) + 32 * bj + 16 * n + 4 * fq : -1; }
    const int r = c - NHT * 256;
    return r < 544 ? r : r < 672 ? SRC_BV + (r - 544) : r < 2208 ? SRC_CV + (r - 672) : r < 2720 ? SRC_DV + (r - 2208) : r < 4768 ? SRC_SILU + (r - 2720) : r < 12960 ? SRC_GATE + (r - 4768) : -1;
}
constexpr float EPS = 1e-6f;
constexpr float LOG2E = 1.4426950408889634f;

constexpr size_t MiB = 1u << 20;
constexpr size_t WS_WIN = 0;
constexpr size_t SZ_WIN1 = (size_t)LDP * DM * 2;
constexpr size_t WS_WB = WS_WIN + 4 * SZ_WIN1;
constexpr size_t SZ_WB1 = (size_t)4 * 2048 * 512 * 2;
constexpr size_t WS_WO = WS_WB + 4 * SZ_WB1;
constexpr size_t SZ_WO1 = (size_t)2048 * 2048 * 2;
constexpr size_t WS_WUQ = WS_WO + 4 * SZ_WO1;
constexpr size_t SZ_WUQ1 = (size_t)768 * 384 * 2;
constexpr size_t WS_WUKV = WS_WUQ + 4 * MiB;
constexpr size_t SZ_WUKV1 = (size_t)1024 * 256 * 2;
constexpr size_t WS_COS = WS_WUKV + 4 * MiB;
constexpr size_t WS_SIN = WS_COS + MiB;
constexpr size_t WS_DTAB = WS_SIN + MiB;
constexpr size_t WS_CTAB = WS_DTAB + MiB;
constexpr size_t WS_H = WS_CTAB + MiB;
constexpr size_t WS_PROJ = WS_H + 32 * MiB;
constexpr size_t WS_QUP = WS_PROJ + (size_t)S * LDP * 2;
constexpr size_t WS_KVUP = WS_QUP + 12 * MiB;
constexpr size_t WS_QA = WS_KVUP + 16 * MiB;
constexpr size_t WS_KA = WS_QA + 12 * MiB;
constexpr size_t WS_VA = WS_KA + 12 * MiB;
constexpr size_t WS_QB = WS_VA + 8 * MiB;
constexpr size_t WS_KB = WS_QB + 8 * MiB;
constexpr size_t WS_QC = WS_KB + 2 * MiB;
constexpr size_t WS_KC = WS_QC + 24 * MiB;
constexpr size_t WS_QD = WS_KC + 24 * MiB;
constexpr size_t WS_KD = WS_QD + 8 * MiB;
constexpr size_t WS_Y = WS_KD + 8 * MiB;
constexpr size_t WS_MIXF = WS_Y + 32 * MiB;
constexpr size_t WS_MIXB = WS_MIXF + 64 * MiB;
constexpr size_t WS_BAR = WS_MIXB + 32 * MiB;
constexpr size_t WS_SSQ = WS_BAR + MiB;
constexpr size_t WS_END = WS_SSQ + MiB;

constexpr int LDS_BYTES = 155648;
#ifndef REP_MASK
#define REP_MASK 0
#endif

DI unsigned cvt_pk(float lo, float hi) {
    typedef float f2 __attribute__((ext_vector_type(2))); typedef __bf16 b2 __attribute__((ext_vector_type(2)));
    f2 v = {lo, hi}; b2 b = __builtin_convertvector(v, b2); return __builtin_bit_cast(unsigned, b);
}
DI float bflo(unsigned u) { return __uint_as_float(u << 16); }
DI float bfhi(unsigned u) { return __uint_as_float(u & 0xffff0000u); }
DI void unpack8(const u32x4 v, float* x) { x[0] = bflo(v.x); x[1] = bfhi(v.x); x[2] = bflo(v.y); x[3] = bfhi(v.y); x[4] = bflo(v.z); x[5] = bfhi(v.z); x[6] = bflo(v.w); x[7] = bfhi(v.w); }
DI u32x4 pack8(const float* x) { u32x4 v; v.x = cvt_pk(x[0], x[1]); v.y = cvt_pk(x[2], x[3]); v.z = cvt_pk(x[4], x[5]); v.w = cvt_pk(x[6], x[7]); return v; }
DI float sigmoidf_(float v) { return __builtin_amdgcn_rcpf(1.0f + __expf(-v)); }
DI int crow(int r, int hi) { return (r & 3) + 8 * (r >> 2) + 4 * hi; }
DI float shx(float v, int m, int lane) { return __int_as_float(__builtin_amdgcn_ds_bpermute((lane ^ m) << 2, __float_as_int(v))); }

namespace pg8 {
constexpr int BM = 256, BK = 64, HALF = 128, HTB = HALF * BK * 2, STAGE_BYTES = 8 * HTB, NXCD = 8, WGM = 8;
DI int lds_byte(int r, int c) { const int st = (r >> 4) * 2 + (c >> 5), rr = r & 15, cc = c & 31, ob = rr * 64 + cc * 2; return st * 1024 + (ob ^ (((ob >> 9) & 1) << 5)); }
DI void stage_rc(int b, int& R, int& C) { const int st = b / 1024, sb = b % 1024, swz = sb ^ (((sb >> 9) & 1) << 5); R = (st >> 1) * 16 + swz / 64; C = (st & 1) * 32 + (swz % 64) / 2; }
DI int perm32(int rho) { const int n = rho >> 4, i = rho & 15; return 8 * (i >> 2) + 4 * n + (i & 3); }

struct Unit { int pm, pn, tag; const char* a; const char* b; };

DI void static_order(int L, int nM, int nN, int& pm, int& pn) {
    const int nwg = nM * nN; int wgid = L;
    { const int q = nwg / NXCD, r = nwg % NXCD, xcd = wgid % NXCD, off = wgid / NXCD; wgid = (xcd < r ? xcd * (q + 1) : r * (q + 1) + (xcd - r) * q) + off; }
    const int nig = WGM * nN, gid = wgid / nig, fm = gid * WGM, gsz = (nM - fm) < WGM ? (nM - fm) : WGM;
    pm = fm + ((wgid % nig) % gsz); pn = (wgid % nig) / gsz;
}
struct SchedGrid {
    const char* A; const char* B; int nM, nN, G, c; size_t tstepA, tstepB;
    DI bool next(int i, Unit& u) const {
        const long L = (long)i * G + c; if (L >= (long)nM * nN) return false;
        static_order((int)L, nM, nN, u.pm, u.pn); u.tag = 0; u.a = A + (size_t)u.pm * tstepA; u.b = B + (size_t)u.pn * tstepB; return true;
    }
};
struct SchedBranch {
    const char* A; const char* B; int nM, nN, G, c; size_t tstepA, tstepB, bstepA, bstepB;
    DI bool next(int i, Unit& u) const {
        const long L = (long)(i >> 2) * G + c; if (L >= (long)nM * nN) return false;
        static_order((int)L, nM, nN, u.pm, u.pn); u.tag = i & 3;
        u.a = A + (size_t)u.pm * tstepA + (size_t)u.tag * bstepA; u.b = B + (size_t)u.pn * tstepB + (size_t)u.tag * bstepB; return true;
    }
};

struct EpiBf16 {
    static constexpr bool HOOK = false;
    bf16_t* O; int ldc;
    DI void operator()(const f32x4 (&acc)[2][2][4][2], const Unit& u, int wr, int wc, int fr, int fq) const {
        const int row0 = u.pm * BM + wr * 64 + fr, col0 = u.pn * BM + wc * 32 + 8 * fq;
#pragma unroll
        for (int ai = 0; ai < 2; ++ai)
#pragma unroll
            for (int m = 0; m < 4; ++m) { bf16_t* rowp = O + (size_t)(row0 + ai * HALF + m * 16) * ldc + col0;
#pragma unroll
                for (int bj = 0; bj < 2; ++bj) { const f32x4 v0 = acc[ai][bj][m][0], v1 = acc[ai][bj][m][1];
                    u32x4 w; w.x = cvt_pk(v0[0], v0[1]); w.y = cvt_pk(v0[2], v0[3]); w.z = cvt_pk(v1[0], v1[1]); w.w = cvt_pk(v1[2], v1[3]);
                    *(u32x4*)(rowp + bj * HALF) = w; } }
    }
};
struct HeadInfo { const float* wv; bf16_t* dst; int dstride; float scale; bool rope; };
struct EpiProj {
    static constexpr bool HOOK = false;
    bf16_t* O; const float* ssq;
    const float* gqa_n; const float* dil_n; const float* diff_n;
    const float* cosT; const float* sinT;
    bf16_t* Qb; bf16_t* Kb; bf16_t* Qc; bf16_t* Kc; bf16_t* Qd; bf16_t* Kd;
    DI HeadInfo head(int idx) const {
        HeadInfo h; h.dstride = 64; h.scale = 1.f; h.rope = false;
        if (idx < 8) { h.wv = gqa_n; h.dst = Qb + (size_t)idx * S * 64; h.scale = 0.125f * LOG2E; h.rope = true; }
        else if (idx < 10) { h.wv = gqa_n + 64; h.dst = Kb + (size_t)(idx - 8) * S * 64; h.rope = true; }
        else if (idx < 34) { const int j = idx - 10; h.wv = dil_n + (j >> 3) * 64; h.dst = Qc + (size_t)j * S * 64; h.scale = 0.125f * LOG2E; }
        else if (idx < 58) { const int j = idx - 34; h.wv = dil_n + (3 + (j >> 3)) * 64; h.dst = Kc + (size_t)j * S * 64; }
        else if (idx < 66) { const int j = idx - 58; h.wv = diff_n; h.dst = Qd + (size_t)(j >> 1) * S * 128 + (j & 1) * 64; h.dstride = 128; h.scale = 0.125f * LOG2E; }
        else { const int j = idx - 66; h.wv = diff_n + 64; h.dst = Kd + (size_t)(j >> 1) * S * 128 + (j & 1) * 64; h.dstride = 128; }
        return h;
    }
    DI void operator()(const f32x4 (&acc)[2][2][4][2], const Unit& u, int wr, int wc, int fr, int fq) const {
        int row0 = u.pm * BM + wr * 64 + fr, col0 = u.pn * BM + wc * 32 + 8 * fq;
        asm volatile("" : "+v"(row0), "+v"(col0));
        float rstd[2][4];
#pragma unroll
        for (int ai = 0; ai < 2; ++ai)
#pragma unroll
            for (int m = 0; m < 4; ++m) rstd[ai][m] = rsqrtf(ssq[row0 + ai * HALF + m * 16] * (1.0f / DM) + EPS);
        if (u.pn < NHT) {
            const int hs = 4 * u.pn + wc;
            if (hs >= 74) return;
            const HeadInfo hd = head(hs);
            const int lane = fq * 16 + fr;
            f32x4 w[2][2];
#pragma unroll
            for (int bj = 0; bj < 2; ++bj)
#pragma unroll
                for (int n = 0; n < 2; ++n) w[bj][n] = *(const f32x4*)(hd.wv + 32 * bj + 16 * n + 4 * fq) * hd.scale;
#pragma unroll
            for (int ai = 0; ai < 2; ++ai)
#pragma unroll
                for (int m = 0; m < 4; ++m) {
                    const int t = row0 + ai * HALF + m * 16;
                    f32x4 x[2][2]; float ss = 0.f;
#pragma unroll
                    for (int bj = 0; bj < 2; ++bj)
#pragma unroll
                        for (int n = 0; n < 2; ++n) { x[bj][n] = acc[ai][bj][m][n] * rstd[ai][m]; const f32x4 q = x[bj][n] * x[bj][n]; ss += (q[0] + q[1]) + (q[2] + q[3]); }
                    ss += shx(ss, 16, lane); ss += shx(ss, 32, lane);
                    const float rn = rsqrtf(ss * (1.0f / 64.0f) + EPS);
#pragma unroll
                    for (int bj = 0; bj < 2; ++bj) {
                        f32x4 x1 = x[bj][0] * rn * w[bj][0], x2 = x[bj][1] * rn * w[bj][1];
                        if (hd.rope) {
                            const int pos = bj == 0 ? (t >> 6) : (t & 63);
                            const f32x4 c = *(const f32x4*)(cosT + pos * 16 + 4 * fq), sn = *(const f32x4*)(sinT + pos * 16 + 4 * fq);
                            const f32x4 y1 = x1 * c - x2 * sn, y2 = x1 * sn + x2 * c; x1 = y1; x2 = y2;
                        }
                        bf16_t* d = hd.dst + (size_t)t * hd.dstride + 32 * bj + 4 * fq;
                        u32x2 o1, o2; o1.x = cvt_pk(x1[0], x1[1]); o1.y = cvt_pk(x1[2], x1[3]); o2.x = cvt_pk(x2[0], x2[1]); o2.y = cvt_pk(x2[2], x2[3]);
                        *(u32x2*)d = o1; *(u32x2*)(d + 16) = o2;
                    }
                }
            return;
        }
#pragma unroll
        for (int bj = 0; bj < 2; ++bj) {
            const int colw = u.pn * BM + bj * HALF + wc * 32;
            const int act = colw < C_SILU ? 0 : (colw < C_GATE ? 1 : 2);
#pragma unroll
            for (int ai = 0; ai < 2; ++ai)
#pragma unroll
                for (int m = 0; m < 4; ++m) {
                    float v[8];
#pragma unroll
                    for (int j = 0; j < 4; ++j) { v[j] = acc[ai][bj][m][0][j] * rstd[ai][m]; v[4 + j] = acc[ai][bj][m][1][j] * rstd[ai][m]; }
                    if (act) {
#pragma unroll
                        for (int j = 0; j < 8; ++j) { const float sg = sigmoidf_(v[j]); v[j] = act == 1 ? v[j] * sg : sg; }
                    }
                    *(u32x4*)(O + (size_t)(row0 + ai * HALF + m * 16) * LDP + col0 + bj * HALF) = pack8(v);
                }
        }
    }
};
struct EpiBranch {
    static constexpr bool HOOK = true;
    bf16_t* MB; const bf16_t* G;
    DI void hook(f32x4 (&acc)[2][2][4][2], const Unit& u, int n, int wr, int wc, int fr, int fq) const {
        int row0 = u.pm * BM + wr * 64 + fr, col0 = u.pn * BM + wc * 32 + 8 * fq;
        asm volatile("" : "+v"(row0), "+v"(col0));
#pragma unroll
        for (int ai = 0; ai < 2; ++ai) {
#pragma unroll
            for (int m = 0; m < 4; ++m) { const size_t row = (size_t)(row0 + ai * HALF + m * 16);
#pragma unroll
                for (int bj = 0; bj < 2; ++bj) { const int col = col0 + bj * HALF;
                    float gp[8], gc[8]; unpack8(*(const u32x4*)(G + row * LDP + (size_t)(n - 1) * DM + col), gp); unpack8(*(const u32x4*)(G + row * LDP + (size_t)n * DM + col), gc);
#pragma unroll
                    for (int j = 0; j < 4; ++j) { acc[ai][bj][m][0][j] *= fmaxf(gp[j], 1e-30f) * __builtin_amdgcn_rcpf(fmaxf(gc[j], 1e-30f));
                                                  acc[ai][bj][m][1][j] *= fmaxf(gp[4 + j], 1e-30f) * __builtin_amdgcn_rcpf(fmaxf(gc[4 + j], 1e-30f)); } }
                if (m & 1) asm volatile("" ::: "memory"); }
        }
    }
    DI void operator()(const f32x4 (&acc)[2][2][4][2], const Unit& u, int wr, int wc, int fr, int fq) const {
        int row0 = u.pm * BM + wr * 64 + fr, col0 = u.pn * BM + wc * 32 + 8 * fq;
        asm volatile("" : "+v"(row0), "+v"(col0));
#pragma unroll
        for (int ai = 0; ai < 2; ++ai)
#pragma unroll
            for (int m = 0; m < 4; ++m) { const size_t row = (size_t)(row0 + ai * HALF + m * 16);
#pragma unroll
                for (int bj = 0; bj < 2; ++bj) { const int col = col0 + bj * HALF;
                    float g[8]; unpack8(*(const u32x4*)(G + row * LDP + (size_t)3 * DM + col), g);
                    const f32x4 v0 = acc[ai][bj][m][0], v1 = acc[ai][bj][m][1];
                    u32x4 w; w.x = cvt_pk(v0[0] * fmaxf(g[0], 1e-30f), v0[1] * fmaxf(g[1], 1e-30f)); w.y = cvt_pk(v0[2] * fmaxf(g[2], 1e-30f), v0[3] * fmaxf(g[3], 1e-30f));
                    w.z = cvt_pk(v1[0] * fmaxf(g[4], 1e-30f), v1[1] * fmaxf(g[5], 1e-30f)); w.w = cvt_pk(v1[2] * fmaxf(g[6], 1e-30f), v1[3] * fmaxf(g[7], 1e-30f));
                    *(u32x4*)(MB + row * DM + col) = w; } }
    }
};
template <bool NEXT>
struct EpiOut {
    static constexpr bool HOOK = false;
    const float* Xin; float* Xout; bf16_t* XB; float* ssq;
    DI void operator()(const f32x4 (&acc)[2][2][4][2], const Unit& u, int wr, int wc, int fr, int fq) const {
        int row0 = u.pm * BM + wr * 64 + fr, col0 = u.pn * BM + wc * 32 + 8 * fq; const int lane = fq * 16 + fr;
        asm volatile("" : "+v"(row0), "+v"(col0));
#pragma unroll
        for (int ai = 0; ai < 2; ++ai) {
            f32x4 xa[4][2][2];
#pragma unroll
            for (int m = 0; m < 4; ++m)
#pragma unroll
                for (int bj = 0; bj < 2; ++bj) { const size_t off = (size_t)(row0 + ai * HALF + m * 16) * DM + col0 + bj * HALF;
                    xa[m][bj][0] = *(const f32x4*)(Xin + off); xa[m][bj][1] = *(const f32x4*)(Xin + off + 4); }
#pragma unroll
            for (int m = 0; m < 4; ++m) { const int row = row0 + ai * HALF + m * 16; float ss = 0.f;
#pragma unroll
                for (int bj = 0; bj < 2; ++bj) { const size_t off = (size_t)row * DM + col0 + bj * HALF;
                    const f32x4 a = xa[m][bj][0] + acc[ai][bj][m][0], b = xa[m][bj][1] + acc[ai][bj][m][1];
                    *(f32x4*)(Xout + off) = a; *(f32x4*)(Xout + off + 4) = b;
                    if (NEXT) { u32x4 w; w.x = cvt_pk(a[0], a[1]); w.y = cvt_pk(a[2], a[3]); w.z = cvt_pk(b[0], b[1]); w.w = cvt_pk(b[2], b[3]); *(u32x4*)(XB + off) = w;
                        ss += (a[0] * a[0] + a[1] * a[1]) + (a[2] * a[2] + a[3] * a[3]) + (b[0] * b[0] + b[1] * b[1]) + (b[2] * b[2] + b[3] * b[3]); } }
                if (NEXT) { ss += shx(ss, 16, lane); ss += shx(ss, 32, lane); if (fq == 0) atomicAdd(ssq + row, ss); } }
            asm volatile("" ::: "memory");
        }
    }
};

template <class Epi, class Sched>
DI void gemm_phase(LAS unsigned char* lds, const int tid, const int K, const int lda, const int ldb, const Sched& S_, const Epi& E) {
    const int wid = __builtin_amdgcn_readfirstlane(tid >> 6), lane = tid & 63, wr = wid >> 2, wc = wid & 3, fr = lane & 15, fq = lane >> 4;
    const int nt = K / BK;
    unsigned voffA[2], voffB[2];
#pragma unroll
    for (int i = 0; i < 2; ++i) { int R, C; stage_rc(tid * 16 + i * 8192, R, C); const int Rb = (R & ~31) + perm32(R & 31);
        voffA[i] = (unsigned)(R * lda + C) * 2u; voffB[i] = (unsigned)(Rb * ldb + C) * 2u; }
    const size_t kstep = (size_t)(BK * 2);
    const size_t hstepA = (size_t)HALF * lda * 2, hstepB = (size_t)HALF * ldb * 2;
    const unsigned ldsw = (unsigned)wid * 1024u;
    const int aoff = lds_byte(wr * 64 + fr, fq * 8), boff = lds_byte(wc * 32 + fr, fq * 8);
#define PG8_SA(b, h) (((b) * 2 + (h)) * HTB)
#define PG8_SB(b, h) ((4 + (b) * 2 + (h)) * HTB)
#define PG8_STAGE(bufoff, gbase, voff) do { _Pragma("unroll") for (int _i = 0; _i < 2; ++_i) \
        __builtin_amdgcn_global_load_lds((const unsigned*)((const char*)(gbase) + (voff)[_i]), (LAS unsigned*)(lds + (bufoff) + ldsw + _i * 8192), 16, 0, 0); } while (0)
#define PG8_LDA(dst, b, h) do { _Pragma("unroll") for (int m = 0; m < 4; ++m) _Pragma("unroll") for (int k = 0; k < 2; ++k) dst[m][k] = *(const LAS bf16x8*)(lds + PG8_SA(b, h) + aoff + m * 2048 + k * 1024); } while (0)
#define PG8_LDB(dst, b, h) do { _Pragma("unroll") for (int n = 0; n < 2; ++n) _Pragma("unroll") for (int k = 0; k < 2; ++k) dst[n][k] = *(const LAS bf16x8*)(lds + PG8_SB(b, h) + boff + n * 2048 + k * 1024); } while (0)
#define PG8_MMA(ai, bj, At, Bt) do { __builtin_amdgcn_s_setprio(1); _Pragma("unroll") for (int m = 0; m < 4; ++m) _Pragma("unroll") for (int n = 0; n < 2; ++n) _Pragma("unroll") for (int k = 0; k < 2; ++k) \
        acc[ai][bj][m][n] = __builtin_amdgcn_mfma_f32_16x16x32_bf16(Bt[n][k], At[m][k], acc[ai][bj][m][n], 0, 0, 0); __builtin_amdgcn_s_setprio(0); } while (0)
#define PG8_WAIT_V(n) asm volatile("s_waitcnt vmcnt(" #n ")" ::: "memory")
#define PG8_WAIT_L(n) asm volatile("s_waitcnt lgkmcnt(" #n ")" ::: "memory")
#define PG8_BAR __builtin_amdgcn_s_barrier()
#define PG8_SCHED __builtin_amdgcn_sched_barrier(0)
    Unit cur, nxt; int ui = 0;
    if (!S_.next(0, cur)) return;
    f32x4 acc[2][2][4][2];
#pragma unroll
    for (int a = 0; a < 2; ++a)
#pragma unroll
        for (int b = 0; b < 2; ++b)
#pragma unroll
            for (int m = 0; m < 4; ++m)
#pragma unroll
                for (int n = 0; n < 2; ++n) acc[a][b][m][n] = (f32x4){0.f, 0.f, 0.f, 0.f};
    bf16x8 At[4][2], B0[2][2], B1[2][2];
    const char* cA = cur.a; const char* cB = cur.b;
    PG8_STAGE(PG8_SB(0, 0), cB, voffB); PG8_STAGE(PG8_SB(0, 1), cB + hstepB, voffB); PG8_STAGE(PG8_SA(0, 0), cA, voffA); PG8_STAGE(PG8_SA(0, 1), cA + hstepA, voffA);
    if (wr == 1) PG8_BAR;
    PG8_WAIT_V(2); PG8_BAR;
    PG8_STAGE(PG8_SB(1, 0), cB + kstep, voffB); PG8_STAGE(PG8_SA(1, 0), cA + kstep, voffA); PG8_STAGE(PG8_SB(1, 1), cB + hstepB + kstep, voffB);
    PG8_WAIT_V(6); PG8_BAR;
    for (;;) {
        const bool has_next = S_.next(ui + 1, nxt);
        const char* nA = has_next ? nxt.a : cA; const char* nB = has_next ? nxt.b : cB;
        for (int t = 0; t < nt; t += 2) {
            const bool last = (t == nt - 2);
            const char* a1 = cA + (size_t)(t + 1) * kstep;
            const char* a2 = last ? nA : cA + (size_t)(t + 2) * kstep; const char* b2 = last ? nB : cB + (size_t)(t + 2) * kstep;
            const char* a3 = a2 + kstep; const char* b3 = b2 + kstep;
            PG8_LDB(B0, 0, 0); PG8_LDB(B1, 0, 1); PG8_SCHED; PG8_LDA(At, 0, 0); PG8_STAGE(PG8_SA(1, 1), a1 + hstepA, voffA);
            PG8_WAIT_V(8); PG8_WAIT_L(0); PG8_BAR; PG8_MMA(0, 0, At, B0); PG8_MMA(0, 1, At, B1); PG8_BAR; PG8_SCHED;
            PG8_LDA(At, 0, 1); PG8_STAGE(PG8_SB(0, 0), b2, voffB); PG8_STAGE(PG8_SB(0, 1), b2 + hstepB, voffB); PG8_STAGE(PG8_SA(0, 0), a2, voffA);
            PG8_WAIT_V(8); PG8_WAIT_L(0); PG8_BAR; PG8_MMA(1, 0, At, B0); PG8_MMA(1, 1, At, B1); PG8_BAR; PG8_SCHED;
            PG8_LDB(B0, 1, 0); PG8_LDB(B1, 1, 1); PG8_SCHED; PG8_LDA(At, 1, 0); PG8_STAGE(PG8_SA(0, 1), a2 + hstepA, voffA);
            PG8_WAIT_V(8); PG8_WAIT_L(0); PG8_BAR; PG8_MMA(0, 0, At, B0); PG8_MMA(0, 1, At, B1); PG8_BAR; PG8_SCHED;
            PG8_LDA(At, 1, 1); PG8_STAGE(PG8_SB(1, 0), b3, voffB); PG8_STAGE(PG8_SB(1, 1), b3 + hstepB, voffB); PG8_STAGE(PG8_SA(1, 0), a3, voffA);
            PG8_WAIT_V(8); PG8_WAIT_L(0); PG8_BAR; PG8_MMA(1, 0, At, B0); PG8_MMA(1, 1, At, B1); PG8_BAR; PG8_SCHED;
            if constexpr (Epi::HOOK) { if (((t + 2) & 7) == 0 && !last) { E.hook(acc, cur, (t + 2) >> 3, wr, wc, fr, fq); PG8_SCHED; } }
        }
        if (wr == 0) PG8_BAR;
        E(acc, cur, wr, wc, fr, fq);
        if (!has_next) break;
#pragma unroll
        for (int a = 0; a < 2; ++a)
#pragma unroll
            for (int b = 0; b < 2; ++b)
#pragma unroll
                for (int m = 0; m < 4; ++m)
#pragma unroll
                    for (int n = 0; n < 2; ++n) acc[a][b][m][n] = (f32x4){0.f, 0.f, 0.f, 0.f};
        cur = nxt; cA = nA; cB = nB; ++ui;
        if (wr == 1) PG8_BAR;
    }
    PG8_WAIT_V(0);
    PG8_BAR;
#undef PG8_SA
#undef PG8_SB
#undef PG8_STAGE
#undef PG8_LDA
#undef PG8_LDB
#undef PG8_MMA
#undef PG8_WAIT_V
#undef PG8_WAIT_L
#undef PG8_BAR
#undef PG8_SCHED
}
}

#define MFMA32(a, b, c) __builtin_amdgcn_mfma_f32_32x32x16_bf16((a), (b), (c), 0, 0, 0)
typedef short v4i16_t __attribute__((ext_vector_type(4)));
DI s16x4 vtr(const LAS unsigned char* p) { return __builtin_bit_cast(s16x4, __builtin_amdgcn_ds_read_tr16_b64_v4i16((LAS v4i16_t*)p)); }
constexpr float THR = 8.0f;

template <int DQK, int KP>
DI void qk_tile(f32x16& p0, f32x16& p1, const LAS unsigned char* kp, const bf16x8* qf) {
#pragma unroll
    for (int d0 = 0; d0 < DQK / 16; ++d0) {
        const bf16x8 a0 = *(const LAS bf16x8*)(kp + d0 * 32);
        const bf16x8 a1 = *(const LAS bf16x8*)(kp + 32 * KP + d0 * 32);
        p0 = MFMA32(a0, qf[d0], p0); p1 = MFMA32(a1, qf[d0], p1);
    }
}
template <int DV, int VP>
DI void softmax_pv(f32x16& p0, f32x16& p1, float& l, f32x16 (&o)[DV / 32], const LAS unsigned char* vp) {
    float s0 = 0.f, s1 = 0.f, s2 = 0.f, s3 = 0.f;
#pragma unroll
    for (int r = 0; r < 16; r += 4) {
        p0[r] = __builtin_amdgcn_exp2f(p0[r]); p0[r + 1] = __builtin_amdgcn_exp2f(p0[r + 1]); p0[r + 2] = __builtin_amdgcn_exp2f(p0[r + 2]); p0[r + 3] = __builtin_amdgcn_exp2f(p0[r + 3]);
        s0 += p0[r]; s1 += p0[r + 1]; s2 += p0[r + 2]; s3 += p0[r + 3];
    }
#pragma unroll
    for (int r = 0; r < 16; r += 4) {
        p1[r] = __builtin_amdgcn_exp2f(p1[r]); p1[r + 1] = __builtin_amdgcn_exp2f(p1[r + 1]); p1[r + 2] = __builtin_amdgcn_exp2f(p1[r + 2]); p1[r + 3] = __builtin_amdgcn_exp2f(p1[r + 3]);
        s0 += p1[r]; s1 += p1[r + 1]; s2 += p1[r + 2]; s3 += p1[r + 3];
    }
    l += (s0 + s1) + (s2 + s3);
    u32x4 pw[4];
    pw[0] = (u32x4){cvt_pk(p0[0], p0[1]), cvt_pk(p0[2], p0[3]), cvt_pk(p0[4], p0[5]), cvt_pk(p0[6], p0[7])};
    pw[1] = (u32x4){cvt_pk(p0[8], p0[9]), cvt_pk(p0[10], p0[11]), cvt_pk(p0[12], p0[13]), cvt_pk(p0[14], p0[15])};
    pw[2] = (u32x4){cvt_pk(p1[0], p1[1]), cvt_pk(p1[2], p1[3]), cvt_pk(p1[4], p1[5]), cvt_pk(p1[6], p1[7])};
    pw[3] = (u32x4){cvt_pk(p1[8], p1[9]), cvt_pk(p1[10], p1[11]), cvt_pk(p1[12], p1[13]), cvt_pk(p1[14], p1[15])};
#pragma unroll
    for (int d0 = 0; d0 < DV / 32; ++d0)
#pragma unroll
        for (int ks = 0; ks < 4; ++ks) {
            const s16x4 lo = vtr(vp + (16 * ks) * VP + d0 * 64);
            const s16x4 hh = vtr(vp + (16 * ks + 8) * VP + d0 * 64);
            const bf16x8 vf = (bf16x8){lo[0], lo[1], lo[2], lo[3], hh[0], hh[1], hh[2], hh[3]};
            o[d0] = MFMA32(vf, __builtin_bit_cast(bf16x8, pw[ks]), o[d0]);
        }
}

DI void exp_tile(f32x16& p0, f32x16& p1) {
#pragma unroll
    for (int r = 0; r < 16; ++r) p0[r] = __builtin_amdgcn_exp2f(p0[r]);
#pragma unroll
    for (int r = 0; r < 16; ++r) p1[r] = __builtin_amdgcn_exp2f(p1[r]);
}
DI void sum_pack(const f32x16& p0, const f32x16& p1, float& l, u32x4 (&pw)[4]) {
    float s0 = 0.f, s1 = 0.f, s2 = 0.f, s3 = 0.f;
#pragma unroll
    for (int r = 0; r < 16; r += 4) { s0 += p0[r]; s1 += p0[r + 1]; s2 += p0[r + 2]; s3 += p0[r + 3]; }
#pragma unroll
    for (int r = 0; r < 16; r += 4) { s0 += p1[r]; s1 += p1[r + 1]; s2 += p1[r + 2]; s3 += p1[r + 3]; }
    l += (s0 + s1) + (s2 + s3);
    pw[0] = (u32x4){cvt_pk(p0[0], p0[1]), cvt_pk(p0[2], p0[3]), cvt_pk(p0[4], p0[5]), cvt_pk(p0[6], p0[7])};
    pw[1] = (u32x4){cvt_pk(p0[8], p0[9]), cvt_pk(p0[10], p0[11]), cvt_pk(p0[12], p0[13]), cvt_pk(p0[14], p0[15])};
    pw[2] = (u32x4){cvt_pk(p1[0], p1[1]), cvt_pk(p1[2], p1[3]), cvt_pk(p1[4], p1[5]), cvt_pk(p1[6], p1[7])};
    pw[3] = (u32x4){cvt_pk(p1[8], p1[9]), cvt_pk(p1[10], p1[11]), cvt_pk(p1[12], p1[13]), cvt_pk(p1[14], p1[15])};
}
template <int DV, int VP>
DI void pv_tile(f32x16 (&o)[DV / 32], const u32x4 (&pw)[4], const LAS unsigned char* vp) {
#pragma unroll
    for (int kh = 0; kh < 2; ++kh) {
        bf16x8 vf[DV / 32][2];
#pragma unroll
        for (int d0 = 0; d0 < DV / 32; ++d0)
#pragma unroll
            for (int k2 = 0; k2 < 2; ++k2) { const int ks = 2 * kh + k2;
                const s16x4 lo = vtr(vp + (16 * ks) * VP + d0 * 64);
                const s16x4 hh = vtr(vp + (16 * ks + 8) * VP + d0 * 64);
                vf[d0][k2] = (bf16x8){lo[0], lo[1], lo[2], lo[3], hh[0], hh[1], hh[2], hh[3]}; }
#pragma unroll
        for (int k2 = 0; k2 < 2; ++k2)
#pragma unroll
            for (int d0 = 0; d0 < DV / 32; ++d0) o[d0] = MFMA32(vf[d0][k2], __builtin_bit_cast(bf16x8, pw[2 * kh + k2]), o[d0]);
    }
}

typedef __bf16 bf16x2_t __attribute__((ext_vector_type(2)));
DI float dot2_ones(unsigned packed, float c) { return __builtin_amdgcn_fdot2_f32_bf16(__builtin_bit_cast(bf16x2_t, packed), __builtin_bit_cast(bf16x2_t, 0x3f803f80u), c, false); }
DI void rowsum_pw(const u32x4 (&pw)[4], float (&ls)[4]) {
#pragma unroll
    for (int w = 0; w < 16; ++w) ls[w & 3] = dot2_ones(pw[w >> 2][w & 3], ls[w & 3]);
}
DI void pack_tile(const f32x16& p0, const f32x16& p1, u32x4 (&pw)[4]) {
    pw[0] = (u32x4){cvt_pk(p0[0], p0[1]), cvt_pk(p0[2], p0[3]), cvt_pk(p0[4], p0[5]), cvt_pk(p0[6], p0[7])};
    pw[1] = (u32x4){cvt_pk(p0[8], p0[9]), cvt_pk(p0[10], p0[11]), cvt_pk(p0[12], p0[13]), cvt_pk(p0[14], p0[15])};
    pw[2] = (u32x4){cvt_pk(p1[0], p1[1]), cvt_pk(p1[2], p1[3]), cvt_pk(p1[4], p1[5]), cvt_pk(p1[6], p1[7])};
    pw[3] = (u32x4){cvt_pk(p1[8], p1[9]), cvt_pk(p1[10], p1[11]), cvt_pk(p1[12], p1[13]), cvt_pk(p1[14], p1[15])};
}
template <int DQK, int KP, int DV, int VP, bool CONSTC, int KWIN = 8, bool ONES = false>
DI void tile_step(u32x4 (&pw)[4], f32x16& pn0, f32x16& pn1, const f32x16& cvec, float (&ls)[4], f32x16 (&o)[DV / 32], const bf16x8* qf,
                  const LAS unsigned char* kp, const LAS unsigned char* vp, f32x16* osum = nullptr, bf16x8 onesf = bf16x8{}) {
    constexpr int NKS = DQK / 16, NQK = 2 * NKS, ND0 = DV / 32, NPV = 4 * ND0, EPG = 32 / NPV, W = (DV > 64) ? 4 : 8;
#define SB_ __builtin_amdgcn_sched_barrier(0)
#define VFRAG(f) do { const int ks_ = (f) / ND0, d0_ = (f) % ND0; const s16x4 lo_ = vtr(vp + (16 * ks_) * VP + d0_ * 64); const s16x4 hh_ = vtr(vp + (16 * ks_ + 8) * VP + d0_ * 64); \
        vf[(f) % W] = (bf16x8){lo_[0], lo_[1], lo_[2], lo_[3], hh_[0], hh_[1], hh_[2], hh_[3]}; } while (0)
#define KFRAG(i) do { kf[(i) % KWIN] = *(const LAS bf16x8*)(kp + ((i) & 1) * 32 * KP + ((i) >> 1) * 32); } while (0)
#define PVAL(r) ((r) < 16 ? pn0[(r) & 15] : pn1[(r) & 15])
    bf16x8 kf[KWIN];
#pragma unroll
    for (int i = 0; i < KWIN; ++i) KFRAG(i);
    SB_;
    bf16x8 vf[W]; u32x4 pwn[4];
#pragma unroll
    for (int i = 0; i < NQK; ++i) {
        if (CONSTC && i < 2) { if (i == 0) pn0 = MFMA32(kf[0], qf[0], cvec); else pn1 = MFMA32(kf[1], qf[0], cvec); }
        else if ((i & 1) == 0) pn0 = MFMA32(kf[i % KWIN], qf[i >> 1], pn0); else pn1 = MFMA32(kf[i % KWIN], qf[i >> 1], pn1);
        if (i + KWIN < NQK) KFRAG(i + KWIN);
        if (i < W) VFRAG(i);
        if (!ONES && i < 8) { ls[(2 * i) & 3] = dot2_ones(pw[(2 * i) >> 2][(2 * i) & 3], ls[(2 * i) & 3]); ls[(2 * i + 1) & 3] = dot2_ones(pw[(2 * i + 1) >> 2][(2 * i + 1) & 3], ls[(2 * i + 1) & 3]); }
        SB_;
        if (ONES && (i & 1) && i < 8) { *osum = MFMA32(onesf, __builtin_bit_cast(bf16x8, pw[i >> 1]), *osum); SB_; }
    }
#pragma unroll
    for (int j = 0; j < NPV; ++j) {
        o[j % ND0] = MFMA32(vf[j % W], __builtin_bit_cast(bf16x8, pw[j / ND0]), o[j % ND0]);
        if (j + W < NPV) VFRAG(j + W);
#pragma unroll
        for (int e = 0; e < EPG; ++e) { const int r = j * EPG + e;
            if (r < 16) pn0[r] = __builtin_amdgcn_exp2f(pn0[r]); else pn1[r - 16] = __builtin_amdgcn_exp2f(pn1[r - 16]); }
        if (j > 0) {
#pragma unroll
            for (int e = 0; e < EPG; e += 2) { const int r = (j - 1) * EPG + e; pwn[(r >> 1) >> 2][(r >> 1) & 3] = cvt_pk(PVAL(r), PVAL(r + 1)); }
        }
        SB_;
    }
#pragma unroll
    for (int e = 0; e < EPG; e += 2) { const int r = (NPV - 1) * EPG + e; pwn[(r >> 1) >> 2][(r >> 1) & 3] = cvt_pk(PVAL(r), PVAL(r + 1)); }
#pragma unroll
    for (int k = 0; k < 4; ++k) pw[k] = pwn[k];
#undef PVAL
#undef KFRAG
#undef VFRAG
#undef SB_
}

template <int KW, int DQK, int DV, int MODE>
DI void attn_dense(LAS unsigned char* lds, const int tid, const bf16_t* Qw, int qpitch, const bf16_t* Kb, int kpitch, const bf16_t* Vb, int vpitch, int kco,
                   int qtok0, const LAS float* dtab, float nbound, int rot, f32x16 (&o)[DV / 32], float& l_out) {
    constexpr int KP = KW * 2 + 16, VP = DV * 2 + 64, KT = 64 * KP, VT = 64 * VP;
    constexpr int KCH = KW / 8, NKC = 64 * KCH, KPT = (NKC + 511) / 512, VCH = DV / 8, NVC = 64 * VCH, VPT = NVC / 512;
    const int lane = tid & 63, r32 = lane & 31, hi = lane >> 5;
    bf16x8 qf[DQK / 16];
#pragma unroll
    for (int d0 = 0; d0 < DQK / 16; ++d0) qf[d0] = *(const bf16x8*)(Qw + (size_t)r32 * qpitch + d0 * 16 + hi * 8);
    u32x4 kreg[KPT], vreg[VPT];
    unsigned kgo[KPT], klo[KPT], vgo[VPT], vlo[VPT];
#pragma unroll
    for (int i_ = 0; i_ < KPT; ++i_) { const int c_ = tid + i_ * 512; const int key_ = c_ / KCH, part_ = c_ % KCH; kgo[i_] = (unsigned)(key_ * kpitch + part_ * 8) * 2u; klo[i_] = (unsigned)(key_ * KP + part_ * 16); }
#pragma unroll
    for (int i_ = 0; i_ < VPT; ++i_) { const int c_ = tid + i_ * 512; const int key_ = c_ / VCH, part_ = c_ % VCH; vgo[i_] = (unsigned)(key_ * vpitch + part_ * 8) * 2u; vlo[i_] = (unsigned)(2 * KT + key_ * VP + part_ * 16); }
    const bool kact1 = (NKC % 512 == 0) || (tid + (KPT - 1) * 512 < NKC);
#define AD_TILE(t) (((t) + rot) & (S / 64 - 1))
#define AD_GLOAD_K(t) do { const char* kt_ = (const char*)Kb + (size_t)AD_TILE(t) * 64 * kpitch * 2; \
    _Pragma("unroll") for (int i_ = 0; i_ < KPT; ++i_) { if (MODE == 1) asm volatile("" : "+v"(kgo[i_])); if (i_ + 1 < KPT || kact1) kreg[i_] = *(const u32x4*)(kt_ + kgo[i_]); } } while (0)
#define AD_GLOAD_V(t) do { const char* vt_ = (const char*)Vb + (size_t)AD_TILE(t) * 64 * vpitch * 2; \
    _Pragma("unroll") for (int i_ = 0; i_ < VPT; ++i_) { if (MODE == 1) asm volatile("" : "+v"(vgo[i_])); vreg[i_] = *(const u32x4*)(vt_ + vgo[i_]); } } while (0)
#define AD_LSTORE_K(b) do { \
    _Pragma("unroll") for (int i_ = 0; i_ < KPT; ++i_) { if (i_ + 1 < KPT || kact1) *(LAS u32x4*)(lds + (b) * KT + klo[i_]) = kreg[i_]; } } while (0)
#define AD_LSTORE_V(b) do { \
    _Pragma("unroll") for (int i_ = 0; i_ < VPT; ++i_) *(LAS u32x4*)(lds + (b) * VT + vlo[i_]) = vreg[i_]; } while (0)
#define AD_CINIT(P0, P1, t) do { \
        if (MODE == 1) { \
            const int k0_ = AD_TILE(t) * 64, minrel_ = k0_ - (qtok0 + 31), maxrel_ = k0_ + 63 - qtok0; \
            if (minrel_ >= 559 || maxrel_ <= -559) { \
                const float c_ = (minrel_ >= 559 ? dtab[2046] : dtab[0]); \
                _Pragma("unroll") for (int r = 0; r < 16; ++r) { P0[r] = c_; P1[r] = c_; } \
            } else { \
                const LAS float* tp_ = dtab + (k0_ - qtok0 - r32 + 4 * hi + 1023); \
                _Pragma("unroll") for (int r = 0; r < 16; ++r) { P0[r] = tp_[(r & 3) + 8 * (r >> 2)]; P1[r] = tp_[32 + (r & 3) + 8 * (r >> 2)]; } \
            } \
        } else { \
            _Pragma("unroll") for (int r = 0; r < 16; ++r) { P0[r] = nbound; P1[r] = nbound; } \
        } } while (0)
    float l = 0.f;
#pragma unroll
    for (int d0 = 0; d0 < DV / 32; ++d0)
#pragma unroll
        for (int r = 0; r < 16; ++r) o[d0][r] = 0.f;
    constexpr int NT = S / 64;
    const int koff = r32 * KP + (kco + hi * 8) * 2;
    const int voff = 2 * KT + (4 * hi + ((lane & 15) >> 2)) * VP + (((lane >> 4) & 1) * 16 + (lane & 3) * 4) * 2;
    AD_GLOAD_K(0); AD_LSTORE_K(0);
    __syncthreads();
    AD_GLOAD_K(1); AD_GLOAD_V(0);
    u32x4 pw[4];
    { f32x16 pc0, pc1;
      AD_CINIT(pc0, pc1, 0);
      qk_tile<DQK, KP>(pc0, pc1, lds + koff, qf);
      exp_tile(pc0, pc1);
      pack_tile(pc0, pc1, pw); }
    AD_LSTORE_K(1); AD_LSTORE_V(0);
    __syncthreads();
    float ls[4] = {0.f, 0.f, 0.f, 0.f};
    f32x16 osum;
#pragma unroll
    for (int r = 0; r < 16; ++r) osum[r] = 0.f;
    bf16x8 onesf;
#pragma unroll
    for (int j = 0; j < 8; ++j) onesf[j] = (r32 == 0) ? (short)0x3f80 : (short)0;
    f32x16 cvec;
#pragma unroll
    for (int r = 0; r < 16; ++r) cvec[r] = nbound;
    asm volatile("" : "+v"(cvec));
#define AD_STEP(CONSTC_, INIT_) do { \
        const int tn = (t + 1 < NT) ? t + 1 : NT - 1;         \
        AD_GLOAD_K(tn); \
        AD_GLOAD_V(t); \
        f32x16 pn0, pn1; \
        INIT_; \
        __builtin_amdgcn_sched_barrier(0); \
        tile_step<DQK, KP, DV, VP, CONSTC_, 4, MODE == 0>(pw, pn0, pn1, cvec, ls, o, qf, lds + (t & 1) * KT + koff, lds + ((t - 1) & 1) * VT + voff, &osum, onesf); \
        AD_LSTORE_K((t + 1) & 1); \
        AD_LSTORE_V(t & 1); \
        __syncthreads(); } while (0)
    if (MODE == 1) {
        int t1 = (qtok0 - 622 >= 0) ? (qtok0 - 622) / 64 + 1 : 0; t1 = t1 < 1 ? 1 : (t1 > NT ? NT : t1);
        int t2 = (qtok0 + 590 + 63) / 64; t2 = t2 < t1 ? t1 : (t2 > NT ? NT : t2);
        int t = 1;
        { const float c_ = dtab[0];
#pragma unroll
          for (int r = 0; r < 16; ++r) cvec[r] = c_;
          asm volatile("" : "+v"(cvec)); }
        for (; t < t1; ++t) AD_STEP(true, (void)0);
        for (; t < t2; ++t) AD_STEP(false, AD_CINIT(pn0, pn1, t));
        { const float c_ = dtab[2046];
#pragma unroll
          for (int r = 0; r < 16; ++r) cvec[r] = c_;
          asm volatile("" : "+v"(cvec)); }
        for (; t < NT; ++t) AD_STEP(true, (void)0);
    } else {
        for (int t = 1; t < NT; ++t) AD_STEP(true, (void)0);
    }
#undef AD_STEP
    rowsum_pw(pw, ls);
    pv_tile<DV, VP>(o, pw, lds + ((NT - 1) & 1) * VT + voff);
    l = (ls[0] + ls[1]) + (ls[2] + ls[3]);
    __syncthreads();
#undef AD_GLOAD_K
#undef AD_TILE
#undef AD_GLOAD_V
#undef AD_LSTORE_K
#undef AD_LSTORE_V
#undef AD_CINIT
    l += shx(l, 32, lane);
    if (MODE == 0) l += __int_as_float(__builtin_amdgcn_ds_bpermute((lane & 31) << 2, __float_as_int(osum[0])));
    l_out = l;
}

template <int KW, int DQK, int DV>
DI void attn_dense_pair(LAS unsigned char* lds, const int tid, const bf16_t* Qw, int qpitch, const bf16_t* Kb, int kpitch, const bf16_t* Vb, int vpitch,
                        float nbound, f32x16 (&o)[DV / 32], float& l_out) {
    constexpr int KP = KW * 2 + 16, VP = DV * 2 + 64, KT = 64 * KP, VT = 64 * VP;
    constexpr int KCH = KW / 8, NKC = 64 * KCH, KPT = (NKC + 511) / 512, VCH = DV / 8, NVC = 64 * VCH, VPT = NVC / 512;
    const int lane = tid & 63, r32 = lane & 31, hi = lane >> 5;
    bf16x8 qf[DQK / 16];
#pragma unroll
    for (int d0 = 0; d0 < DQK / 16; ++d0) qf[d0] = *(const bf16x8*)(Qw + (size_t)r32 * qpitch + d0 * 16 + hi * 8);
    u32x4 kreg[2][KPT], vreg[2][VPT];
    unsigned kgo[KPT], klo[KPT], vgo[VPT], vlo[VPT];
#pragma unroll
    for (int i_ = 0; i_ < KPT; ++i_) { const int c_ = tid + i_ * 512; const int key_ = c_ / KCH, part_ = c_ % KCH; kgo[i_] = (unsigned)(key_ * kpitch + part_ * 8) * 2u; klo[i_] = (unsigned)(key_ * KP + part_ * 16); }
#pragma unroll
    for (int i_ = 0; i_ < VPT; ++i_) { const int c_ = tid + i_ * 512; const int key_ = c_ / VCH, part_ = c_ % VCH; vgo[i_] = (unsigned)(key_ * vpitch + part_ * 8) * 2u; vlo[i_] = (unsigned)(4 * KT + key_ * VP + part_ * 16); }
    const bool kact1 = (NKC % 512 == 0) || (tid + (KPT - 1) * 512 < NKC);
    constexpr int NT = S / 64;
#define AP_CL(t) ((t) < NT ? (t) : NT - 1)
#define AP_GLOAD_K(j, t) do { const char* kt_ = (const char*)Kb + (size_t)AP_CL(t) * 64 * kpitch * 2; \
    _Pragma("unroll") for (int i_ = 0; i_ < KPT; ++i_) { if (i_ + 1 < KPT || kact1) kreg[j][i_] = *(const u32x4*)(kt_ + kgo[i_]); } } while (0)
#define AP_GLOAD_V(j, t) do { const char* vt_ = (const char*)Vb + (size_t)AP_CL(t) * 64 * vpitch * 2; \
    _Pragma("unroll") for (int i_ = 0; i_ < VPT; ++i_) vreg[j][i_] = *(const u32x4*)(vt_ + vgo[i_]); } while (0)
#define AP_LSTORE_K(j, t) do { \
    _Pragma("unroll") for (int i_ = 0; i_ < KPT; ++i_) { if (i_ + 1 < KPT || kact1) *(LAS u32x4*)(lds + ((t) & 3) * KT + klo[i_]) = kreg[j][i_]; } } while (0)
#define AP_LSTORE_V(j, t) do { \
    _Pragma("unroll") for (int i_ = 0; i_ < VPT; ++i_) *(LAS u32x4*)(lds + ((t) & 3) * VT + vlo[i_]) = vreg[j][i_]; } while (0)
#pragma unroll
    for (int d0 = 0; d0 < DV / 32; ++d0)
#pragma unroll
        for (int r = 0; r < 16; ++r) o[d0][r] = 0.f;
    const int koff = r32 * KP + hi * 16;
    const int voff = 4 * KT + (4 * hi + ((lane & 15) >> 2)) * VP + (((lane >> 4) & 1) * 16 + (lane & 3) * 4) * 2;
    AP_GLOAD_K(0, 0); AP_LSTORE_K(0, 0);
    __syncthreads();
    AP_GLOAD_K(0, 1); AP_GLOAD_K(1, 2); AP_GLOAD_V(0, 0); AP_GLOAD_V(1, 1);
    u32x4 pw[4];
    { f32x16 pc0, pc1;
#pragma unroll
      for (int r = 0; r < 16; ++r) { pc0[r] = nbound; pc1[r] = nbound; }
      qk_tile<DQK, KP>(pc0, pc1, lds + koff, qf);
      exp_tile(pc0, pc1);
      pack_tile(pc0, pc1, pw); }
    AP_LSTORE_K(0, 1); AP_LSTORE_K(1, 2); AP_LSTORE_V(0, 0); AP_LSTORE_V(1, 1);
    __syncthreads();
    float ls[4] = {0.f, 0.f, 0.f, 0.f};
    f32x16 osum;
#pragma unroll
    for (int r = 0; r < 16; ++r) osum[r] = 0.f;
    bf16x8 onesf;
#pragma unroll
    for (int j = 0; j < 8; ++j) onesf[j] = (r32 == 0) ? (short)0x3f80 : (short)0;
    f32x16 cvec;
#pragma unroll
    for (int r = 0; r < 16; ++r) cvec[r] = nbound;
    asm volatile("" : "+v"(cvec));
    for (int t = 1; t + 1 < NT; t += 2) {
        AP_GLOAD_K(0, t + 2); AP_GLOAD_K(1, t + 3); AP_GLOAD_V(0, t + 1); AP_GLOAD_V(1, t + 2);
        f32x16 pn0, pn1;
        __builtin_amdgcn_sched_barrier(0);
        tile_step<DQK, KP, DV, VP, true, 4, true>(pw, pn0, pn1, cvec, ls, o, qf, lds + (t & 3) * KT + koff, lds + ((t - 1) & 3) * VT + voff, &osum, onesf);
        __builtin_amdgcn_sched_barrier(0);
        tile_step<DQK, KP, DV, VP, true, 4, true>(pw, pn0, pn1, cvec, ls, o, qf, lds + ((t + 1) & 3) * KT + koff, lds + (t & 3) * VT + voff, &osum, onesf);
        AP_LSTORE_K(0, t + 2); AP_LSTORE_K(1, t + 3); AP_LSTORE_V(0, t + 1); AP_LSTORE_V(1, t + 2);
        __syncthreads();
    }
    { f32x16 pn0, pn1;
      tile_step<DQK, KP, DV, VP, true, 4, true>(pw, pn0, pn1, cvec, ls, o, qf, lds + ((NT - 1) & 3) * KT + koff, lds + ((NT - 2) & 3) * VT + voff, &osum, onesf); }
    rowsum_pw(pw, ls);
    pv_tile<DV, VP>(o, pw, lds + ((NT - 1) & 3) * VT + voff);
    float l = (ls[0] + ls[1]) + (ls[2] + ls[3]);
    __syncthreads();
#undef AP_CL
#undef AP_GLOAD_K
#undef AP_GLOAD_V
#undef AP_LSTORE_K
#undef AP_LSTORE_V
    l += shx(l, 32, lane);
    l += __int_as_float(__builtin_amdgcn_ds_bpermute((lane & 31) << 2, __float_as_int(osum[0])));
    l_out = l;
}

DI float uni(float v) { return __int_as_float(__builtin_amdgcn_readfirstlane(__float_as_int(v))); }
DI float wave_absmax(const float* w, int n, int lane) {
    float m = 0.f;
    for (int i = lane; i < n; i += 64) m = fmaxf(m, fabsf(w[i]));
#pragma unroll
    for (int o = 1; o < 64; o <<= 1) m = fmaxf(m, shx(m, o, lane));
    return m;
}

DI void store_y64(const f32x16 (&o)[2], float linv, bf16_t* Y, const bf16_t* proj, int token, int ycol, int hi) {
#pragma unroll
    for (int d0 = 0; d0 < 2; ++d0)
#pragma unroll
        for (int g = 0; g < 4; ++g) {
            const int col = ycol + 32 * d0 + 8 * g + 4 * hi;
            const u32x2 gv = *(const u32x2*)(proj + (size_t)token * LDP + C_SILU + col);
            u32x2 w;
            w.x = cvt_pk(o[d0][4 * g + 0] * linv * bflo(gv.x), o[d0][4 * g + 1] * linv * bfhi(gv.x));
            w.y = cvt_pk(o[d0][4 * g + 2] * linv * bflo(gv.y), o[d0][4 * g + 3] * linv * bfhi(gv.y));
            *(u32x2*)(Y + (size_t)token * DM + col) = w;
        }
}

struct Params {
    const float* x; const float* norm_w; const float* w_in; const float* mla_q_norm; const float* mla_kv_norm; const float* mla_w_uq; const float* mla_w_ukv;
    const float* mla_qk_norm; const float* gqa_qk_norm; const float* dil_qk_norm; const float* diff_qk_norm; const float* diff_lambda; const float* diff_subnorm;
    const float* rel_bias; const float* w_branch; const float* w_out; float* out; unsigned char* ws;
};

DI float wave_sum(float v, int lane) {
#pragma unroll
    for (int o = 1; o < 64; o <<= 1) v += shx(v, o, lane);
    return v;
}
DI unsigned f2bf(float f) { unsigned u = __float_as_uint(f); return (u + 0x7fffu + ((u >> 16) & 1u)) >> 16; }
DI unsigned pk2(float lo, float hi) { return cvt_pk(lo, hi); }

DI void transpose_item(const float* W, int K, int N, bf16_t* WT, int ldk, const float* ksc, LAS float* scr, int item, int lane) {
    const int nblk = N / 32, kb = item / nblk, nb = item % nblk, k0 = 64 * kb, n0 = 32 * nb;
    { f32x4 v[8]; const int n4 = (lane & 7) * 4, kr = lane >> 3;
#pragma unroll
      for (int i = 0; i < 8; ++i) v[i] = *(const f32x4*)(W + (size_t)(k0 + 8 * i + kr) * N + n0 + n4);
#pragma unroll
      for (int i = 0; i < 8; ++i) { LAS float* d = scr + (8 * i + kr) * 33 + n4; d[0] = v[i].x; d[1] = v[i].y; d[2] = v[i].z; d[3] = v[i].w; } }
    const int c = lane & 7;
    f32x4 sc0 = (f32x4){1.f, 1.f, 1.f, 1.f}, sc1 = sc0;
    if (ksc) { sc0 = *(const f32x4*)(ksc + k0 + 8 * c); sc1 = *(const f32x4*)(ksc + k0 + 8 * c + 4); }
    asm volatile("s_waitcnt lgkmcnt(0)" ::: "memory");
#pragma unroll
    for (int j = 0; j < 4; ++j) { const int n = (lane >> 3) + 8 * j; const LAS float* s = scr + (8 * c) * 33 + n;
        u32x4 o; o.x = pk2(s[0 * 33] * sc0.x, s[1 * 33] * sc0.y); o.y = pk2(s[2 * 33] * sc0.z, s[3 * 33] * sc0.w); o.z = pk2(s[4 * 33] * sc1.x, s[5 * 33] * sc1.y); o.w = pk2(s[6 * 33] * sc1.z, s[7 * 33] * sc1.w);
        *(u32x4*)(WT + (size_t)(n0 + n) * ldk + k0 + 8 * c) = o; }
    asm volatile("s_waitcnt lgkmcnt(0)" ::: "memory");
}

DI void transpose_item_in(const float* W, bf16_t* WT, const float* ksc, LAS float* scr, int item, int lane) {
    constexpr int nblk = LDP / 32;
    const int kb = item / nblk, nb = item % nblk, k0 = 64 * kb, n0 = 32 * nb;
    { f32x4 v[8]; const int n4 = (lane & 7) * 4, kr = lane >> 3; const int sc = in_src_col(n0 + n4);
#pragma unroll
      for (int i = 0; i < 8; ++i) v[i] = sc >= 0 ? *(const f32x4*)(W + (size_t)(k0 + 8 * i + kr) * NIN + sc) : (f32x4){0.f, 0.f, 0.f, 0.f};
#pragma unroll
      for (int i = 0; i < 8; ++i) { LAS float* d = scr + (8 * i + kr) * 33 + n4; d[0] = v[i].x; d[1] = v[i].y; d[2] = v[i].z; d[3] = v[i].w; } }
    const int c = lane & 7;
    const f32x4 sc0 = *(const f32x4*)(ksc + k0 + 8 * c), sc1 = *(const f32x4*)(ksc + k0 + 8 * c + 4);
    asm volatile("s_waitcnt lgkmcnt(0)" ::: "memory");
#pragma unroll
    for (int j = 0; j < 4; ++j) { const int n = (lane >> 3) + 8 * j; const LAS float* s = scr + (8 * c) * 33 + n;
        u32x4 o; o.x = pk2(s[0 * 33] * sc0.x, s[1 * 33] * sc0.y); o.y = pk2(s[2 * 33] * sc0.z, s[3 * 33] * sc0.w); o.z = pk2(s[4 * 33] * sc1.x, s[5 * 33] * sc1.y); o.w = pk2(s[6 * 33] * sc1.z, s[7 * 33] * sc1.w);
        *(u32x4*)(WT + (size_t)(n0 + n) * DM + k0 + 8 * c) = o; }
    asm volatile("s_waitcnt lgkmcnt(0)" ::: "memory");
}

DI int rel_bucket(int rel) {
    const int side = rel > 0 ? 16 : 0; const int n = rel < 0 ? -rel : rel;
    const float nf = (float)(n > 1 ? n : 1);
    int large = 8 + (int)(logf(nf / 8.0f) / logf(128.0f) * 8.0f);
    large = large < 15 ? large : 15;
    return side + (n < 8 ? n : large);
}


#define XB_TMO      128
#define XB_XCNT(j)  (256  + 64 * (j))
#define XB_XSUB(j)  (1280 + 64 * (j))
#define XB_XGEN(j)  (2304 + 64 * (j))
#define XB_TOP      3328
#define XB_TOPGEN   3392
#define XCD_BAR_WORDS 3456
#define XB_SPIN_CAP (1u << 22)
DI unsigned xb_ld(unsigned* p)              { return __hip_atomic_load(p, __ATOMIC_RELAXED, __HIP_MEMORY_SCOPE_AGENT); }
DI unsigned xb_add(unsigned* p, unsigned v) { return __hip_atomic_fetch_add(p, v, __ATOMIC_RELAXED, __HIP_MEMORY_SCOPE_AGENT); }
DI unsigned xb_xcc_id() { return (unsigned)__builtin_amdgcn_s_getreg((3 << 11) | 20) & 0xFu; }
#define XB_SPIN(cond, bar) do { unsigned _sp = 0; while (cond) { __builtin_amdgcn_s_sleep(1); \
    if ((++_sp & 255u) == 0u) { if (xb_ld(&(bar)[XB_TMO])) break; if (_sp > XB_SPIN_CAP) { atomicAdd(&(bar)[XB_TMO], 1u); break; } } } } while (0)
DI void xcd_barrier_complete(unsigned* bar, unsigned x, unsigned& nloc, unsigned& nx) {
    const unsigned G = gridDim.x * gridDim.y * gridDim.z;
    unsigned sum, cnt, mine, sp = 0u;
    for (;;) {
        sum = 0u; cnt = 0u; mine = 0u;
#pragma unroll
        for (unsigned j = 0; j < 16; ++j) { const unsigned c = xb_ld(&bar[XB_XCNT(j)]); sum += c; cnt += (c > 0u) ? 1u : 0u; mine = (j == x) ? c : mine; }
        if (sum == G) break;
        __builtin_amdgcn_s_sleep(1);
        if ((++sp & 255u) == 0u) { if (xb_ld(&bar[XB_TMO])) break; if (sp > XB_SPIN_CAP) { atomicAdd(&bar[XB_TMO], 1u); break; } }
    }
    nloc = mine > 0u ? mine : 1u; nx = cnt > 0u ? cnt : 1u;
}
DI void xcd_barrier(unsigned* bar, volatile LAS unsigned* st, int wid0) {
    asm volatile("s_waitcnt vmcnt(0)" ::: "memory");
    __syncthreads();
    if (wid0 == 0 && __builtin_amdgcn_mbcnt_hi(~0u, __builtin_amdgcn_mbcnt_lo(~0u, 0u)) == 0u) {
        const unsigned x = xb_xcc_id();
        __builtin_amdgcn_s_waitcnt(0);
        unsigned nloc = st[0], nx = st[1];
        if (nloc == 0u) { xcd_barrier_complete(bar, x, nloc, nx); st[0] = nloc; st[1] = nx; }
        const unsigned old = xb_add(&bar[XB_XSUB(x)], 1u);
        const unsigned gen = old / nloc;
        if (old + 1u == (gen + 1u) * nloc) {
            __builtin_amdgcn_fence(__ATOMIC_RELEASE, "agent");
            asm volatile("s_waitcnt vmcnt(0)" ::: "memory");
            const unsigned og = xb_add(&bar[XB_TOP], 1u);
            const unsigned tg = og / nx;
            if (og + 1u == (tg + 1u) * nx) xb_add(&bar[XB_TOPGEN], 1u);
            else XB_SPIN(xb_ld(&bar[XB_TOPGEN]) == tg, bar);
            __builtin_amdgcn_fence(__ATOMIC_ACQUIRE, "agent");
            xb_add(&bar[XB_XGEN(x)], 1u);
            asm volatile("s_waitcnt vmcnt(0)" ::: "memory");
        } else {
            XB_SPIN(xb_ld(&bar[XB_XGEN(x)]) == gen, bar);
            __builtin_amdgcn_fence(__ATOMIC_ACQUIRE, "agent");
            asm volatile("s_waitcnt vmcnt(0)" ::: "memory");
        }
    }
    __syncthreads();
}

DI void xcd_arrive(unsigned* bar, volatile LAS unsigned* st, int wid0) {
    asm volatile("s_waitcnt vmcnt(0)" ::: "memory");
    __syncthreads();
    if (wid0 == 0 && __builtin_amdgcn_mbcnt_hi(~0u, __builtin_amdgcn_mbcnt_lo(~0u, 0u)) == 0u) {
        const unsigned x = xb_xcc_id();
        __builtin_amdgcn_s_waitcnt(0);
        const unsigned nloc = st[0], nx = st[1];
        const unsigned old = xb_add(&bar[XB_XSUB(x)], 1u);
        const unsigned gen = old / nloc;
        if (old + 1u == (gen + 1u) * nloc) {
            __builtin_amdgcn_fence(__ATOMIC_RELEASE, "agent");
            asm volatile("s_waitcnt vmcnt(0)" ::: "memory");
            const unsigned og = xb_add(&bar[XB_TOP], 1u);
            const unsigned tg = og / nx;
            if (og + 1u == (tg + 1u) * nx) xb_add(&bar[XB_TOPGEN], 1u);
        }
    }
}
DI void xcd_wait(unsigned* bar, unsigned target, int wid0) {
    if (wid0 == 0 && __builtin_amdgcn_mbcnt_hi(~0u, __builtin_amdgcn_mbcnt_lo(~0u, 0u)) == 0u) {
        XB_SPIN(xb_ld(&bar[XB_TOPGEN]) < target, bar);
        __builtin_amdgcn_fence(__ATOMIC_ACQUIRE, "agent");
        asm volatile("s_waitcnt vmcnt(0)" ::: "memory");
    }
    __syncthreads();
}

__global__ void __launch_bounds__(512) mega(Params P) {
    extern __shared__ __attribute__((aligned(16))) unsigned char lds_raw[];
    LAS unsigned char* lds = (LAS unsigned char*)lds_raw;
    cg::grid_group grid = cg::this_grid();
    volatile LAS unsigned* bst = (volatile LAS unsigned*)(lds + LDS_BYTES - 16);
    unsigned* barw = (unsigned*)(P.ws + WS_BAR);
    if (threadIdx.x == 0) { bst[0] = 0u; bst[1] = 0u; }
    if (blockIdx.x == 0) for (int i = threadIdx.x; i < 2 * XCD_BAR_WORDS; i += 512) __hip_atomic_store(&barw[i], 0u, __ATOMIC_RELAXED, __HIP_MEMORY_SCOPE_AGENT);
    __syncthreads();
#define GRID_SYNC() xcd_barrier(barw, bst, wid0)
#define XCD_ARRIVE() xcd_arrive(barw + XCD_BAR_WORDS, bst, wid0)
#define XCD_WAIT(g) xcd_wait(barw + XCD_BAR_WORDS, (unsigned)(g), wid0)
    const int wid0 = __builtin_amdgcn_readfirstlane((int)threadIdx.x >> 6);
#define RELANE(x) int x = (int)__builtin_amdgcn_mbcnt_hi(~0u, __builtin_amdgcn_mbcnt_lo(~0u, 0u)); asm volatile("" : "+v"(x));
#define PHASE_BEGIN \
    int wid = wid0; asm volatile("" : "+s"(wid)); \
    int lane = (int)__builtin_amdgcn_mbcnt_hi(~0u, __builtin_amdgcn_mbcnt_lo(~0u, 0u)); asm volatile("" : "+v"(lane)); \
    const int tid = wid * 64 + lane; \
    int bx = blockIdx.x; asm volatile("" : "+s"(bx)); \
    const int G = gridDim.x; \
    const int gw = bx * 8 + wid, NGW = G * 8, gt = bx * 512 + tid, NGT = G * 512; \
    const int vcu = (G % 8 == 0) ? (bx % 8) * (G / 8) + bx / 8 : bx; \
    size_t wsz_ = 0; asm volatile("" : "+s"(wsz_)); unsigned char* ws = P.ws + wsz_; \
    bf16_t* WinT = (bf16_t*)(ws + WS_WIN); bf16_t* WbT = (bf16_t*)(ws + WS_WB); bf16_t* WoT = (bf16_t*)(ws + WS_WO); \
    bf16_t* WuqT = (bf16_t*)(ws + WS_WUQ); bf16_t* WukvT = (bf16_t*)(ws + WS_WUKV); \
    float* cosT = (float*)(ws + WS_COS); float* sinT = (float*)(ws + WS_SIN); float* dtabG = (float*)(ws + WS_DTAB); float* ctabG = (float*)(ws + WS_CTAB); \
    bf16_t* Hb = (bf16_t*)(ws + WS_H); bf16_t* proj = (bf16_t*)(ws + WS_PROJ); bf16_t* qup = (bf16_t*)(ws + WS_QUP); bf16_t* kvup = (bf16_t*)(ws + WS_KVUP); \
    bf16_t* Qa = (bf16_t*)(ws + WS_QA); bf16_t* Ka = (bf16_t*)(ws + WS_KA); bf16_t* Va = (bf16_t*)(ws + WS_VA); \
    bf16_t* Qb = (bf16_t*)(ws + WS_QB); bf16_t* Kb = (bf16_t*)(ws + WS_KB); bf16_t* Qc = (bf16_t*)(ws + WS_QC); bf16_t* Kc = (bf16_t*)(ws + WS_KC); \
    bf16_t* Qd = (bf16_t*)(ws + WS_QD); bf16_t* Kd = (bf16_t*)(ws + WS_KD); bf16_t* Yb = (bf16_t*)(ws + WS_Y); \
    float* mixF = (float*)(ws + WS_MIXF); bf16_t* mixB = (bf16_t*)(ws + WS_MIXB); \
    (void)lane; (void)gw; (void)NGW; (void)gt; (void)NGT; (void)vcu; (void)WinT; (void)WbT; (void)WoT; (void)WuqT; (void)WukvT; (void)cosT; (void)sinT; (void)dtabG; (void)ctabG; \
    (void)Hb; (void)proj; (void)qup; (void)kvup; (void)Qa; (void)Ka; (void)Va; (void)Qb; (void)Kb; (void)Qc; (void)Kc; (void)Qd; (void)Kd; (void)Yb; (void)mixF; (void)mixB;

        for (int rep_ = 0; rep_ < ((REP_MASK >> 0) & 1) + 1; ++rep_) {
    {
        PHASE_BEGIN
        LAS float* scr = (LAS float*)(lds + wid * 16384);
        constexpr int I_IN = (DM / 64) * (LDP / 32), I_BR = (512 / 64) * (DM / 32), I_O = (DM / 64) * (DM / 32), I_UQ = (384 / 64) * (768 / 32), I_UKV = (128 / 64) * (1024 / 32);
        constexpr int PER_L = I_IN + 4 * I_BR + I_O + I_UQ + I_UKV;
        for (int it = gw; it < DEPTH * PER_L; it += NGW) {
            const int l = it / PER_L; int r = it % PER_L;
            if (r < I_IN) { transpose_item_in(P.w_in + (size_t)l * DM * NIN, WinT + (size_t)l * LDP * DM, P.norm_w + l * DM, scr, r, lane); continue; } r -= I_IN;
            if (r < 4 * I_BR) { const int n = r / I_BR; transpose_item(P.w_branch + ((size_t)l * 4 + n) * 512 * DM, 512, DM, WbT + (size_t)l * DM * DM + n * 512, DM, nullptr, scr, r % I_BR, lane); continue; } r -= 4 * I_BR;
            if (r < I_O) { transpose_item(P.w_out + (size_t)l * DM * DM, DM, DM, WoT + (size_t)l * DM * DM, DM, nullptr, scr, r, lane); continue; } r -= I_O;
            if (r < I_UQ) { transpose_item(P.mla_w_uq + (size_t)l * 384 * 768, 384, 768, WuqT + (size_t)l * 768 * 384, 384, P.mla_q_norm + l * 384, scr, r, lane); continue; } r -= I_UQ;
            transpose_item(P.mla_w_ukv + (size_t)l * 128 * 1024, 128, 1024, WukvT + (size_t)l * 1024 * 256, 256, P.mla_kv_norm + l * 128, scr, r, lane);
        }
        for (int i = gt; i < DEPTH * 1024 * 16; i += NGT) { const int row = i / 16, c = i % 16;
            *(u32x4*)(WukvT + (size_t)row * 256 + 128 + c * 8) = (u32x4){0u, 0u, 0u, 0u}; }
        { float* ssq = (float*)(ws + WS_SSQ);
          for (int i = gt; i < 4 * S; i += NGT) ssq[S + i] = 0.f;
          for (int row = gw; row < S; row += NGW) {
              const f32x4* xr = (const f32x4*)(P.x + (size_t)row * DM) + lane;
              u32x2* o8 = (u32x2*)(Hb + (size_t)row * DM) + lane; float ss = 0.f;
#pragma unroll
              for (int j = 0; j < 8; ++j) { const f32x4 v = xr[64 * j]; ss += (v.x * v.x + v.y * v.y) + (v.z * v.z + v.w * v.w);
                  u32x2 o; o.x = cvt_pk(v.x, v.y); o.y = cvt_pk(v.z, v.w); o8[64 * j] = o; }
              ss = wave_sum(ss, lane);
              if (lane == 0) ssq[row] = ss;
          } }
        for (int i = gt; i < S * 16; i += NGT) { const int pos = i >> 4, fi = i & 15;
            const float inv = powf(10000.0f, -(float)(2 * fi) / 32.0f);
            const float ang = (float)pos * inv;
            const double rev = (double)ang * 0.15915494309189535; const float fr = (float)(rev - rint(rev));
            cosT[i] = __builtin_amdgcn_cosf(fr); sinT[i] = __builtin_amdgcn_sinf(fr); }
        for (int i = gt; i < 4 * 2048; i += NGT) { const int h = i >> 11, k = i & 2047; const int rel = k - 1023;
            dtabG[i] = (k < 2047) ? P.rel_bias[rel_bucket(rel) * 28 + 24 + h] * LOG2E : 0.f; }
        for (int i = gt; i < 24 * 132; i += NGT) { const int gh = i / 132, j = i % 132; const int g = gh >> 3; const int dil = 1 << (2 * g);
            ctabG[i] = (j < 129) ? P.rel_bias[rel_bucket((j - 64) * dil) * 28 + gh] * LOG2E : 0.f; }
    }
    grid.sync();
    if (wid0 == 0 && __builtin_amdgcn_mbcnt_hi(~0u, __builtin_amdgcn_mbcnt_lo(~0u, 0u)) == 0u) (void)xb_add(&barw[XB_XCNT(xb_xcc_id())], 1u);
        }

    for (int l = 0; l < DEPTH; ++l) {
        for (int rep_ = 0; rep_ < ((REP_MASK >> 2) & 1) + 1; ++rep_) {
        {
            PHASE_BEGIN
            pg8::SchedGrid sc{(const char*)Hb, (const char*)(WinT + (size_t)l * LDP * DM), S / 256, LDP / 256, G, bx, (size_t)256 * DM * 2, (size_t)256 * DM * 2};
            pg8::EpiProj ep{proj, (const float*)(ws + WS_SSQ) + (size_t)l * S, P.gqa_qk_norm + l * 128, P.dil_qk_norm + l * 384, P.diff_qk_norm + l * 128, cosT, sinT, Qb, Kb, Qc, Kc, Qd, Kd};
            pg8::gemm_phase(lds, tid, DM, DM, DM, sc, ep);
        }
        GRID_SYNC();
        }
        {
            PHASE_BEGIN
            { pg8::SchedGrid sc{(const char*)(proj + C_ACQ), (const char*)(WuqT + (size_t)l * 768 * 384), S / 256, 3, G, bx, (size_t)256 * LDP * 2, (size_t)256 * 384 * 2};
              pg8::EpiBf16 ep{qup, 768}; pg8::gemm_phase(lds, tid, 384, LDP, 384, sc, ep); }
            { pg8::SchedGrid sc{(const char*)(proj + C_ACKV), (const char*)(WukvT + (size_t)l * 1024 * 256), S / 256, 4, G, (bx + 128) % G, (size_t)256 * LDP * 2, (size_t)256 * 256 * 2};
              pg8::EpiBf16 ep{kvup, 1024}; pg8::gemm_phase(lds, tid, 256, LDP, 256, sc, ep); }
        }
        XCD_ARRIVE();
        {
            for (int rb_ = 0; rb_ < ((REP_MASK >> 9) & 1) + 1; ++rb_)
            { PHASE_BEGIN
            const float nbound = uni(-(64.0f * 0.125f * LOG2E * 1.02f) * wave_absmax(P.gqa_qk_norm + (l * 2 + 0) * 64, 64, lane) * wave_absmax(P.gqa_qk_norm + (l * 2 + 1) * 64, 64, lane));
            for (int u = vcu; u < 256; u += G) {
                const int h = u >> 5, qb = u & 31, q0 = qb * 256 + wid * 32, kv = h >> 2;
                f32x16 o[2]; float lsum;
                attn_dense_pair<64, 64, 64>(lds, tid, Qb + ((size_t)h * S + q0) * 64, 64, Kb + (size_t)kv * S * 64, 64, proj + C_BV + kv * 64, LDP, nbound, o, lsum);
                { RELANE(l2) int u2 = u; asm volatile("" : "+s"(u2)); const int h2 = u2 >> 5, q02 = (u2 & 31) * 256 + wid * 32;
                  store_y64(o, 1.0f / lsum, Yb, proj, q02 + (l2 & 31), 512 + h2 * 64, l2 >> 5); }
            } }
        }
        XCD_WAIT(2 * l + 1);
        {
            PHASE_BEGIN
            const float scl = 0.10206207261596575f * LOG2E;
            for (int it2 = gt; it2 < S * 16; it2 += NGT) {
              if (it2 < S * 8) {
                const int it = it2;
                const int t = it >> 3, h = it & 7;
                size_t wz_ = 0; asm volatile("" : "+s"(wz_)); const float* wq = P.mla_qk_norm + (l * 2 + 0) * 96 + wz_;
                const bf16_t* src = qup + (size_t)t * 768 + h * 96;
                u32x4 rc[6], rq[12];
#pragma unroll
                for (int i = 0; i < 6; ++i) rc[i] = *(const u32x4*)(proj + (size_t)t * LDP + C_ACQ + h * 48 + i * 8);
#pragma unroll
                for (int i = 0; i < 12; ++i) rq[i] = *(const u32x4*)(src + i * 8);
                float cs = 0.f;
#pragma unroll
                for (int i = 0; i < 6; ++i) { float c8[8]; unpack8(rc[i], c8);
#pragma unroll
                    for (int j = 0; j < 8; ++j) cs += c8[j] * c8[j]; }
                cs += shx(cs, 1, lane); cs += shx(cs, 2, lane); cs += shx(cs, 4, lane);
                const float rstd = rsqrtf(cs * (1.0f / 384.0f) + EPS);
                float ss = 0.f;
#pragma unroll
                for (int i = 0; i < 12; ++i) { float c8[8]; unpack8(rq[i], c8);
#pragma unroll
                    for (int j = 0; j < 8; ++j) { const float v = c8[j] * rstd; ss += v * v; } }
                const float rn = rsqrtf(ss * (1.0f / 96.0f) + EPS) * rstd;
                bf16_t* dst = Qa + ((size_t)h * S + t) * 96;
#pragma unroll
                for (int i = 0; i < 8; ++i) { float c8[8]; unpack8(rq[i], c8);
#pragma unroll
                    for (int j = 0; j < 8; ++j) c8[j] *= rn * wq[i * 8 + j] * scl;
                    *(u32x4*)(dst + 8 * i) = pack8(c8); }
#pragma unroll
                for (int i = 0; i < 2; ++i) { float a8[8], b8[8]; unpack8(rq[8 + i], a8); unpack8(rq[10 + i], b8);
#pragma unroll
                    for (int j = 0; j < 8; ++j) { const float a = a8[j] * rn * wq[64 + i * 8 + j], b = b8[j] * rn * wq[80 + i * 8 + j];
                        const float c = cosT[t * 16 + i * 8 + j], sn = sinT[t * 16 + i * 8 + j];
                        a8[j] = (a * c - b * sn) * scl; b8[j] = (a * sn + b * c) * scl; }
                    *(u32x4*)(dst + 64 + 8 * i) = pack8(a8); *(u32x4*)(dst + 80 + 8 * i) = pack8(b8); }
              } else {
                const int it = it2 - S * 8;
                const int t = it >> 3, h = it & 7;
                size_t wz_ = 0; asm volatile("" : "+s"(wz_)); const float* wk = P.mla_qk_norm + (l * 2 + 1) * 96 + wz_;
                const bf16_t* src = kvup + (size_t)t * 1024 + h * 128;
                const bf16_t* srcr = proj + (size_t)t * LDP + C_AKR;
                u32x4 rc[2], rk[8], rr[4], rv[8];
#pragma unroll
                for (int i = 0; i < 2; ++i) rc[i] = *(const u32x4*)(proj + (size_t)t * LDP + C_ACKV + h * 16 + i * 8);
#pragma unroll
                for (int i = 0; i < 8; ++i) { rk[i] = *(const u32x4*)(src + i * 8); rv[i] = *(const u32x4*)(src + 64 + i * 8); }
#pragma unroll
                for (int i = 0; i < 4; ++i) rr[i] = *(const u32x4*)(srcr + i * 8);
                float cs = 0.f;
#pragma unroll
                for (int i = 0; i < 2; ++i) { float c8[8]; unpack8(rc[i], c8);
#pragma unroll
                    for (int j = 0; j < 8; ++j) cs += c8[j] * c8[j]; }
                cs += shx(cs, 1, lane); cs += shx(cs, 2, lane); cs += shx(cs, 4, lane);
                const float rstd = rsqrtf(cs * (1.0f / 128.0f) + EPS);
                float ss = 0.f;
#pragma unroll
                for (int i = 0; i < 8; ++i) { float c8[8]; unpack8(rk[i], c8);
#pragma unroll
                    for (int j = 0; j < 8; ++j) { const float v = c8[j] * rstd; ss += v * v; } }
#pragma unroll
                for (int i = 0; i < 4; ++i) { float c8[8]; unpack8(rr[i], c8);
#pragma unroll
                    for (int j = 0; j < 8; ++j) ss += c8[j] * c8[j]; }
                const float rn = rsqrtf(ss * (1.0f / 96.0f) + EPS);
                bf16_t* dst = Ka + ((size_t)h * S + t) * 96;
#pragma unroll
                for (int i = 0; i < 8; ++i) { float c8[8]; unpack8(rk[i], c8);
#pragma unroll
                    for (int j = 0; j < 8; ++j) c8[j] *= rstd * rn * wk[i * 8 + j];
                    *(u32x4*)(dst + 8 * i) = pack8(c8); }
#pragma unroll
                for (int i = 0; i < 2; ++i) { float a8[8], b8[8]; unpack8(rr[i], a8); unpack8(rr[2 + i], b8);
#pragma unroll
                    for (int j = 0; j < 8; ++j) { const float a = a8[j] * rn * wk[64 + i * 8 + j], b = b8[j] * rn * wk[80 + i * 8 + j];
                        const float c = cosT[t * 16 + i * 8 + j], sn = sinT[t * 16 + i * 8 + j];
                        a8[j] = a * c - b * sn; b8[j] = a * sn + b * c; }
                    *(u32x4*)(dst + 64 + 8 * i) = pack8(a8); *(u32x4*)(dst + 80 + 8 * i) = pack8(b8); }
                bf16_t* dv = Va + ((size_t)h * S + t) * 64;
#pragma unroll
                for (int i = 0; i < 8; ++i) { float c8[8]; unpack8(rv[i], c8);
#pragma unroll
                    for (int j = 0; j < 8; ++j) c8[j] *= rstd;
                    *(u32x4*)(dv + 8 * i) = pack8(c8); }
              }
            }
        }
        XCD_ARRIVE();
        {
            for (int rd_ = 0; rd_ < ((REP_MASK >> 10) & 1) + 1; ++rd_)
            {
                PHASE_BEGIN
                float maxb = 0.f;
                for (int i = lane; i < 32 * 28; i += 64) maxb = fmaxf(maxb, fabsf(P.rel_bias[i]));
#pragma unroll
                for (int o_ = 1; o_ < 64; o_ <<= 1) maxb = fmaxf(maxb, shx(maxb, o_, lane));
                const float nbound = uni(-((64.0f * 0.125f * LOG2E * 1.02f) * wave_absmax(P.diff_qk_norm + (l * 2 + 0) * 64, 64, lane) * wave_absmax(P.diff_qk_norm + (l * 2 + 1) * 64, 64, lane) + maxb * LOG2E));
                constexpr int DBUF = 2 * (64 * (128 * 2 + 16) + 64 * (128 * 2 + 64));
                LAS float* dtab = (LAS float*)(lds + DBUF);
                LAS float* xch = (LAS float*)lds;
                for (int u = vcu; u < 256; u += G) {
                    const int h = u >> 6, qb = u & 63, map = wid >> 2, q0 = qb * 128 + (wid & 3) * 32;
                    for (int i = tid; i < 2048; i += 512) dtab[i] = dtabG[h * 2048 + i] + nbound;
                    __syncthreads();
                    f32x16 o[4]; float lsum;
                    attn_dense<128, 64, 128, 1>(lds, tid, Qd + ((size_t)h * S + q0) * 128 + map * 64, 128, Kd + (size_t)h * S * 128, 128, proj + C_DV + h * 128, LDP, map * 64, q0, dtab, nbound, 0, o, lsum);
                    const float linv = 1.0f / lsum;
                    RELANE(l2) int u2 = u; asm volatile("" : "+s"(u2));
                    const int h2 = u2 >> 6, q02 = (u2 & 63) * 128 + (wid & 3) * 32, hi2 = l2 >> 5;
                    if (map == 1) {
#pragma unroll
                        for (int d0 = 0; d0 < 4; ++d0)
#pragma unroll
                            for (int r = 0; r < 16; ++r) xch[(d0 * 16 + r) * 256 + (wid & 3) * 64 + l2] = o[d0][r] * linv;
                    }
                    __syncthreads();
                    if (map == 0) {
                        const float* lv = P.diff_lambda + l * 256;
                        const float d01 = wave_sum(lv[l2] * lv[64 + l2], l2), d23 = wave_sum(lv[128 + l2] * lv[192 + l2], l2);
                        const float lambda_init = 0.8f - 0.6f * expf(-0.3f * (float)l);
                        const float lam = expf(d01) - expf(d23) + lambda_init;
                        float ss = 0.f;
#pragma unroll
                        for (int d0 = 0; d0 < 4; ++d0)
#pragma unroll
                            for (int r = 0; r < 16; ++r) { const float v = o[d0][r] * linv - lam * xch[(d0 * 16 + r) * 256 + wid * 64 + l2]; o[d0][r] = v; ss += v * v; }
                        ss += shx(ss, 32, l2);
                        const float rn = rsqrtf(ss * (1.0f / 128.0f) + EPS) * (1.0f - lambda_init);
                        const int token = q02 + (l2 & 31); const float* sw = P.diff_subnorm + l * 128;
#pragma unroll
                        for (int d0 = 0; d0 < 4; ++d0) {
#pragma unroll
                            for (int g = 0; g < 4; ++g) {
                                const int dv = 32 * d0 + 8 * g + 4 * hi2, col = 1536 + h2 * 128 + dv;
                                const u32x2 gv = *(const u32x2*)(proj + (size_t)token * LDP + C_SILU + col);
                                const f32x4 w = *(const f32x4*)(sw + dv);
                                u32x2 ov;
                                ov.x = cvt_pk(o[d0][4 * g + 0] * rn * w.x * bflo(gv.x), o[d0][4 * g + 1] * rn * w.y * bfhi(gv.x));
                                ov.y = cvt_pk(o[d0][4 * g + 2] * rn * w.z * bflo(gv.y), o[d0][4 * g + 3] * rn * w.w * bfhi(gv.y));
                                *(u32x2*)(Yb + (size_t)token * DM + col) = ov;
                            }
                            asm volatile("" ::: "memory");
                        }
                    }
                    __syncthreads();
                }
            }
            for (int rc_ = 0; rc_ < ((REP_MASK >> 11) & 1) + 1; ++rc_)
            {
                PHASE_BEGIN const int r32 = lane & 31, hi = lane >> 5;
                float nbound;
                { RELANE(l6)
                  float maxb = 0.f;
                  for (int i = l6; i < 32 * 28; i += 64) maxb = fmaxf(maxb, fabsf(P.rel_bias[i]));
#pragma unroll
                  for (int o_ = 1; o_ < 64; o_ <<= 1) maxb = fmaxf(maxb, shx(maxb, o_, l6));
                  float wmax = 0.f;
                  for (int g_ = 0; g_ < 3; ++g_) wmax = fmaxf(wmax, wave_absmax(P.dil_qk_norm + ((l * 2 + 0) * 3 + g_) * 64, 64, l6) * wave_absmax(P.dil_qk_norm + ((l * 2 + 1) * 3 + g_) * 64, 64, l6));
                  nbound = uni(-((64.0f * 0.125f * LOG2E * 1.02f) * wmax + maxb * LOG2E)); }
                constexpr int CKP = 144, CVP = 144, CKT = 64 * CKP, CWB = CKT + 64 * CVP;
                constexpr int CR0 = 576, CR1 = 192, CR2 = 128, CT1 = 2 * CR0 + 1, CT2 = CT1 + 2 * CR1 + 1, CTN = CT2 + 2 * CR2 + 1;
                LAS float* ctab = (LAS float*)(lds + 8 * CWB);
                LAS unsigned char* wl = lds + wid * CWB;
                for (int u = vcu; u < 256; u += G) {
                    const int h = u >> 5, bb = (u >> 1) & 15, rh = u & 1, r16 = rh * 8 + wid, i0 = bb * 32;
                    __syncthreads();
                    RELANE(l5)
                    for (int i = wid * 64 + l5; i < CTN; i += 512) { const int g_ = i < CT1 ? 0 : (i < CT2 ? 1 : 2); const int rel = i - (g_ == 0 ? CR0 : (g_ == 1 ? CT1 + CR1 : CT2 + CR2));
                        ctab[i] = (rel >= -64 && rel <= 64) ? ctabG[(g_ * 8 + h) * 132 + rel + 64] + nbound : -INFINITY; }
                    __syncthreads();
                    float lsum = 0.f; f32x16 o[2];
#pragma unroll
                    for (int d0 = 0; d0 < 2; ++d0)
#pragma unroll
                        for (int r = 0; r < 16; ++r) o[d0][r] = 0.f;
                    bf16x8 qf[4]; u32x4 kreg[8], vreg[8];
                    float ls[4] = {0.f, 0.f, 0.f, 0.f};
                    const int koff = r32 * CKP + hi * 16;
                    const int voff = CKT + (4 * hi + ((lane & 15) >> 2)) * CVP + (((lane >> 4) & 1) * 16 + (lane & 3) * 4) * 2;
#define C_DECODE(T, g_, tt_) const int g_ = (T) < 10 ? 0 : ((T) < 14 ? 1 : 2); const int tt_ = (T) - (g_ == 0 ? 0 : (g_ == 1 ? 10 : 14));
#define C_GLOAD(T) do { C_DECODE(T, g__, tt__) const int sh__ = 2 * g__, e__ = 16 >> sh__, rc__ = r16 & ((1 << sh__) - 1), L__ = S >> sh__; const int kb__ = e__ * i0 - 64 + 64 * tt__; \
        const char* kg__ = (const char*)(Kc + (size_t)(g__ * 8 + h) * S * 64); const char* vg__ = (const char*)(proj + C_CV + (g__ * 8 + h) * 64); \
        if (kb__ >= 0 && kb__ + 64 <= L__) {        \
            const size_t tok0__ = (size_t)((kb__ << sh__) + rc__); const char* kt__ = kg__ + tok0__ * 128; const char* vt__ = vg__ + tok0__ * (LDP * 2); \
            _Pragma("unroll") for (int i_ = 0; i_ < 8; ++i_) { const unsigned dk_ = (unsigned)((key0 + 8 * i_) << sh__); \
                kreg[i_] = *(const u32x4*)(kt__ + dk_ * 128u + part16); vreg[i_] = *(const u32x4*)(vt__ + dk_ * (unsigned)(LDP * 2) + part16); } \
        } else { \
            _Pragma("unroll") for (int i_ = 0; i_ < 8; ++i_) { int ks_ = kb__ + key0 + 8 * i_; ks_ = ks_ < 0 ? 0 : ks_; ks_ = ks_ > L__ - 1 ? L__ - 1 : ks_; \
                const size_t tok_ = (size_t)((ks_ << sh__) + rc__); kreg[i_] = *(const u32x4*)(kg__ + tok_ * 128 + part16); vreg[i_] = *(const u32x4*)(vg__ + tok_ * (LDP * 2) + part16); } \
        } } while (0)
                    {
                        RELANE(l4) const int tid4 = wid * 64 + l4, r32g = l4 & 31, hig = l4 >> 5;
                        const int koffg = r32g * CKP + hig * 16;
                        const int voffg = CKT + (4 * hig + ((l4 & 15) >> 2)) * CVP + (((l4 >> 4) & 1) * 16 + (l4 & 3) * 4) * 2;
                        const int h0 = h;
                        const char* kg0 = (const char*)(Kc + (size_t)(0 * 8 + h0) * S * 64); const char* vg0 = (const char*)(proj + C_CV + (0 * 8 + h0) * 64);
                        const int skey = tid4 >> 3, spart16 = (tid4 & 7) * 16;
                        u32x4 kr0, vr0;
                        const bf16_t* qg = Qc + ((size_t)(0 * 8 + h0) * S + 16 * i0 + r16) * 64;
#pragma unroll
                        for (int d0 = 0; d0 < 4; ++d0) qf[d0] = *(const bf16x8*)(qg + (size_t)r32g * 1024 + d0 * 16 + hig * 8);
#define C0_GLOAD(tt_) do { int ks_ = 16 * i0 - 64 + 64 * (tt_) + skey; ks_ = ks_ < 0 ? 0 : ks_; ks_ = ks_ > S - 1 ? S - 1 : ks_; \
        kr0 = *(const u32x4*)(kg0 + (size_t)ks_ * 128 + spart16); vr0 = *(const u32x4*)(vg0 + (size_t)ks_ * (LDP * 2) + spart16); } while (0)
#define C0_LSTORE(b_) do { *(LAS u32x4*)(lds + (b_) * CWB + skey * CKP + spart16) = kr0; *(LAS u32x4*)(lds + (b_) * CWB + CKT + skey * CVP + spart16) = vr0; } while (0)
#define C0_GLOAD_K(tt_) do { int ks_ = 16 * i0 - 64 + 64 * (tt_) + skey; ks_ = ks_ < 0 ? 0 : ks_; ks_ = ks_ > S - 1 ? S - 1 : ks_; kr0 = *(const u32x4*)(kg0 + (size_t)ks_ * 128 + spart16); } while (0)
#define C0_GLOAD_V(tt_) do { int ks_ = 16 * i0 - 64 + 64 * (tt_) + skey; ks_ = ks_ < 0 ? 0 : ks_; ks_ = ks_ > S - 1 ? S - 1 : ks_; vr0 = *(const u32x4*)(vg0 + (size_t)ks_ * (LDP * 2) + spart16); } while (0)
#define C0_LSTORE_K(b_) do { *(LAS u32x4*)(lds + (b_) * CWB + skey * CKP + spart16) = kr0; } while (0)
#define C0_LSTORE_V(b_) do { *(LAS u32x4*)(lds + (b_) * CWB + CKT + skey * CVP + spart16) = vr0; } while (0)
#define C0_CINIT(P0, P1, tt_) do { const int kb_ = 16 * i0 - 64 + 64 * (tt_); const LAS float* tp_ = ctab + CR0 + (kb_ + 4 * hig - subq); \
        _Pragma("unroll") for (int r = 0; r < 16; ++r) { P0[r] = tp_[(r & 3) + 8 * (r >> 2)]; P1[r] = tp_[32 + (r & 3) + 8 * (r >> 2)]; } \
        if (kb_ < 0 || kb_ + 64 > S) { \
            _Pragma("unroll") for (int r = 0; r < 16; ++r) { const int ks0_ = kb_ + 4 * hig + (r & 3) + 8 * (r >> 2); \
                if ((unsigned)ks0_ >= (unsigned)S) P0[r] = -INFINITY; \
                if ((unsigned)(ks0_ + 32) >= (unsigned)S) P1[r] = -INFINITY; } } } while (0)
                        const int subq = 16 * (i0 + r32g) + r16;
                        C0_GLOAD_K(0); C0_LSTORE_K(0);
                        __syncthreads();
                        C0_GLOAD_K(1); C0_GLOAD_V(0);
                        u32x4 pw0_[4];
                        { f32x16 pc0, pc1; C0_CINIT(pc0, pc1, 0);
                          qk_tile<64, CKP>(pc0, pc1, lds + koffg, qf); exp_tile(pc0, pc1); pack_tile(pc0, pc1, pw0_); }
                        C0_LSTORE_K(1); C0_LSTORE_V(0);
                        __syncthreads();
                        f32x16 cdummy;
#pragma unroll
                        for (int r = 0; r < 16; ++r) cdummy[r] = 0.f;
                        for (int tt = 1; tt < 10; ++tt) {
                            C0_GLOAD_K(tt + 1 < 10 ? tt + 1 : 9); C0_GLOAD_V(tt);
                            f32x16 pn0, pn1; C0_CINIT(pn0, pn1, tt);
                            __builtin_amdgcn_sched_barrier(0);
                            tile_step<64, CKP, 64, CVP, false>(pw0_, pn0, pn1, cdummy, ls, o, qf, lds + (tt & 1) * CWB + koffg, lds + ((tt - 1) & 1) * CWB + voffg);
                            C0_LSTORE_K((tt + 1) & 1); C0_LSTORE_V(tt & 1);
                            __syncthreads();
                        }
                        rowsum_pw(pw0_, ls);
                        pv_tile<64, CVP>(o, pw0_, lds + (9 & 1) * CWB + voffg);
                        __syncthreads();
#undef C0_GLOAD_K
#undef C0_GLOAD_V
#undef C0_LSTORE_K
#undef C0_LSTORE_V
#undef C0_CINIT
#undef C0_GLOAD
#undef C0_LSTORE
                    }
                    RELANE(l3) const int key0 = l3 >> 3, part16 = (l3 & 7) * 16;
                    size_t z3_ = 0; asm volatile("" : "+s"(z3_)); const bf16_t* Kc_ = Kc + z3_; const bf16_t* Qc_ = Qc + z3_; const bf16_t* proj_ = proj + z3_;
                    int u3_ = u; asm volatile("" : "+s"(u3_));
                    const int h_ = u3_ >> 5, i0_w = ((u3_ >> 1) & 15) * 32, r16_ = (u3_ & 1) * 8 + wid, r32_ = l3 & 31, hi_ = l3 >> 5;
                    const int koff_ = r32_ * CKP + hi_ * 16;
                    const int voff_ = CKT + (4 * hi_ + ((l3 & 15) >> 2)) * CVP + (((l3 >> 4) & 1) * 16 + (l3 & 3) * 4) * 2;
#define Kc Kc_
#define Qc Qc_
#define proj proj_
#define h h_
#define i0 i0_w
#define r16 r16_
#define r32 r32_
#define hi hi_
#define koff koff_
#define voff voff_
                    C_GLOAD(10);
                    for (int T = 10; T < 17; ++T) {
                        C_DECODE(T, g, tt)
                        const int sh = 2 * g, e = 16 >> sh, L = S >> sh;
                        if (tt == 0) {
                            const bf16_t* qg = Qc + ((size_t)(g * 8 + h) * S + 16 * i0 + r16) * 64;
#pragma unroll
                            for (int d0 = 0; d0 < 4; ++d0) qf[d0] = *(const bf16x8*)(qg + (size_t)r32 * 1024 + d0 * 16 + hi * 8);
                        }
#pragma unroll
                        for (int i_ = 0; i_ < 8; ++i_) { *(LAS u32x4*)(wl + (key0 + 8 * i_) * CKP + part16) = kreg[i_]; *(LAS u32x4*)(wl + CKT + (key0 + 8 * i_) * CVP + part16) = vreg[i_]; }
                        if (T + 1 < 17) C_GLOAD(T + 1);
                        const int kb = e * i0 - 64 + 64 * tt;
                        const int subq = e * (i0 + r32) + (r16 >> sh);
                        const LAS float* tp = ctab + (g == 0 ? CR0 : (g == 1 ? CT1 + CR1 : CT2 + CR2)) + (kb + 4 * hi - subq);
                        f32x16 p0, p1;
#pragma unroll
                        for (int r = 0; r < 16; ++r) { p0[r] = tp[(r & 3) + 8 * (r >> 2)]; p1[r] = tp[32 + (r & 3) + 8 * (r >> 2)]; }
                        if (kb < 0 || kb + 64 > L) {
#pragma unroll
                            for (int r = 0; r < 16; ++r) { const int ks0 = kb + 4 * hi + (r & 3) + 8 * (r >> 2);
                                if ((unsigned)ks0 >= (unsigned)L) p0[r] = -INFINITY;
                                if ((unsigned)(ks0 + 32) >= (unsigned)L) p1[r] = -INFINITY; }
                        }
                        qk_tile<64, CKP>(p0, p1, wl + koff, qf);
                        exp_tile(p0, p1);
                        u32x4 pw_[4]; pack_tile(p0, p1, pw_); rowsum_pw(pw_, ls);
                        pv_tile<64, CVP>(o, pw_, wl + voff);
                    }
                    lsum = (ls[0] + ls[1]) + (ls[2] + ls[3]);
#undef Kc
#undef Qc
#undef proj
#undef h
#undef i0
#undef r16
#undef r32
#undef hi
#undef koff
#undef voff
#undef C_GLOAD
#undef C_DECODE
                    { RELANE(l2) lsum += shx(lsum, 32, l2); int u2 = u; asm volatile("" : "+s"(u2)); const int h2 = u2 >> 5, i02 = ((u2 >> 1) & 15) * 32, r162 = (u2 & 1) * 8 + wid;
                      store_y64(o, 1.0f / lsum, Yb, proj, 16 * (i02 + (l2 & 31)) + r162, 1024 + h2 * 64, l2 >> 5); }
                }
                __syncthreads();
            }
        }
        XCD_WAIT(2 * l + 2);
        {
            for (int ra_ = 0; ra_ < ((REP_MASK >> 8) & 1) + 1; ++ra_)
            { PHASE_BEGIN
            const float nbound = uni(-(96.0f * 0.10206207261596575f * LOG2E * 1.02f) * wave_absmax(P.mla_qk_norm + (l * 2 + 0) * 96, 96, lane) * wave_absmax(P.mla_qk_norm + (l * 2 + 1) * 96, 96, lane));
            for (int u = vcu; u < 256; u += G) {
                const int h = u >> 5, qb = u & 31, q0 = qb * 256 + wid * 32;
                f32x16 o[2]; float lsum;
                attn_dense<96, 96, 64, 0>(lds, tid, Qa + ((size_t)h * S + q0) * 96, 96, Ka + (size_t)h * S * 96, 96, Va + (size_t)h * S * 64, 64, 0, 0, nullptr, nbound, 0, o, lsum);
                { RELANE(l2) int u2 = u; asm volatile("" : "+s"(u2)); const int h2 = u2 >> 5, q02 = (u2 & 31) * 256 + wid * 32;
                  store_y64(o, 1.0f / lsum, Yb, proj, q02 + (l2 & 31), 0 + h2 * 64, l2 >> 5); }
            } }
        }
        GRID_SYNC();
        for (int rep_ = 0; rep_ < ((REP_MASK >> 6) & 1) + 1; ++rep_) {
        {
            PHASE_BEGIN
            pg8::SchedGrid sc{(const char*)Yb, (const char*)(WbT + (size_t)l * DM * DM), S / 256, DM / 256, G, bx, (size_t)256 * DM * 2, (size_t)256 * DM * 2};
            pg8::EpiBranch ep{mixB, proj + C_GATE};
            pg8::gemm_phase(lds, tid, DM, DM, DM, sc, ep);
        }
        GRID_SYNC();
        }
        if (REP_MASK & 128) { for (int k_ = 0; k_ < 8; ++k_) grid.sync(); }
        {
            PHASE_BEGIN
            const float* xin = (l == 0) ? P.x : P.out;
            pg8::SchedGrid sc{(const char*)mixB, (const char*)(WoT + (size_t)l * DM * DM), S / 256, DM / 256, G, bx, (size_t)256 * DM * 2, (size_t)256 * DM * 2};
            if (l + 1 < DEPTH) { pg8::EpiOut<true> ep{xin, P.out, Hb, (float*)(ws + WS_SSQ) + (size_t)(l + 1) * S}; pg8::gemm_phase(lds, tid, DM, DM, DM, sc, ep); }
            else { pg8::EpiOut<false> ep{xin, P.out, nullptr, nullptr}; pg8::gemm_phase(lds, tid, DM, DM, DM, sc, ep); }
        }
        GRID_SYNC();
    }
}

extern "C" void kernel_launch(void* const* d_in, const int* in_sizes, int n_in, void* d_out, int out_size, void* d_ws, size_t ws_size, hipStream_t stream) {
    static int grid = 0;
    if (grid == 0) {
        int dev = 0, cus = 0, per_cu = 0;
        hipGetDevice(&dev);
        hipDeviceGetAttribute(&cus, hipDeviceAttributeMultiprocessorCount, dev);
        hipFuncSetAttribute((const void*)mega, hipFuncAttributeMaxDynamicSharedMemorySize, LDS_BYTES);
        hipOccupancyMaxActiveBlocksPerMultiprocessor(&per_cu, (const void*)mega, 512, LDS_BYTES);
        if (per_cu < 1) per_cu = 1;
        grid = cus * 1;
        (void)hipGetLastError();
        if (ws_size < WS_END) { fprintf(stderr, "kernel_launch: workspace too small (%zu < %zu)\n", ws_size, (size_t)WS_END); grid = -1; }
    }
    if (grid < 0) return;
    Params p{};
    p.x = (const float*)d_in[0]; p.norm_w = (const float*)d_in[1]; p.w_in = (const float*)d_in[2]; p.mla_q_norm = (const float*)d_in[3];
    p.mla_kv_norm = (const float*)d_in[4]; p.mla_w_uq = (const float*)d_in[5]; p.mla_w_ukv = (const float*)d_in[6]; p.mla_qk_norm = (const float*)d_in[7];
    p.gqa_qk_norm = (const float*)d_in[8]; p.dil_qk_norm = (const float*)d_in[9]; p.diff_qk_norm = (const float*)d_in[10]; p.diff_lambda = (const float*)d_in[11];
    p.diff_subnorm = (const float*)d_in[12]; p.rel_bias = (const float*)d_in[13]; p.w_branch = (const float*)d_in[14]; p.w_out = (const float*)d_in[15];
    p.out = (float*)d_out; p.ws = (unsigned char*)d_ws;
    void* args[] = {&p};
    hipError_t e = hipLaunchCooperativeKernel((const void*)mega, dim3(grid), dim3(512), args, LDS_BYTES, stream);
    if (e != hipSuccess) fprintf(stderr, "cooperative launch failed: %s (grid %d)\n", hipGetErrorString(e), grid);
}
```

```cpp
#include <hip/hip_runtime.h>
#include <hip/hip_cooperative_groups.h>
#include <cstdio>
#include <cstdint>
namespace cg = cooperative_groups;

#define LAS __attribute__((address_space(3)))
#define DI __device__ __forceinline__
typedef unsigned short bf16_t;
typedef short bf16x8 __attribute__((ext_vector_type(8)));
typedef short s16x4 __attribute__((ext_vector_type(4)));
typedef float f32x4 __attribute__((ext_vector_type(4)));
typedef float f32x16 __attribute__((ext_vector_type(16)));
typedef unsigned u32x4 __attribute__((ext_vector_type(4)));
typedef unsigned u32x2 __attribute__((ext_vector_type(2)));

constexpr int S = 8192, DM = 2048, DEPTH = 4, NIN = 17696, LDP = 17920;
constexpr int NHT = 19, C_ACQ = 4864, C_ACKV = 5248, C_AKR = 5376, C_BV = 5408, C_CV = 5536, C_DV = 7072, C_SILU = 7584, C_GATE = 9632, C_END = 17824;
constexpr int SRC_BQ = 544, SRC_BK = 1056, SRC_BV = 1184, SRC_CQ = 1312, SRC_CK = 2848, SRC_CV = 4384, SRC_DQ = 5920, SRC_DK = 6432, SRC_DV = 6944, SRC_SILU = 7456, SRC_GATE = 9504;
__host__ __device__ inline int head_src(int idx) { return idx < 8 ? SRC_BQ + 64 * idx : idx < 10 ? SRC_BK + 64 * (idx - 8) : idx < 34 ? SRC_CQ + 64 * (idx - 10) : idx < 58 ? SRC_CK + 64 * (idx - 34)
                                                        : idx < 66 ? SRC_DQ + 64 * (idx - 58) : SRC_DK + 64 * (idx - 66); }
__host__ __device__ inline int in_src_col(int c) {
    if (c < NHT * 256) { const int T = c >> 8, ct = c & 255, bj = ct >> 7, wc = (ct >> 5) & 3, o = ct & 31, fq = o >> 3, n = (o >> 2) & 1, hs = 4 * T + wc;
        return hs < 74 ? head_src(hs) + 32 * bj + 16 * n + 4 * fq : -1; }
    const int r = c - NHT * 256;
    return r < 544 ? r : r < 672 ? SRC_BV + (r - 544) : r < 2208 ? SRC_CV + (r - 672) : r < 2720 ? SRC_DV + (r - 2208) : r < 4768 ? SRC_SILU + (r - 2720) : r < 12960 ? SRC_GATE + (r - 4768) : -1;
}
constexpr float EPS = 1e-6f;
constexpr float LOG2E = 1.4426950408889634f;

constexpr size_t MiB = 1u << 20;
constexpr size_t WS_WIN = 0;
constexpr size_t SZ_WIN1 = (size_t)LDP * DM * 2;
constexpr size_t WS_WB = WS_WIN + 4 * SZ_WIN1;
constexpr size_t SZ_WB1 = (size_t)4 * 2048 * 512 * 2;
constexpr size_t WS_WO = WS_WB + 4 * SZ_WB1;
constexpr size_t SZ_WO1 = (size_t)2048 * 2048 * 2;
constexpr size_t WS_WUQ = WS_WO + 4 * SZ_WO1;
constexpr size_t SZ_WUQ1 = (size_t)768 * 384 * 2;
constexpr size_t WS_WUKV = WS_WUQ + 4 * MiB;
constexpr size_t SZ_WUKV1 = (size_t)1024 * 256 * 2;
constexpr size_t WS_COS = WS_WUKV + 4 * MiB;
constexpr size_t WS_SIN = WS_COS + MiB;
constexpr size_t WS_DTAB = WS_SIN + MiB;
constexpr size_t WS_CTAB = WS_DTAB + MiB;
constexpr size_t WS_H = WS_CTAB + MiB;
constexpr size_t WS_PROJ = WS_H + 32 * MiB;
constexpr size_t WS_QUP = WS_PROJ + (size_t)S * LDP * 2;
constexpr size_t WS_KVUP = WS_QUP + 12 * MiB;
constexpr size_t WS_QA = WS_KVUP + 16 * MiB;
constexpr size_t WS_KA = WS_QA + 12 * MiB;
constexpr size_t WS_VA = WS_KA + 12 * MiB;
constexpr size_t WS_QB = WS_VA + 8 * MiB;
constexpr size_t WS_KB = WS_QB + 8 * MiB;
constexpr size_t WS_QC = WS_KB + 2 * MiB;
constexpr size_t WS_KC = WS_QC + 24 * MiB;
constexpr size_t WS_QD = WS_KC + 24 * MiB;
constexpr size_t WS_KD = WS_QD + 8 * MiB;
constexpr size_t WS_Y = WS_KD + 8 * MiB;
constexpr size_t WS_MIXF = WS_Y + 32 * MiB;
constexpr size_t WS_MIXB = WS_MIXF + 64 * MiB;
constexpr size_t WS_BAR = WS_MIXB + 32 * MiB;
constexpr size_t WS_SSQ = WS_BAR + MiB;
constexpr size_t WS_END = WS_SSQ + MiB;

constexpr int LDS_BYTES = 155648;
#ifndef REP_MASK
#define REP_MASK 0
#endif

DI unsigned cvt_pk(float lo, float hi) {
    typedef float f2 __attribute__((ext_vector_type(2))); typedef __bf16 b2 __attribute__((ext_vector_type(2)));
    f2 v = {lo, hi}; b2 b = __builtin_convertvector(v, b2); return __builtin_bit_cast(unsigned, b);
}
DI float bflo(unsigned u) { return __uint_as_float(u << 16); }
DI float bfhi(unsigned u) { return __uint_as_float(u & 0xffff0000u); }
DI void unpack8(const u32x4 v, float* x) { x[0] = bflo(v.x); x[1] = bfhi(v.x); x[2] = bflo(v.y); x[3] = bfhi(v.y); x[4] = bflo(v.z); x[5] = bfhi(v.z); x[6] = bflo(v.w); x[7] = bfhi(v.w); }
DI u32x4 pack8(const float* x) { u32x4 v; v.x = cvt_pk(x[0], x[1]); v.y = cvt_pk(x[2], x[3]); v.z = cvt_pk(x[4], x[5]); v.w = cvt_pk(x[6], x[7]); return v; }
DI float sigmoidf_(float v) { return __builtin_amdgcn_rcpf(1.0f + __expf(-v)); }
DI int crow(int r, int hi) { return (r & 3) + 8 * (r >> 2) + 4 * hi; }
DI float shx(float v, int m, int lane) { return __int_as_float(__builtin_amdgcn_ds_bpermute((lane ^ m) << 2, __float_as_int(v))); }

namespace pg8 {
constexpr int BM = 256, BK = 64, HALF = 128, HTB = HALF * BK * 2, STAGE_BYTES = 8 * HTB, NXCD = 8, WGM = 8;
DI int lds_byte(int r, int c) { const int st = (r >> 4) * 2 + (c >> 5), rr = r & 15, cc = c & 31, ob = rr * 64 + cc * 2; return st * 1024 + (ob ^ (((ob >> 9) & 1) << 5)); }
DI void stage_rc(int b, int& R, int& C) { const int st = b / 1024, sb = b % 1024, swz = sb ^ (((sb >> 9) & 1) << 5); R = (st >> 1) * 16 + swz / 64; C = (st & 1) * 32 + (swz % 64) / 2; }
DI int perm32(int rho) { const int n = rho >> 4, i = rho & 15; return 8 * (i >> 2) + 4 * n + (i & 3); }

struct Unit { int pm, pn, tag; const char* a; const char* b; };

DI void static_order(int L, int nM, int nN, int& pm, int& pn) {
    const int nwg = nM * nN; int wgid = L;
    { const int q = nwg / NXCD, r = nwg % NXCD, xcd = wgid % NXCD, off = wgid / NXCD; wgid = (xcd < r ? xcd * (q + 1) : r * (q + 1) + (xcd - r) * q) + off; }
    const int nig = WGM * nN, gid = wgid / nig, fm = gid * WGM, gsz = (nM - fm) < WGM ? (nM - fm) : WGM;
    pm = fm + ((wgid % nig) % gsz); pn = (wgid % nig) / gsz;
}
struct SchedGrid {
    const char* A; const char* B; int nM, nN, G, c; size_t tstepA, tstepB;
    DI bool next(int i, Unit& u) const {
        const long L = (long)i * G + c; if (L >= (long)nM * nN) return false;
        static_order((int)L, nM, nN, u.pm, u.pn); u.tag = 0; u.a = A + (size_t)u.pm * tstepA; u.b = B + (size_t)u.pn * tstepB; return true;
    }
};
struct SchedBranch {
    const char* A; const char* B; int nM, nN, G, c; size_t tstepA, tstepB, bstepA, bstepB;
    DI bool next(int i, Unit& u) const {
        const long L = (long)(i >> 2) * G + c; if (L >= (long)nM * nN) return false;
        static_order((int)L, nM, nN, u.pm, u.pn); u.tag = i & 3;
        u.a = A + (size_t)u.pm * tstepA + (size_t)u.tag * bstepA; u.b = B + (size_t)u.pn * tstepB + (size_t)u.tag * bstepB; return true;
    }
};

struct EpiBf16 {
    static constexpr bool HOOK = false;
    bf16_t* O; int ldc;
    DI void operator()(const f32x4 (&acc)[2][2][4][2], const Unit& u, int wr, int wc, int fr, int fq) const {
        const int row0 = u.pm * BM + wr * 64 + fr, col0 = u.pn * BM + wc * 32 + 8 * fq;
#pragma unroll
        for (int ai = 0; ai < 2; ++ai)
#pragma unroll
            for (int m = 0; m < 4; ++m) { bf16_t* rowp = O + (size_t)(row0 + ai * HALF + m * 16) * ldc + col0;
#pragma unroll
                for (int bj = 0; bj < 2; ++bj) { const f32x4 v0 = acc[ai][bj][m][0], v1 = acc[ai][bj][m][1];
                    u32x4 w; w.x = cvt_pk(v0[0], v0[1]); w.y = cvt_pk(v0[2], v0[3]); w.z = cvt_pk(v1[0], v1[1]); w.w = cvt_pk(v1[2], v1[3]);
                    *(u32x4*)(rowp + bj * HALF) = w; } }
    }
};
struct HeadInfo { const float* wv; bf16_t* dst; int dstride; float scale; bool rope; };
struct EpiProj {
    static constexpr bool HOOK = false;
    bf16_t* O; const float* ssq;
    const float* gqa_n; const float* dil_n; const float* diff_n;
    const float* cosT; const float* sinT;
    bf16_t* Qb; bf16_t* Kb; bf16_t* Qc; bf16_t* Kc; bf16_t* Qd; bf16_t* Kd;
    DI HeadInfo head(int idx) const {
        HeadInfo h; h.dstride = 64; h.scale = 1.f; h.rope = false;
        if (idx < 8) { h.wv = gqa_n; h.dst = Qb + (size_t)idx * S * 64; h.scale = 0.125f * LOG2E; h.rope = true; }
        else if (idx < 10) { h.wv = gqa_n + 64; h.dst = Kb + (size_t)(idx - 8) * S * 64; h.rope = true; }
        else if (idx < 34) { const int j = idx - 10; h.wv = dil_n + (j >> 3) * 64; h.dst = Qc + (size_t)j * S * 64; h.scale = 0.125f * LOG2E; }
        else if (idx < 58) { const int j = idx - 34; h.wv = dil_n + (3 + (j >> 3)) * 64; h.dst = Kc + (size_t)j * S * 64; }
        else if (idx < 66) { const int j = idx - 58; h.wv = diff_n; h.dst = Qd + (size_t)(j >> 1) * S * 128 + (j & 1) * 64; h.dstride = 128; h.scale = 0.125f * LOG2E; }
        else { const int j = idx - 66; h.wv = diff_n + 64; h.dst = Kd + (size_t)(j >> 1) * S * 128 + (j & 1) * 64; h.dstride = 128; }
        return h;
    }
    DI void operator()(const f32x4 (&acc)[2][2][4][2], const Unit& u, int wr, int wc, int fr, int fq) const {
        int row0 = u.pm * BM + wr * 64 + fr, col0 = u.pn * BM + wc * 32 + 8 * fq;
        asm volatile("" : "+v"(row0), "+v"(col0));
        float rstd[2][4];
#pragma unroll
        for (int ai = 0; ai < 2; ++ai)
#pragma unroll
            for (int m = 0; m < 4; ++m) rstd[ai][m] = rsqrtf(ssq[row0 + ai * HALF + m * 16] * (1.0f / DM) + EPS);
        if (u.pn < NHT) {
            const int hs = 4 * u.pn + wc;
            if (hs >= 74) return;
            const HeadInfo hd = head(hs);
            const int lane = fq * 16 + fr;
            f32x4 w[2][2];
#pragma unroll
            for (int bj = 0; bj < 2; ++bj)
#pragma unroll
                for (int n = 0; n < 2; ++n) w[bj][n] = *(const f32x4*)(hd.wv + 32 * bj + 16 * n + 4 * fq) * hd.scale;
#pragma unroll
            for (int ai = 0; ai < 2; ++ai)
#pragma unroll
                for (int m = 0; m < 4; ++m) {
                    const int t = row0 + ai * HALF + m * 16;
                    f32x4 x[2][2]; float ss = 0.f;
#pragma unroll
                    for (int bj = 0; bj < 2; ++bj)
#pragma unroll
                        for (int n = 0; n < 2; ++n) { x[bj][n] = acc[ai][bj][m][n] * rstd[ai][m]; const f32x4 q = x[bj][n] * x[bj][n]; ss += (q[0] + q[1]) + (q[2] + q[3]); }
                    ss += shx(ss, 16, lane); ss += shx(ss, 32, lane);
                    const float rn = rsqrtf(ss * (1.0f / 64.0f) + EPS);
#pragma unroll
                    for (int bj = 0; bj < 2; ++bj) {
                        f32x4 x1 = x[bj][0] * rn * w[bj][0], x2 = x[bj][1] * rn * w[bj][1];
                        if (hd.rope) {
                            const int pos = bj == 0 ? (t >> 6) : (t & 63);
                            const f32x4 c = *(const f32x4*)(cosT + pos * 16 + 4 * fq), sn = *(const f32x4*)(sinT + pos * 16 + 4 * fq);
                            const f32x4 y1 = x1 * c - x2 * sn, y2 = x1 * sn + x2 * c; x1 = y1; x2 = y2;
                        }
                        bf16_t* d = hd.dst + (size_t)t * hd.dstride + 32 * bj + 4 * fq;
                        u32x2 o1, o2; o1.x = cvt_pk(x1[0], x1[1]); o1.y = cvt_pk(x1[2], x1[3]); o2.x = cvt_pk(x2[0], x2[1]); o2.y = cvt_pk(x2[2], x2[3]);
                        *(u32x2*)d = o1; *(u32x2*)(d + 16) = o2;
                    }
                }
            return;
        }
#pragma unroll
        for (int bj = 0; bj < 2; ++bj) {
            const int colw = u.pn * BM + bj * HALF + wc * 32;
            const int act = colw < C_SILU ? 0 : (colw < C_GATE ? 1 : 2);
#pragma unroll
            for (int ai = 0; ai < 2; ++ai)
#pragma unroll
                for (int m = 0; m < 4; ++m) {
                    float v[8];
#pragma unroll
                    for (int j = 0; j < 4; ++j) { v[j] = acc[ai][bj][m][0][j] * rstd[ai][m]; v[4 + j] = acc[ai][bj][m][1][j] * rstd[ai][m]; }
                    if (act) {
#pragma unroll
                        for (int j = 0; j < 8; ++j) { const float sg = sigmoidf_(v[j]); v[j] = act == 1 ? v[j] * sg : sg; }
                    }
                    *(u32x4*)(O + (size_t)(row0 + ai * HALF + m * 16) * LDP + col0 + bj * HALF) = pack8(v);
                }
        }
    }
};
struct EpiBranch {
    static constexpr bool HOOK = true;
    bf16_t* MB; const bf16_t* G;
    DI void hook(f32x4 (&acc)[2][2][4][2], const Unit& u, int n, int wr, int wc, int fr, int fq) const {
        int row0 = u.pm * BM + wr * 64 + fr, col0 = u.pn * BM + wc * 32 + 8 * fq;
        asm volatile("" : "+v"(row0), "+v"(col0));
#pragma unroll
        for (int ai = 0; ai < 2; ++ai) {
#pragma unroll
            for (int m = 0; m < 4; ++m) { const size_t row = (size_t)(row0 + ai * HALF + m * 16);
#pragma unroll
                for (int bj = 0; bj < 2; ++bj) { const int col = col0 + bj * HALF;
                    float gp[8], gc[8]; unpack8(*(const u32x4*)(G + row * LDP + (size_t)(n - 1) * DM + col), gp); unpack8(*(const u32x4*)(G + row * LDP + (size_t)n * DM + col), gc);
#pragma unroll
                    for (int j = 0; j < 4; ++j) { acc[ai][bj][m][0][j] *= fmaxf(gp[j], 1e-30f) * __builtin_amdgcn_rcpf(fmaxf(gc[j], 1e-30f));
                                                  acc[ai][bj][m][1][j] *= fmaxf(gp[4 + j], 1e-30f) * __builtin_amdgcn_rcpf(fmaxf(gc[4 + j], 1e-30f)); } }
                if (m & 1) asm volatile("" ::: "memory"); }
        }
    }
    DI void operator()(const f32x4 (&acc)[2][2][4][2], const Unit& u, int wr, int wc, int fr, int fq) const {
        int row0 = u.pm * BM + wr * 64 + fr, col0 = u.pn * BM + wc * 32 + 8 * fq;
        asm volatile("" : "+v"(row0), "+v"(col0));
#pragma unroll
        for (int ai = 0; ai < 2; ++ai)
#pragma unroll
            for (int m = 0; m < 4; ++m) { const size_t row = (size_t)(row0 + ai * HALF + m * 16);
#pragma unroll
                for (int bj = 0; bj < 2; ++bj) { const int col = col0 + bj * HALF;
                    float g[8]; unpack8(*(const u32x4*)(G + row * LDP + (size_t)3 * DM + col), g);
                    const f32x4 v0 = acc[ai][bj][m][0], v1 = acc[ai][bj][m][1];
                    u32x4 w; w.x = cvt_pk(v0[0] * fmaxf(g[0], 1e-30f), v0[1] * fmaxf(g[1], 1e-30f)); w.y = cvt_pk(v0[2] * fmaxf(g[2], 1e-30f), v0[3] * fmaxf(g[3], 1e-30f));
                    w.z = cvt_pk(v1[0] * fmaxf(g[4], 1e-30f), v1[1] * fmaxf(g[5], 1e-30f)); w.w = cvt_pk(v1[2] * fmaxf(g[6], 1e-30f), v1[3] * fmaxf(g[7], 1e-30f));
                    *(u32x4*)(MB + row * DM + col) = w; } }
    }
};
template <bool NEXT>
struct EpiOut {
    static constexpr bool HOOK = false;
    const float* Xin; float* Xout; bf16_t* XB; float* ssq;
    DI void operator()(const f32x4 (&acc)[2][2][4][2], const Unit& u, int wr, int wc, int fr, int fq) const {
        int row0 = u.pm * BM + wr * 64 + fr, col0 = u.pn * BM + wc * 32 + 8 * fq; const int lane = fq * 16 + fr;
        asm volatile("" : "+v"(row0), "+v"(col0));
#pragma unroll
        for (int ai = 0; ai < 2; ++ai) {
            f32x4 xa[4][2][2];
#pragma unroll
            for (int m = 0; m < 4; ++m)
#pragma unroll
                for (int bj = 0; bj < 2; ++bj) { const size_t off = (size_t)(row0 + ai * HALF + m * 16) * DM + col0 + bj * HALF;
                    xa[m][bj][0] = *(const f32x4*)(Xin + off); xa[m][bj][1] = *(const f32x4*)(Xin + off + 4); }
#pragma unroll
            for (int m = 0; m < 4; ++m) { const int row = row0 + ai * HALF + m * 16; float ss = 0.f;
#pragma unroll
                for (int bj = 0; bj < 2; ++bj) { const size_t off = (size_t)row * DM + col0 + bj * HALF;
                    const f32x4 a = xa[m][bj][0] + acc[ai][bj][m][0], b = xa[m][bj][1] + acc[ai][bj][m][1];
                    *(f32x4*)(Xout + off) = a; *(f32x4*)(Xout + off + 4) = b;
                    if (NEXT) { u32x4 w; w.x = cvt_pk(a[0], a[1]); w.y = cvt_pk(a[2], a[3]); w.z = cvt_pk(b[0], b[1]); w.w = cvt_pk(b[2], b[3]); *(u32x4*)(XB + off) = w;
                        ss += (a[0] * a[0] + a[1] * a[1]) + (a[2] * a[2] + a[3] * a[3]) + (b[0] * b[0] + b[1] * b[1]) + (b[2] * b[2] + b[3] * b[3]); } }
                if (NEXT) { ss += shx(ss, 16, lane); ss += shx(ss, 32, lane); if (fq == 0) atomicAdd(ssq + row, ss); } }
            asm volatile("" ::: "memory");
        }
    }
};

template <class Epi, class Sched>
DI void gemm_phase(LAS unsigned char* lds, const int tid, const int K, const int lda, const int ldb, const Sched& S_, const Epi& E) {
    const int wid = __builtin_amdgcn_readfirstlane(tid >> 6), lane = tid & 63, wr = wid >> 2, wc = wid & 3, fr = lane & 15, fq = lane >> 4;
    const int nt = K / BK;
    unsigned voffA[2], voffB[2];
#pragma unroll
    for (int i = 0; i < 2; ++i) { int R, C; stage_rc(tid * 16 + i * 8192, R, C); const int Rb = (R & ~31) + perm32(R & 31);
        voffA[i] = (unsigned)(R * lda + C) * 2u; voffB[i] = (unsigned)(Rb * ldb + C) * 2u; }
    const size_t kstep = (size_t)(BK * 2);
    const size_t hstepA = (size_t)HALF * lda * 2, hstepB = (size_t)HALF * ldb * 2;
    const unsigned ldsw = (unsigned)wid * 1024u;
    const int aoff = lds_byte(wr * 64 + fr, fq * 8), boff = lds_byte(wc * 32 + fr, fq * 8);
#define PG8_SA(b, h) (((b) * 2 + (h)) * HTB)
#define PG8_SB(b, h) ((4 + (b) * 2 + (h)) * HTB)
#define PG8_STAGE(bufoff, gbase, voff) do { _Pragma("unroll") for (int _i = 0; _i < 2; ++_i) \
        __builtin_amdgcn_global_load_lds((const unsigned*)((const char*)(gbase) + (voff)[_i]), (LAS unsigned*)(lds + (bufoff) + ldsw + _i * 8192), 16, 0, 0); } while (0)
#define PG8_LDA(dst, b, h) do { _Pragma("unroll") for (int m = 0; m < 4; ++m) _Pragma("unroll") for (int k = 0; k < 2; ++k) dst[m][k] = *(const LAS bf16x8*)(lds + PG8_SA(b, h) + aoff + m * 2048 + k * 1024); } while (0)
#define PG8_LDB(dst, b, h) do { _Pragma("unroll") for (int n = 0; n < 2; ++n) _Pragma("unroll") for (int k = 0; k < 2; ++k) dst[n][k] = *(const LAS bf16x8*)(lds + PG8_SB(b, h) + boff + n * 2048 + k * 1024); } while (0)
#define PG8_MMA(ai, bj, At, Bt) do { __builtin_amdgcn_s_setprio(1); _Pragma("unroll") for (int m = 0; m < 4; ++m) _Pragma("unroll") for (int n = 0; n < 2; ++n) _Pragma("unroll") for (int k = 0; k < 2; ++k) \
        acc[ai][bj][m][n] = __builtin_amdgcn_mfma_f32_16x16x32_bf16(Bt[n][k], At[m][k], acc[ai][bj][m][n], 0, 0, 0); __builtin_amdgcn_s_setprio(0); } while (0)
#define PG8_WAIT_V(n) asm volatile("s_waitcnt vmcnt(" #n ")" ::: "memory")
#define PG8_WAIT_L(n) asm volatile("s_waitcnt lgkmcnt(" #n ")" ::: "memory")
#define PG8_BAR __builtin_amdgcn_s_barrier()
#define PG8_SCHED __builtin_amdgcn_sched_barrier(0)
    Unit cur, nxt; int ui = 0;
    if (!S_.next(0, cur)) return;
    f32x4 acc[2][2][4][2];
#pragma unroll
    for (int a = 0; a < 2; ++a)
#pragma unroll
        for (int b = 0; b < 2; ++b)
#pragma unroll
            for (int m = 0; m < 4; ++m)
#pragma unroll
                for (int n = 0; n < 2; ++n) acc[a][b][m][n] = (f32x4){0.f, 0.f, 0.f, 0.f};
    bf16x8 At[4][2], B0[2][2], B1[2][2];
    const char* cA = cur.a; const char* cB = cur.b;
    PG8_STAGE(PG8_SB(0, 0), cB, voffB); PG8_STAGE(PG8_SB(0, 1), cB + hstepB, voffB); PG8_STAGE(PG8_SA(0, 0), cA, voffA); PG8_STAGE(PG8_SA(0, 1), cA + hstepA, voffA);
    if (wr == 1) PG8_BAR;
    PG8_WAIT_V(2); PG8_BAR;
    PG8_STAGE(PG8_SB(1, 0), cB + kstep, voffB); PG8_STAGE(PG8_SA(1, 0), cA + kstep, voffA); PG8_STAGE(PG8_SB(1, 1), cB + hstepB + kstep, voffB);
    PG8_WAIT_V(6); PG8_BAR;
    for (;;) {
        const bool has_next = S_.next(ui + 1, nxt);
        const char* nA = has_next ? nxt.a : cA; const char* nB = has_next ? nxt.b : cB;
        for (int t = 0; t < nt; t += 2) {
            const bool last = (t == nt - 2);
            const char* a1 = cA + (size_t)(t + 1) * kstep;
            const char* a2 = last ? nA : cA + (size_t)(t + 2) * kstep; const char* b2 = last ? nB : cB + (size_t)(t + 2) * kstep;
            const char* a3 = a2 + kstep; const char* b3 = b2 + kstep;
            PG8_LDB(B0, 0, 0); PG8_LDB(B1, 0, 1); PG8_SCHED; PG8_LDA(At, 0, 0); PG8_STAGE(PG8_SA(1, 1), a1 + hstepA, voffA);
            PG8_WAIT_V(8); PG8_WAIT_L(0); PG8_BAR; PG8_MMA(0, 0, At, B0); PG8_MMA(0, 1, At, B1); PG8_BAR; PG8_SCHED;
            PG8_LDA(At, 0, 1); PG8_STAGE(PG8_SB(0, 0), b2, voffB); PG8_STAGE(PG8_SB(0, 1), b2 + hstepB, voffB); PG8_STAGE(PG8_SA(0, 0), a2, voffA);
            PG8_WAIT_V(8); PG8_WAIT_L(0); PG8_BAR; PG8_MMA(1, 0, At, B0); PG8_MMA(1, 1, At, B1); PG8_BAR; PG8_SCHED;
            PG8_LDB(B0, 1, 0); PG8_LDB(B1, 1, 1); PG8_SCHED; PG8_LDA(At, 1, 0); PG8_STAGE(PG8_SA(0, 1), a2 + hstepA, voffA);
            PG8_WAIT_V(8); PG8_WAIT_L(0); PG8_BAR; PG8_MMA(0, 0, At, B0); PG8_MMA(0, 1, At, B1); PG8_BAR; PG8_SCHED;
            PG8_LDA(At, 1, 1); PG8_STAGE(PG8_SB(1, 0), b3, voffB); PG8_STAGE(PG8_SB(1, 1), b3 + hstepB, voffB); PG8_STAGE(PG8_SA(1, 0), a3, voffA);
            PG8_WAIT_V(8); PG8_WAIT_L(0); PG8_BAR; PG8_MMA(1, 0, At, B0); PG8_MMA(1, 1, At, B1); PG8_BAR; PG8_SCHED;
            if constexpr (Epi::HOOK) { if (((t + 2) & 7) == 0 && !last) { E.hook(acc, cur, (t + 2) >> 3, wr, wc, fr, fq); PG8_SCHED; } }
        }
        if (wr == 0) PG8_BAR;
        E(acc, cur, wr, wc, fr, fq);
        if (!has_next) break;
#pragma unroll
        for (int a = 0; a < 2; ++a)
#pragma unroll
            for (int b = 0; b < 2; ++b)
#pragma unroll
                for (int m = 0; m < 4; ++m)
#pragma unroll
                    for (int n = 0; n < 2; ++n) acc[a][b][m][n] = (f32x4){0.f, 0.f, 0.f, 0.f};
        cur = nxt; cA = nA; cB = nB; ++ui;
        if (wr == 1) PG8_BAR;
    }
    PG8_WAIT_V(0);
    PG8_BAR;
#undef PG8_SA
#undef PG8_SB
#undef PG8_STAGE
#undef PG8_LDA
#undef PG8_LDB
#undef PG8_MMA
#undef PG8_WAIT_V
#undef PG8_WAIT_L
#undef PG8_BAR
#undef PG8_SCHED
}
}

#define MFMA32(a, b, c) __builtin_amdgcn_mfma_f32_32x32x16_bf16((a), (b), (c), 0, 0, 0)
typedef short v4i16_t __attribute__((ext_vector_type(4)));
DI s16x4 vtr(const LAS unsigned char* p) { return __builtin_bit_cast(s16x4, __builtin_amdgcn_ds_read_tr16_b64_v4i16((LAS v4i16_t*)p)); }
constexpr float THR = 8.0f;

template <int DQK, int KP>
DI void qk_tile(f32x16& p0, f32x16& p1, const LAS unsigned char* kp, const bf16x8* qf) {
#pragma unroll
    for (int d0 = 0; d0 < DQK / 16; ++d0) {
        const bf16x8 a0 = *(const LAS bf16x8*)(kp + d0 * 32);
        const bf16x8 a1 = *(const LAS bf16x8*)(kp + 32 * KP + d0 * 32);
        p0 = MFMA32(a0, qf[d0], p0); p1 = MFMA32(a1, qf[d0], p1);
    }
}
template <int DV, int VP>
DI void softmax_pv(f32x16& p0, f32x16& p1, float& l, f32x16 (&o)[DV / 32], const LAS unsigned char* vp) {
    float s0 = 0.f, s1 = 0.f, s2 = 0.f, s3 = 0.f;
#pragma unroll
    for (int r = 0; r < 16; r += 4) {
        p0[r] = __builtin_amdgcn_exp2f(p0[r]); p0[r + 1] = __builtin_amdgcn_exp2f(p0[r + 1]); p0[r + 2] = __builtin_amdgcn_exp2f(p0[r + 2]); p0[r + 3] = __builtin_amdgcn_exp2f(p0[r + 3]);
        s0 += p0[r]; s1 += p0[r + 1]; s2 += p0[r + 2]; s3 += p0[r + 3];
    }
#pragma unroll
    for (int r = 0; r < 16; r += 4) {
        p1[r] = __builtin_amdgcn_exp2f(p1[r]); p1[r + 1] = __builtin_amdgcn_exp2f(p1[r + 1]); p1[r + 2] = __builtin_amdgcn_exp2f(p1[r + 2]); p1[r + 3] = __builtin_amdgcn_exp2f(p1[r + 3]);
        s0 += p1[r]; s1 += p1[r + 1]; s2 += p1[r + 2]; s3 += p1[r + 3];
    }
    l += (s0 + s1) + (s2 + s3);
    u32x4 pw[4];
    pw[0] = (u32x4){cvt_pk(p0[0], p0[1]), cvt_pk(p0[2], p0[3]), cvt_pk(p0[4], p0[5]), cvt_pk(p0[6], p0[7])};
    pw[1] = (u32x4){cvt_pk(p0[8], p0[9]), cvt_pk(p0[10], p0[11]), cvt_pk(p0[12], p0[13]), cvt_pk(p0[14], p0[15])};
    pw[2] = (u32x4){cvt_pk(p1[0], p1[1]), cvt_pk(p1[2], p1[3]), cvt_pk(p1[4], p1[5]), cvt_pk(p1[6], p1[7])};
    pw[3] = (u32x4){cvt_pk(p1[8], p1[9]), cvt_pk(p1[10], p1[11]), cvt_pk(p1[12], p1[13]), cvt_pk(p1[14], p1[15])};
#pragma unroll
    for (int d0 = 0; d0 < DV / 32; ++d0)
#pragma unroll
        for (int ks = 0; ks < 4; ++ks) {
            const s16x4 lo = vtr(vp + (16 * ks) * VP + d0 * 64);
            const s16x4 hh = vtr(vp + (16 * ks + 8) * VP + d0 * 64);
            const bf16x8 vf = (bf16x8){lo[0], lo[1], lo[2], lo[3], hh[0], hh[1], hh[2], hh[3]};
            o[d0] = MFMA32(vf, __builtin_bit_cast(bf16x8, pw[ks]), o[d0]);
        }
}

DI void exp_tile(f32x16& p0, f32x16& p1) {
#pragma unroll
    for (int r = 0; r < 16; ++r) p0[r] = __builtin_amdgcn_exp2f(p0[r]);
#pragma unroll
    for (int r = 0; r < 16; ++r) p1[r] = __builtin_amdgcn_exp2f(p1[r]);
}
DI void sum_pack(const f32x16& p0, const f32x16& p1, float& l, u32x4 (&pw)[4]) {
    float s0 = 0.f, s1 = 0.f, s2 = 0.f, s3 = 0.f;
#pragma unroll
    for (int r = 0; r < 16; r += 4) { s0 += p0[r]; s1 += p0[r + 1]; s2 += p0[r + 2]; s3 += p0[r + 3]; }
#pragma unroll
    for (int r = 0; r < 16; r += 4) { s0 += p1[r]; s1 += p1[r + 1]; s2 += p1[r + 2]; s3 += p1[r + 3]; }
    l += (s0 + s1) + (s2 + s3);
    pw[0] = (u32x4){cvt_pk(p0[0], p0[1]), cvt_pk(p0[2], p0[3]), cvt_pk(p0[4], p0[5]), cvt_pk(p0[6], p0[7])};
    pw[1] = (u32x4){cvt_pk(p0[8], p0[9]), cvt_pk(p0[10], p0[11]), cvt_pk(p0[12], p0[13]), cvt_pk(p0[14], p0[15])};
    pw[2] = (u32x4){cvt_pk(p1[0], p1[1]), cvt_pk(p1[2], p1[3]), cvt_pk(p1[4], p1[5]), cvt_pk(p1[6], p1[7])};
    pw[3] = (u32x4){cvt_pk(p1[8], p1[9]), cvt_pk(p1[10], p1[11]), cvt_pk(p1[12], p1[13]), cvt_pk(p1[14], p1[15])};
}
template <int DV, int VP>
DI void pv_tile(f32x16 (&o)[DV / 32], const u32x4 (&pw)[4], const LAS unsigned char* vp) {
#pragma unroll
    for (int kh = 0; kh < 2; ++kh) {
        bf16x8 vf[DV / 32][2];
#pragma unroll
        for (int d0 = 0; d0 < DV / 32; ++d0)
#pragma unroll
            for (int k2 = 0; k2 < 2; ++k2) { const int ks = 2 * kh + k2;
                const s16x4 lo = vtr(vp + (16 * ks) * VP + d0 * 64);
                const s16x4 hh = vtr(vp + (16 * ks + 8) * VP + d0 * 64);
                vf[d0][k2] = (bf16x8){lo[0], lo[1], lo[2], lo[3], hh[0], hh[1], hh[2], hh[3]}; }
#pragma unroll
        for (int k2 = 0; k2 < 2; ++k2)
#pragma unroll
            for (int d0 = 0; d0 < DV / 32; ++d0) o[d0] = MFMA32(vf[d0][k2], __builtin_bit_cast(bf16x8, pw[2 * kh + k2]), o[d0]);
    }
}

typedef __bf16 bf16x2_t __attribute__((ext_vector_type(2)));
DI float dot2_ones(unsigned packed, float c) { return __builtin_amdgcn_fdot2_f32_bf16(__builtin_bit_cast(bf16x2_t, packed), __builtin_bit_cast(bf16x2_t, 0x3f803f80u), c, false); }
DI void rowsum_pw(const u32x4 (&pw)[4], float (&ls)[4]) {
#pragma unroll
    for (int w = 0; w < 16; ++w) ls[w & 3] = dot2_ones(pw[w >> 2][w & 3], ls[w & 3]);
}
DI void pack_tile(const f32x16& p0, const f32x16& p1, u32x4 (&pw)[4]) {
    pw[0] = (u32x4){cvt_pk(p0[0], p0[1]), cvt_pk(p0[2], p0[3]), cvt_pk(p0[4], p0[5]), cvt_pk(p0[6], p0[7])};
    pw[1] = (u32x4){cvt_pk(p0[8], p0[9]), cvt_pk(p0[10], p0[11]), cvt_pk(p0[12], p0[13]), cvt_pk(p0[14], p0[15])};
    pw[2] = (u32x4){cvt_pk(p1[0], p1[1]), cvt_pk(p1[2], p1[3]), cvt_pk(p1[4], p1[5]), cvt_pk(p1[6], p1[7])};
    pw[3] = (u32x4){cvt_pk(p1[8], p1[9]), cvt_pk(p1[10], p1[11]), cvt_pk(p1[12], p1[13]), cvt_pk(p1[14], p1[15])};
}
template <int DQK, int KP, int DV, int VP, bool CONSTC, int KWIN = 8, bool ONES = false>
DI void tile_step(u32x4 (&pw)[4], f32x16& pn0, f32x16& pn1, const f32x16& cvec, float (&ls)[4], f32x16 (&o)[DV / 32], const bf16x8* qf,
                  const LAS unsigned char* kp, const LAS unsigned char* vp, f32x16* osum = nullptr, bf16x8 onesf = bf16x8{}) {
    constexpr int NKS = DQK / 16, NQK = 2 * NKS, ND0 = DV / 32, NPV = 4 * ND0, EPG = 32 / NPV, W = (DV > 64) ? 4 : 8;
#define SB_ __builtin_amdgcn_sched_barrier(0)
#define VFRAG(f) do { const int ks_ = (f) / ND0, d0_ = (f) % ND0; const s16x4 lo_ = vtr(vp + (16 * ks_) * VP + d0_ * 64); const s16x4 hh_ = vtr(vp + (16 * ks_ + 8) * VP + d0_ * 64); \
        vf[(f) % W] = (bf16x8){lo_[0], lo_[1], lo_[2], lo_[3], hh_[0], hh_[1], hh_[2], hh_[3]}; } while (0)
#define KFRAG(i) do { kf[(i) % KWIN] = *(const LAS bf16x8*)(kp + ((i) & 1) * 32 * KP + ((i) >> 1) * 32); } while (0)
#define PVAL(r) ((r) < 16 ? pn0[(r) & 15] : pn1[(r) & 15])
    bf16x8 kf[KWIN];
#pragma unroll
    for (int i = 0; i < KWIN; ++i) KFRAG(i);
    SB_;
    bf16x8 vf[W]; u32x4 pwn[4];
#pragma unroll
    for (int i = 0; i < NQK; ++i) {
        if (CONSTC && i < 2) { if (i == 0) pn0 = MFMA32(kf[0], qf[0], cvec); else pn1 = MFMA32(kf[1], qf[0], cvec); }
        else if ((i & 1) == 0) pn0 = MFMA32(kf[i % KWIN], qf[i >> 1], pn0); else pn1 = MFMA32(kf[i % KWIN], qf[i >> 1], pn1);
        if (i + KWIN < NQK) KFRAG(i + KWIN);
        if (i < W) VFRAG(i);
        if (!ONES && i < 8) { ls[(2 * i) & 3] = dot2_ones(pw[(2 * i) >> 2][(2 * i) & 3], ls[(2 * i) & 3]); ls[(2 * i + 1) & 3] = dot2_ones(pw[(2 * i + 1) >> 2][(2 * i + 1) & 3], ls[(2 * i + 1) & 3]); }
        SB_;
        if (ONES && (i & 1) && i < 8) { *osum = MFMA32(onesf, __builtin_bit_cast(bf16x8, pw[i >> 1]), *osum); SB_; }
    }
#pragma unroll
    for (int j = 0; j < NPV; ++j) {
        o[j % ND0] = MFMA32(vf[j % W], __builtin_bit_cast(bf16x8, pw[j / ND0]), o[j % ND0]);
        if (j + W < NPV) VFRAG(j + W);
#pragma unroll
        for (int e = 0; e < EPG; ++e) { const int r = j * EPG + e;
            if (r < 16) pn0[r] = __builtin_amdgcn_exp2f(pn0[r]); else pn1[r - 16] = __builtin_amdgcn_exp2f(pn1[r - 16]); }
        if (j > 0) {
#pragma unroll
            for (int e = 0; e < EPG; e += 2) { const int r = (j - 1) * EPG + e; pwn[(r >> 1) >> 2][(r >> 1) & 3] = cvt_pk(PVAL(r), PVAL(r + 1)); }
        }
        SB_;
    }
#pragma unroll
    for (int e = 0; e < EPG; e += 2) { const int r = (NPV - 1) * EPG + e; pwn[(r >> 1) >> 2][(r >> 1) & 3] = cvt_pk(PVAL(r), PVAL(r + 1)); }
#pragma unroll
    for (int k = 0; k < 4; ++k) pw[k] = pwn[k];
#undef PVAL
#undef KFRAG
#undef VFRAG
#undef SB_
}

template <int KW, int DQK, int DV, int MODE>
DI void attn_dense(LAS unsigned char* lds, const int tid, const bf16_t* Qw, int qpitch, const bf16_t* Kb, int kpitch, const bf16_t* Vb, int vpitch, int kco,
                   int qtok0, const LAS float* dtab, float nbound, int rot, f32x16 (&o)[DV / 32], float& l_out) {
    constexpr int KP = KW * 2 + 16, VP = DV * 2 + 64, KT = 64 * KP, VT = 64 * VP;
    constexpr int KCH = KW / 8, NKC = 64 * KCH, KPT = (NKC + 511) / 512, VCH = DV / 8, NVC = 64 * VCH, VPT = NVC / 512;
    const int lane = tid & 63, r32 = lane & 31, hi = lane >> 5;
    bf16x8 qf[DQK / 16];
#pragma unroll
    for (int d0 = 0; d0 < DQK / 16; ++d0) qf[d0] = *(const bf16x8*)(Qw + (size_t)r32 * qpitch + d0 * 16 + hi * 8);
    u32x4 kreg[KPT], vreg[VPT];
    unsigned kgo[KPT], klo[KPT], vgo[VPT], vlo[VPT];
#pragma unroll
    for (int i_ = 0; i_ < KPT; ++i_) { const int c_ = tid + i_ * 512; const int key_ = c_ / KCH, part_ = c_ % KCH; kgo[i_] = (unsigned)(key_ * kpitch + part_ * 8) * 2u; klo[i_] = (unsigned)(key_ * KP + part_ * 16); }
#pragma unroll
    for (int i_ = 0; i_ < VPT; ++i_) { const int c_ = tid + i_ * 512; const int key_ = c_ / VCH, part_ = c_ % VCH; vgo[i_] = (unsigned)(key_ * vpitch + part_ * 8) * 2u; vlo[i_] = (unsigned)(2 * KT + key_ * VP + part_ * 16); }
    const bool kact1 = (NKC % 512 == 0) || (tid + (KPT - 1) * 512 < NKC);
#define AD_TILE(t) (((t) + rot) & (S / 64 - 1))
#define AD_GLOAD_K(t) do { const char* kt_ = (const char*)Kb + (size_t)AD_TILE(t) * 64 * kpitch * 2; \
    _Pragma("unroll") for (int i_ = 0; i_ < KPT; ++i_) { if (MODE == 1) asm volatile("" : "+v"(kgo[i_])); if (i_ + 1 < KPT || kact1) kreg[i_] = *(const u32x4*)(kt_ + kgo[i_]); } } while (0)
#define AD_GLOAD_V(t) do { const char* vt_ = (const char*)Vb + (size_t)AD_TILE(t) * 64 * vpitch * 2; \
    _Pragma("unroll") for (int i_ = 0; i_ < VPT; ++i_) { if (MODE == 1) asm volatile("" : "+v"(vgo[i_])); vreg[i_] = *(const u32x4*)(vt_ + vgo[i_]); } } while (0)
#define AD_LSTORE_K(b) do { \
    _Pragma("unroll") for (int i_ = 0; i_ < KPT; ++i_) { if (i_ + 1 < KPT || kact1) *(LAS u32x4*)(lds + (b) * KT + klo[i_]) = kreg[i_]; } } while (0)
#define AD_LSTORE_V(b) do { \
    _Pragma("unroll") for (int i_ = 0; i_ < VPT; ++i_) *(LAS u32x4*)(lds + (b) * VT + vlo[i_]) = vreg[i_]; } while (0)
#define AD_CINIT(P0, P1, t) do { \
        if (MODE == 1) { \
            const int k0_ = AD_TILE(t) * 64, minrel_ = k0_ - (qtok0 + 31), maxrel_ = k0_ + 63 - qtok0; \
            if (minrel_ >= 559 || maxrel_ <= -559) { \
                const float c_ = (minrel_ >= 559 ? dtab[2046] : dtab[0]); \
                _Pragma("unroll") for (int r = 0; r < 16; ++r) { P0[r] = c_; P1[r] = c_; } \
            } else { \
                const LAS float* tp_ = dtab + (k0_ - qtok0 - r32 + 4 * hi + 1023); \
                _Pragma("unroll") for (int r = 0; r < 16; ++r) { P0[r] = tp_[(r & 3) + 8 * (r >> 2)]; P1[r] = tp_[32 + (r & 3) + 8 * (r >> 2)]; } \
            } \
        } else { \
            _Pragma("unroll") for (int r = 0; r < 16; ++r) { P0[r] = nbound; P1[r] = nbound; } \
        } } while (0)
    float l = 0.f;
#pragma unroll
    for (int d0 = 0; d0 < DV / 32; ++d0)
#pragma unroll
        for (int r = 0; r < 16; ++r) o[d0][r] = 0.f;
    constexpr int NT = S / 64;
    const int koff = r32 * KP + (kco + hi * 8) * 2;
    const int voff = 2 * KT + (4 * hi + ((lane & 15) >> 2)) * VP + (((lane >> 4) & 1) * 16 + (lane & 3) * 4) * 2;
    AD_GLOAD_K(0); AD_LSTORE_K(0);
    __syncthreads();
    AD_GLOAD_K(1); AD_GLOAD_V(0);
    u32x4 pw[4];
    { f32x16 pc0, pc1;
      AD_CINIT(pc0, pc1, 0);
      qk_tile<DQK, KP>(pc0, pc1, lds + koff, qf);
      exp_tile(pc0, pc1);
      pack_tile(pc0, pc1, pw); }
    AD_LSTORE_K(1); AD_LSTORE_V(0);
    __syncthreads();
    float ls[4] = {0.f, 0.f, 0.f, 0.f};
    f32x16 osum;
#pragma unroll
    for (int r = 0; r < 16; ++r) osum[r] = 0.f;
    bf16x8 onesf;
#pragma unroll
    for (int j = 0; j < 8; ++j) onesf[j] = (r32 == 0) ? (short)0x3f80 : (short)0;
    f32x16 cvec;
#pragma unroll
    for (int r = 0; r < 16; ++r) cvec[r] = nbound;
    asm volatile("" : "+v"(cvec));
#define AD_STEP(CONSTC_, INIT_) do { \
        const int tn = (t + 1 < NT) ? t + 1 : NT - 1;         \
        AD_GLOAD_K(tn); \
        AD_GLOAD_V(t); \
        f32x16 pn0, pn1; \
        INIT_; \
        __builtin_amdgcn_sched_barrier(0); \
        tile_step<DQK, KP, DV, VP, CONSTC_, 4, MODE == 0>(pw, pn0, pn1, cvec, ls, o, qf, lds + (t & 1) * KT + koff, lds + ((t - 1) & 1) * VT + voff, &osum, onesf); \
        AD_LSTORE_K((t + 1) & 1); \
        AD_LSTORE_V(t & 1); \
        __syncthreads(); } while (0)
    if (MODE == 1) {
        int t1 = (qtok0 - 622 >= 0) ? (qtok0 - 622) / 64 + 1 : 0; t1 = t1 < 1 ? 1 : (t1 > NT ? NT : t1);
        int t2 = (qtok0 + 590 + 63) / 64; t2 = t2 < t1 ? t1 : (t2 > NT ? NT : t2);
        int t = 1;
        { const float c_ = dtab[0];
#pragma unroll
          for (int r = 0; r < 16; ++r) cvec[r] = c_;
          asm volatile("" : "+v"(cvec)); }
        for (; t < t1; ++t) AD_STEP(true, (void)0);
        for (; t < t2; ++t) AD_STEP(false, AD_CINIT(pn0, pn1, t));
        { const float c_ = dtab[2046];
#pragma unroll
          for (int r = 0; r < 16; ++r) cvec[r] = c_;
          asm volatile("" : "+v"(cvec)); }
        for (; t < NT; ++t) AD_STEP(true, (void)0);
    } else {
        for (int t = 1; t < NT; ++t) AD_STEP(true, (void)0);
    }
#undef AD_STEP
    rowsum_pw(pw, ls);
    pv_tile<DV, VP>(o, pw, lds + ((NT - 1) & 1) * VT + voff);
    l = (ls[0] + ls[1]) + (ls[2] + ls[3]);
    __syncthreads();
#undef AD_GLOAD_K
#undef AD_TILE
#undef AD_GLOAD_V
#undef AD_LSTORE_K
#undef AD_LSTORE_V
#undef AD_CINIT
    l += shx(l, 32, lane);
    if (MODE == 0) l += __int_as_float(__builtin_amdgcn_ds_bpermute((lane & 31) << 2, __float_as_int(osum[0])));
    l_out = l;
}

template <int KW, int DQK, int DV>
DI void attn_dense_pair(LAS unsigned char* lds, const int tid, const bf16_t* Qw, int qpitch, const bf16_t* Kb, int kpitch, const bf16_t* Vb, int vpitch,
                        float nbound, f32x16 (&o)[DV / 32], float& l_out) {
    constexpr int KP = KW * 2 + 16, VP = DV * 2 + 64, KT = 64 * KP, VT = 64 * VP;
    constexpr int KCH = KW / 8, NKC = 64 * KCH, KPT = (NKC + 511) / 512, VCH = DV / 8, NVC = 64 * VCH, VPT = NVC / 512;
    const int lane = tid & 63, r32 = lane & 31, hi = lane >> 5;
    bf16x8 qf[DQK / 16];
#pragma unroll
    for (int d0 = 0; d0 < DQK / 16; ++d0) qf[d0] = *(const bf16x8*)(Qw + (size_t)r32 * qpitch + d0 * 16 + hi * 8);
    u32x4 kreg[2][KPT], vreg[2][VPT];
    unsigned kgo[KPT], klo[KPT], vgo[VPT], vlo[VPT];
#pragma unroll
    for (int i_ = 0; i_ < KPT; ++i_) { const int c_ = tid + i_ * 512; const int key_ = c_ / KCH, part_ = c_ % KCH; kgo[i_] = (unsigned)(key_ * kpitch + part_ * 8) * 2u; klo[i_] = (unsigned)(key_ * KP + part_ * 16); }
#pragma unroll
    for (int i_ = 0; i_ < VPT; ++i_) { const int c_ = tid + i_ * 512; const int key_ = c_ / VCH, part_ = c_ % VCH; vgo[i_] = (unsigned)(key_ * vpitch + part_ * 8) * 2u; vlo[i_] = (unsigned)(4 * KT + key_ * VP + part_ * 16); }
    const bool kact1 = (NKC % 512 == 0) || (tid + (KPT - 1) * 512 < NKC);
    constexpr int NT = S / 64;
#define AP_CL(t) ((t) < NT ? (t) : NT - 1)
#define AP_GLOAD_K(j, t) do { const char* kt_ = (const char*)Kb + (size_t)AP_CL(t) * 64 * kpitch * 2; \
    _Pragma("unroll") for (int i_ = 0; i_ < KPT; ++i_) { if (i_ + 1 < KPT || kact1) kreg[j][i_] = *(const u32x4*)(kt_ + kgo[i_]); } } while (0)
#define AP_GLOAD_V(j, t) do { const char* vt_ = (const char*)Vb + (size_t)AP_CL(t) * 64 * vpitch * 2; \
    _Pragma("unroll") for (int i_ = 0; i_ < VPT; ++i_) vreg[j][i_] = *(const u32x4*)(vt_ + vgo[i_]); } while (0)
#define AP_LSTORE_K(j, t) do { \
    _Pragma("unroll") for (int i_ = 0; i_ < KPT; ++i_) { if (i_ + 1 < KPT || kact1) *(LAS u32x4*)(lds + ((t) & 3) * KT + klo[i_]) = kreg[j][i_]; } } while (0)
#define AP_LSTORE_V(j, t) do { \
    _Pragma("unroll") for (int i_ = 0; i_ < VPT; ++i_) *(LAS u32x4*)(lds + ((t) & 3) * VT + vlo[i_]) = vreg[j][i_]; } while (0)
#pragma unroll
    for (int d0 = 0; d0 < DV / 32; ++d0)
#pragma unroll
        for (int r = 0; r < 16; ++r) o[d0][r] = 0.f;
    const int koff = r32 * KP + hi * 16;
    const int voff = 4 * KT + (4 * hi + ((lane & 15) >> 2)) * VP + (((lane >> 4) & 1) * 16 + (lane & 3) * 4) * 2;
    AP_GLOAD_K(0, 0); AP_LSTORE_K(0, 0);
    __syncthreads();
    AP_GLOAD_K(0, 1); AP_GLOAD_K(1, 2); AP_GLOAD_V(0, 0); AP_GLOAD_V(1, 1);
    u32x4 pw[4];
    { f32x16 pc0, pc1;
#pragma unroll
      for (int r = 0; r < 16; ++r) { pc0[r] = nbound; pc1[r] = nbound; }
      qk_tile<DQK, KP>(pc0, pc1, lds + koff, qf);
      exp_tile(pc0, pc1);
      pack_tile(pc0, pc1, pw); }
    AP_LSTORE_K(0, 1); AP_LSTORE_K(1, 2); AP_LSTORE_V(0, 0); AP_LSTORE_V(1, 1);
    __syncthreads();
    float ls[4] = {0.f, 0.f, 0.f, 0.f};
    f32x16 osum;
#pragma unroll
    for (int r = 0; r < 16; ++r) osum[r] = 0.f;
    bf16x8 onesf;
#pragma unroll
    for (int j = 0; j < 8; ++j) onesf[j] = (r32 == 0) ? (short)0x3f80 : (short)0;
    f32x16 cvec;
#pragma unroll
    for (int r = 0; r < 16; ++r) cvec[r] = nbound;
    asm volatile("" : "+v"(cvec));
    for (int t = 1; t + 1 < NT; t += 2) {
        AP_GLOAD_K(0, t + 2); AP_GLOAD_K(1, t + 3); AP_GLOAD_V(0, t + 1); AP_GLOAD_V(1, t + 2);
        f32x16 pn0, pn1;
        __builtin_amdgcn_sched_barrier(0);
        tile_step<DQK, KP, DV, VP, true, 4, true>(pw, pn0, pn1, cvec, ls, o, qf, lds + (t & 3) * KT + koff, lds + ((t - 1) & 3) * VT + voff, &osum, onesf);
        __builtin_amdgcn_sched_barrier(0);
        tile_step<DQK, KP, DV, VP, true, 4, true>(pw, pn0, pn1, cvec, ls, o, qf, lds + ((t + 1) & 3) * KT + koff, lds + (t & 3) * VT + voff, &osum, onesf);
        AP_LSTORE_K(0, t + 2); AP_LSTORE_K(1, t + 3); AP_LSTORE_V(0, t + 1); AP_LSTORE_V(1, t + 2);
        __syncthreads();
    }
    { f32x16 pn0, pn1;
      tile_step<DQK, KP, DV, VP, true, 4, true>(pw, pn0, pn1, cvec, ls, o, qf, lds + ((NT - 1) & 3) * KT + koff, lds + ((NT - 2) & 3) * VT + voff, &osum, onesf); }
    rowsum_pw(pw, ls);
    pv_tile<DV, VP>(o, pw, lds + ((NT - 1) & 3) * VT + voff);
    float l = (ls[0] + ls[1]) + (ls[2] + ls[3]);
    __syncthreads();
#undef AP_CL
#undef AP_GLOAD_K
#undef AP_GLOAD_V
#undef AP_LSTORE_K
#undef AP_LSTORE_V
    l += shx(l, 32, lane);
    l += __int_as_float(__builtin_amdgcn_ds_bpermute((lane & 31) << 2, __float_as_int(osum[0])));
    l_out = l;
}

DI float uni(float v) { return __int_as_float(__builtin_amdgcn_readfirstlane(__float_as_int(v))); }
DI float wave_absmax(const float* w, int n, int lane) {
    float m = 0.f;
    for (int i = lane; i < n; i += 64) m = fmaxf(m, fabsf(w[i]));
#pragma unroll
    for (int o = 1; o < 64; o <<= 1) m = fmaxf(m, shx(m, o, lane));
    return m;
}

DI void store_y64(const f32x16 (&o)[2], float linv, bf16_t* Y, const bf16_t* proj, int token, int ycol, int hi) {
#pragma unroll
    for (int d0 = 0; d0 < 2; ++d0)
#pragma unroll
        for (int g = 0; g < 4; ++g) {
            const int col = ycol + 32 * d0 + 8 * g + 4 * hi;
            const u32x2 gv = *(const u32x2*)(proj + (size_t)token * LDP + C_SILU + col);
            u32x2 w;
            w.x = cvt_pk(o[d0][4 * g + 0] * linv * bflo(gv.x), o[d0][4 * g + 1] * linv * bfhi(gv.x));
            w.y = cvt_pk(o[d0][4 * g + 2] * linv * bflo(gv.y), o[d0][4 * g + 3] * linv * bfhi(gv.y));
            *(u32x2*)(Y + (size_t)token * DM + col) = w;
        }
}

struct Params {
    const float* x; const float* norm_w; const float* w_in; const float* mla_q_norm; const float* mla_kv_norm; const float* mla_w_uq; const float* mla_w_ukv;
    const float* mla_qk_norm; const float* gqa_qk_norm; const float* dil_qk_norm; const float* diff_qk_norm; const float* diff_lambda; const float* diff_subnorm;
    const float* rel_bias; const float* w_branch; const float* w_out; float* out; unsigned char* ws;
};

DI float wave_sum(float v, int lane) {
#pragma unroll
    for (int o = 1; o < 64; o <<= 1) v += shx(v, o, lane);
    return v;
}
DI unsigned f2bf(float f) { unsigned u = __float_as_uint(f); return (u + 0x7fffu + ((u >> 16) & 1u)) >> 16; }
DI unsigned pk2(float lo, float hi) { return cvt_pk(lo, hi); }

DI void transpose_item(const float* W, int K, int N, bf16_t* WT, int ldk, const float* ksc, LAS float* scr, int item, int lane) {
    const int nblk = N / 32, kb = item / nblk, nb = item % nblk, k0 = 64 * kb, n0 = 32 * nb;
    { f32x4 v[8]; const int n4 = (lane & 7) * 4, kr = lane >> 3;
#pragma unroll
      for (int i = 0; i < 8; ++i) v[i] = *(const f32x4*)(W + (size_t)(k0 + 8 * i + kr) * N + n0 + n4);
#pragma unroll
      for (int i = 0; i < 8; ++i) { LAS float* d = scr + (8 * i + kr) * 33 + n4; d[0] = v[i].x; d[1] = v[i].y; d[2] = v[i].z; d[3] = v[i].w; } }
    const int c = lane & 7;
    f32x4 sc0 = (f32x4){1.f, 1.f, 1.f, 1.f}, sc1 = sc0;
    if (ksc) { sc0 = *(const f32x4*)(ksc + k0 + 8 * c); sc1 = *(const f32x4*)(ksc + k0 + 8 * c + 4); }
    asm volatile("s_waitcnt lgkmcnt(0)" ::: "memory");
#pragma unroll
    for (int j = 0; j < 4; ++j) { const int n = (lane >> 3) + 8 * j; const LAS float* s = scr + (8 * c) * 33 + n;
        u32x4 o; o.x = pk2(s[0 * 33] * sc0.x, s[1 * 33] * sc0.y); o.y = pk2(s[2 * 33] * sc0.z, s[3 * 33] * sc0.w); o.z = pk2(s[4 * 33] * sc1.x, s[5 * 33] * sc1.y); o.w = pk2(s[6 * 33] * sc1.z, s[7 * 33] * sc1.w);
        *(u32x4*)(WT + (size_t)(n0 + n) * ldk + k0 + 8 * c) = o; }
    asm volatile("s_waitcnt lgkmcnt(0)" ::: "memory");
}

DI void transpose_item_in(const float* W, bf16_t* WT, const float* ksc, LAS float* scr, int item, int lane) {
    constexpr int nblk = LDP / 32;
    const int kb = item / nblk, nb = item % nblk, k0 = 64 * kb, n0 = 32 * nb;
    { f32x4 v[8]; const int n4 = (lane & 7) * 4, kr = lane >> 3; const int sc = in_src_col(n0 + n4);
#pragma unroll
      for (int i = 0; i < 8; ++i) v[i] = sc >= 0 ? *(const f32x4*)(W + (size_t)(k0 + 8 * i + kr) * NIN + sc) : (f32x4){0.f, 0.f, 0.f, 0.f};
#pragma unroll
      for (int i = 0; i < 8; ++i) { LAS float* d = scr + (8 * i + kr) * 33 + n4; d[0] = v[i].x; d[1] = v[i].y; d[2] = v[i].z; d[3] = v[i].w; } }
    const int c = lane & 7;
    const f32x4 sc0 = *(const f32x4*)(ksc + k0 + 8 * c), sc1 = *(const f32x4*)(ksc + k0 + 8 * c + 4);
    asm volatile("s_waitcnt lgkmcnt(0)" ::: "memory");
#pragma unroll
    for (int j = 0; j < 4; ++j) { const int n = (lane >> 3) + 8 * j; const LAS float* s = scr + (8 * c) * 33 + n;
        u32x4 o; o.x = pk2(s[0 * 33] * sc0.x, s[1 * 33] * sc0.y); o.y = pk2(s[2 * 33] * sc0.z, s[3 * 33] * sc0.w); o.z = pk2(s[4 * 33] * sc1.x, s[5 * 33] * sc1.y); o.w = pk2(s[6 * 33] * sc1.z, s[7 * 33] * sc1.w);
        *(u32x4*)(WT + (size_t)(n0 + n) * DM + k0 + 8 * c) = o; }
    asm volatile("s_waitcnt lgkmcnt(0)" ::: "memory");
}

DI int rel_bucket(int rel) {
    const int side = rel > 0 ? 16 : 0; const int n = rel < 0 ? -rel : rel;
    const float nf = (float)(n > 1 ? n : 1);
    int large = 8 + (int)(logf(nf / 8.0f) / logf(128.0f) * 8.0f);
    large = large < 15 ? large : 15;
    return side + (n < 8 ? n : large);
}


#define XB_TMO      128
#define XB_XCNT(j)  (256  + 64 * (j))
#define XB_XSUB(j)  (1280 + 64 * (j))
#define XB_XGEN(j)  (2304 + 64 * (j))
#define XB_TOP      3328
#define XB_TOPGEN   3392
#define XCD_BAR_WORDS 3456
#define XB_SPIN_CAP (1u << 22)
DI unsigned xb_ld(unsigned* p)              { return __hip_atomic_load(p, __ATOMIC_RELAXED, __HIP_MEMORY_SCOPE_AGENT); }
DI unsigned xb_add(unsigned* p, unsigned v) { return __hip_atomic_fetch_add(p, v, __ATOMIC_RELAXED, __HIP_MEMORY_SCOPE_AGENT); }
DI unsigned xb_xcc_id() { return (unsigned)__builtin_amdgcn_s_getreg((3 << 11) | 20) & 0xFu; }
#define XB_SPIN(cond, bar) do { unsigned _sp = 0; while (cond) { __builtin_amdgcn_s_sleep(1); \
    if ((++_sp & 255u) == 0u) { if (xb_ld(&(bar)[XB_TMO])) break; if (_sp > XB_SPIN_CAP) { atomicAdd(&(bar)[XB_TMO], 1u); break; } } } } while (0)
DI void xcd_barrier_complete(unsigned* bar, unsigned x, unsigned& nloc, unsigned& nx) {
    const unsigned G = gridDim.x * gridDim.y * gridDim.z;
    unsigned sum, cnt, mine, sp = 0u;
    for (;;) {
        sum = 0u; cnt = 0u; mine = 0u;
#pragma unroll
        for (unsigned j = 0; j < 16; ++j) { const unsigned c = xb_ld(&bar[XB_XCNT(j)]); sum += c; cnt += (c > 0u) ? 1u : 0u; mine = (j == x) ? c : mine; }
        if (sum == G) break;
        __builtin_amdgcn_s_sleep(1);
        if ((++sp & 255u) == 0u) { if (xb_ld(&bar[XB_TMO])) break; if (sp > XB_SPIN_CAP) { atomicAdd(&bar[XB_TMO], 1u); break; } }
    }
    nloc = mine > 0u ? mine : 1u; nx = cnt > 0u ? cnt : 1u;
}
DI void xcd_barrier(unsigned* bar, volatile LAS unsigned* st, int wid0) {
    asm volatile("s_waitcnt vmcnt(0)" ::: "memory");
    __syncthreads();
    if (wid0 == 0 && __builtin_amdgcn_mbcnt_hi(~0u, __builtin_amdgcn_mbcnt_lo(~0u, 0u)) == 0u) {
        const unsigned x = xb_xcc_id();
        __builtin_amdgcn_s_waitcnt(0);
        unsigned nloc = st[0], nx = st[1];
        if (nloc == 0u) { xcd_barrier_complete(bar, x, nloc, nx); st[0] = nloc; st[1] = nx; }
        const unsigned old = xb_add(&bar[XB_XSUB(x)], 1u);
        const unsigned gen = old / nloc;
        if (old + 1u == (gen + 1u) * nloc) {
            __builtin_amdgcn_fence(__ATOMIC_RELEASE, "agent");
            asm volatile("s_waitcnt vmcnt(0)" ::: "memory");
            const unsigned og = xb_add(&bar[XB_TOP], 1u);
            const unsigned tg = og / nx;
            if (og + 1u == (tg + 1u) * nx) xb_add(&bar[XB_TOPGEN], 1u);
            else XB_SPIN(xb_ld(&bar[XB_TOPGEN]) == tg, bar);
            __builtin_amdgcn_fence(__ATOMIC_ACQUIRE, "agent");
            xb_add(&bar[XB_XGEN(x)], 1u);
            asm volatile("s_waitcnt vmcnt(0)" ::: "memory");
        } else {
            XB_SPIN(xb_ld(&bar[XB_XGEN(x)]) == gen, bar);
            __builtin_amdgcn_fence(__ATOMIC_ACQUIRE, "agent");
            asm volatile("s_waitcnt vmcnt(0)" ::: "memory");
        }
    }
    __syncthreads();
}

DI void xcd_arrive(unsigned* bar, volatile LAS unsigned* st, int wid0) {
    asm volatile("s_waitcnt vmcnt(0)" ::: "memory");
    __syncthreads();
    if (wid0 == 0 && __builtin_amdgcn_mbcnt_hi(~0u, __builtin_amdgcn_mbcnt_lo(~0u, 0u)) == 0u) {
        const unsigned x = xb_xcc_id();
        __builtin_amdgcn_s_waitcnt(0);
        const unsigned nloc = st[0], nx = st[1];
        const unsigned old = xb_add(&bar[XB_XSUB(x)], 1u);
        const unsigned gen = old / nloc;
        if (old + 1u == (gen + 1u) * nloc) {
            __builtin_amdgcn_fence(__ATOMIC_RELEASE, "agent");
            asm volatile("s_waitcnt vmcnt(0)" ::: "memory");
            const unsigned og = xb_add(&bar[XB_TOP], 1u);
            const unsigned tg = og / nx;
            if (og + 1u == (tg + 1u) * nx) xb_add(&bar[XB_TOPGEN], 1u);
        }
    }
}
DI void xcd_wait(unsigned* bar, unsigned target, int wid0) {
    if (wid0 == 0 && __builtin_amdgcn_mbcnt_hi(~0u, __builtin_amdgcn_mbcnt_lo(~0u, 0u)) == 0u) {
        XB_SPIN(xb_ld(&bar[XB_TOPGEN]) < target, bar);
        __builtin_amdgcn_fence(__ATOMIC_ACQUIRE, "agent");
        asm volatile("s_waitcnt vmcnt(0)" ::: "memory");
    }
    __syncthreads();
}

__global__ void __launch_bounds__(512) mega(Params P) {
    extern __shared__ __attribute__((aligned(16))) unsigned char lds_raw[];
    LAS unsigned char* lds = (LAS unsigned char*)lds_raw;
    cg::grid_group grid = cg::this_grid();
    volatile LAS unsigned* bst = (volatile LAS unsigned*)(lds + LDS_BYTES - 16);
    unsigned* barw = (unsigned*)(P.ws + WS_BAR);
    if (threadIdx.x == 0) { bst[0] = 0u; bst[1] = 0u; }
    if (blockIdx.x == 0) for (int i = threadIdx.x; i < 2 * XCD_BAR_WORDS; i += 512) __hip_atomic_store(&barw[i], 0u, __ATOMIC_RELAXED, __HIP_MEMORY_SCOPE_AGENT);
    __syncthreads();
#define GRID_SYNC() xcd_barrier(barw, bst, wid0)
#define XCD_ARRIVE() xcd_arrive(barw + XCD_BAR_WORDS, bst, wid0)
#define XCD_WAIT(g) xcd_wait(barw + XCD_BAR_WORDS, (unsigned)(g), wid0)
    const int wid0 = __builtin_amdgcn_readfirstlane((int)threadIdx.x >> 6);
#define RELANE(x) int x = (int)__builtin_amdgcn_mbcnt_hi(~0u, __builtin_amdgcn_mbcnt_lo(~0u, 0u)); asm volatile("" : "+v"(x));
#define PHASE_BEGIN \
    int wid = wid0; asm volatile("" : "+s"(wid)); \
    int lane = (int)__builtin_amdgcn_mbcnt_hi(~0u, __builtin_amdgcn_mbcnt_lo(~0u, 0u)); asm volatile("" : "+v"(lane)); \
    const int tid = wid * 64 + lane; \
    int bx = blockIdx.x; asm volatile("" : "+s"(bx)); \
    const int G = gridDim.x; \
    const int gw = bx * 8 + wid, NGW = G * 8, gt = bx * 512 + tid, NGT = G * 512; \
    const int vcu = (G % 8 == 0) ? (bx % 8) * (G / 8) + bx / 8 : bx; \
    size_t wsz_ = 0; asm volatile("" : "+s"(wsz_)); unsigned char* ws = P.ws + wsz_; \
    bf16_t* WinT = (bf16_t*)(ws + WS_WIN); bf16_t* WbT = (bf16_t*)(ws + WS_WB); bf16_t* WoT = (bf16_t*)(ws + WS_WO); \
    bf16_t* WuqT = (bf16_t*)(ws + WS_WUQ); bf16_t* WukvT = (bf16_t*)(ws + WS_WUKV); \
    float* cosT = (float*)(ws + WS_COS); float* sinT = (float*)(ws + WS_SIN); float* dtabG = (float*)(ws + WS_DTAB); float* ctabG = (float*)(ws + WS_CTAB); \
    bf16_t* Hb = (bf16_t*)(ws + WS_H); bf16_t* proj = (bf16_t*)(ws + WS_PROJ); bf16_t* qup = (bf16_t*)(ws + WS_QUP); bf16_t* kvup = (bf16_t*)(ws + WS_KVUP); \
    bf16_t* Qa = (bf16_t*)(ws + WS_QA); bf16_t* Ka = (bf16_t*)(ws + WS_KA); bf16_t* Va = (bf16_t*)(ws + WS_VA); \
    bf16_t* Qb = (bf16_t*)(ws + WS_QB); bf16_t* Kb = (bf16_t*)(ws + WS_KB); bf16_t* Qc = (bf16_t*)(ws + WS_QC); bf16_t* Kc = (bf16_t*)(ws + WS_KC); \
    bf16_t* Qd = (bf16_t*)(ws + WS_QD); bf16_t* Kd = (bf16_t*)(ws + WS_KD); bf16_t* Yb = (bf16_t*)(ws + WS_Y); \
    float* mixF = (float*)(ws + WS_MIXF); bf16_t* mixB = (bf16_t*)(ws + WS_MIXB); \
    (void)lane; (void)gw; (void)NGW; (void)gt; (void)NGT; (void)vcu; (void)WinT; (void)WbT; (void)WoT; (void)WuqT; (void)WukvT; (void)cosT; (void)sinT; (void)dtabG; (void)ctabG; \
    (void)Hb; (void)proj; (void)qup; (void)kvup; (void)Qa; (void)Ka; (void)Va; (void)Qb; (void)Kb; (void)Qc; (void)Kc; (void)Qd; (void)Kd; (void)Yb; (void)mixF; (void)mixB;

        for (int rep_ = 0; rep_ < ((REP_MASK >> 0) & 1) + 1; ++rep_) {
    {
        PHASE_BEGIN
        LAS float* scr = (LAS float*)(lds + wid * 16384);
        constexpr int I_IN = (DM / 64) * (LDP / 32), I_BR = (512 / 64) * (DM / 32), I_O = (DM / 64) * (DM / 32), I_UQ = (384 / 64) * (768 / 32), I_UKV = (128 / 64) * (1024 / 32);
        constexpr int PER_L = I_IN + 4 * I_BR + I_O + I_UQ + I_UKV;
        for (int it = gw; it < DEPTH * PER_L; it += NGW) {
            const int l = it / PER_L; int r = it % PER_L;
            if (r < I_IN) { transpose_item_in(P.w_in + (size_t)l * DM * NIN, WinT + (size_t)l * LDP * DM, P.norm_w + l * DM, scr, r, lane); continue; } r -= I_IN;
            if (r < 4 * I_BR) { const int n = r / I_BR; transpose_item(P.w_branch + ((size_t)l * 4 + n) * 512 * DM, 512, DM, WbT + (size_t)l * DM * DM + n * 512, DM, nullptr, scr, r % I_BR, lane); continue; } r -= 4 * I_BR;
            if (r < I_O) { transpose_item(P.w_out + (size_t)l * DM * DM, DM, DM, WoT + (size_t)l * DM * DM, DM, nullptr, scr, r, lane); continue; } r -= I_O;
            if (r < I_UQ) { transpose_item(P.mla_w_uq + (size_t)l * 384 * 768, 384, 768, WuqT + (size_t)l * 768 * 384, 384, P.mla_q_norm + l * 384, scr, r, lane); continue; } r -= I_UQ;
            transpose_item(P.mla_w_ukv + (size_t)l * 128 * 1024, 128, 1024, WukvT + (size_t)l * 1024 * 256, 256, P.mla_kv_norm + l * 128, scr, r, lane);
        }
        for (int i = gt; i < DEPTH * 1024 * 16; i += NGT) { const int row = i / 16, c = i % 16;
            *(u32x4*)(WukvT + (size_t)row * 256 + 128 + c * 8) = (u32x4){0u, 0u, 0u, 0u}; }
        { float* ssq = (float*)(ws + WS_SSQ);
          for (int i = gt; i < 4 * S; i += NGT) ssq[S + i] = 0.f;
          for (int row = gw; row < S; row += NGW) {
              const f32x4* xr = (const f32x4*)(P.x + (size_t)row * DM) + lane;
              u32x2* o8 = (u32x2*)(Hb + (size_t)row * DM) + lane; float ss = 0.f;
#pragma unroll
              for (int j = 0; j < 8; ++j) { const f32x4 v = xr[64 * j]; ss += (v.x * v.x + v.y * v.y) + (v.z * v.z + v.w * v.w);
                  u32x2 o; o.x = cvt_pk(v.x, v.y); o.y = cvt_pk(v.z, v.w); o8[64 * j] = o; }
              ss = wave_sum(ss, lane);
              if (lane == 0) ssq[row] = ss;
          } }
        for (int i = gt; i < S * 16; i += NGT) { const int pos = i >> 4, fi = i & 15;
            const float inv = powf(10000.0f, -(float)(2 * fi) / 32.0f);
            const float ang = (float)pos * inv;
            const double rev = (double)ang * 0.15915494309189535; const float fr = (float)(rev - rint(rev));
            cosT[i] = __builtin_amdgcn_cosf(fr); sinT[i] = __builtin_amdgcn_sinf(fr); }
        for (int i = gt; i < 4 * 2048; i += NGT) { const int h = i >> 11, k = i & 2047; const int rel = k - 1023;
            dtabG[i] = (k < 2047) ? P.rel_bias[rel_bucket(rel) * 28 + 24 + h] * LOG2E : 0.f; }
        for (int i = gt; i < 24 * 132; i += NGT) { const int gh = i / 132, j = i % 132; const int g = gh >> 3; const int dil = 1 << (2 * g);
            ctabG[i] = (j < 129) ? P.rel_bias[rel_bucket((j - 64) * dil) * 28 + gh] * LOG2E : 0.f; }
    }
    grid.sync();
    if (wid0 == 0 && __builtin_amdgcn_mbcnt_hi(~0u, __builtin_amdgcn_mbcnt_lo(~0u, 0u)) == 0u) (void)xb_add(&barw[XB_XCNT(xb_xcc_id())], 1u);
        }

    for (int l = 0; l < DEPTH; ++l) {
        for (int rep_ = 0; rep_ < ((REP_MASK >> 2) & 1) + 1; ++rep_) {
        {
            PHASE_BEGIN
            pg8::SchedGrid sc{(const char*)Hb, (const char*)(WinT + (size_t)l * LDP * DM), S / 256, LDP / 256, G, bx, (size_t)256 * DM * 2, (size_t)256 * DM * 2};
            pg8::EpiProj ep{proj, (const float*)(ws + WS_SSQ) + (size_t)l * S, P.gqa_qk_norm + l * 128, P.dil_qk_norm + l * 384, P.diff_qk_norm + l * 128, cosT, sinT, Qb, Kb, Qc, Kc, Qd, Kd};
            pg8::gemm_phase(lds, tid, DM, DM, DM, sc, ep);
        }
        GRID_SYNC();
        }
        {
            PHASE_BEGIN
            { pg8::SchedGrid sc{(const char*)(proj + C_ACQ), (const char*)(WuqT + (size_t)l * 768 * 384), S / 256, 3, G, bx, (size_t)256 * LDP * 2, (size_t)256 * 384 * 2};
              pg8::EpiBf16 ep{qup, 768}; pg8::gemm_phase(lds, tid, 384, LDP, 384, sc, ep); }
            { pg8::SchedGrid sc{(const char*)(proj + C_ACKV), (const char*)(WukvT + (size_t)l * 1024 * 256), S / 256, 4, G, (bx + 128) % G, (size_t)256 * LDP * 2, (size_t)256 * 256 * 2};
              pg8::EpiBf16 ep{kvup, 1024}; pg8::gemm_phase(lds, tid, 256, LDP, 256, sc, ep); }
        }
        XCD_ARRIVE();
        {
            for (int rb_ = 0; rb_ < ((REP_MASK >> 9) & 1) + 1; ++rb_)
            { PHASE_BEGIN
            const float nbound = uni(-(64.0f * 0.125f * LOG2E * 1.02f) * wave_absmax(P.gqa_qk_norm + (l * 2 + 0) * 64, 64, lane) * wave_absmax(P.gqa_qk_norm + (l * 2 + 1) * 64, 64, lane));
            for (int u = vcu; u < 256; u += G) {
                const int h = u >> 5, qb = u & 31, q0 = qb * 256 + wid * 32, kv = h >> 2;
                f32x16 o[2]; float lsum;
                attn_dense_pair<64, 64, 64>(lds, tid, Qb + ((size_t)h * S + q0) * 64, 64, Kb + (size_t)kv * S * 64, 64, proj + C_BV + kv * 64, LDP, nbound, o, lsum);
                { RELANE(l2) int u2 = u; asm volatile("" : "+s"(u2)); const int h2 = u2 >> 5, q02 = (u2 & 31) * 256 + wid * 32;
                  store_y64(o, 1.0f / lsum, Yb, proj, q02 + (l2 & 31), 512 + h2 * 64, l2 >> 5); }
            } }
        }
        XCD_WAIT(2 * l + 1);
        {
            PHASE_BEGIN
            const float scl = 0.10206207261596575f * LOG2E;
            for (int it2 = gt; it2 < S * 16; it2 += NGT) {
              if (it2 < S * 8) {
                const int it = it2;
                const int t = it >> 3, h = it & 7;
                size_t wz_ = 0; asm volatile("" : "+s"(wz_)); const float* wq = P.mla_qk_norm + (l * 2 + 0) * 96 + wz_;
                const bf16_t* src = qup + (size_t)t * 768 + h * 96;
                u32x4 rc[6], rq[12];
#pragma unroll
                for (int i = 0; i < 6; ++i) rc[i] = *(const u32x4*)(proj + (size_t)t * LDP + C_ACQ + h * 48 + i * 8);
#pragma unroll
                for (int i = 0; i < 12; ++i) rq[i] = *(const u32x4*)(src + i * 8);
                float cs = 0.f;
#pragma unroll
                for (int i = 0; i < 6; ++i) { float c8[8]; unpack8(rc[i], c8);
#pragma unroll
                    for (int j = 0; j < 8; ++j) cs += c8[j] * c8[j]; }
                cs += shx(cs, 1, lane); cs += shx(cs, 2, lane); cs += shx(cs, 4, lane);
                const float rstd = rsqrtf(cs * (1.0f / 384.0f) + EPS);
                float ss = 0.f;
#pragma unroll
                for (int i = 0; i < 12; ++i) { float c8[8]; unpack8(rq[i], c8);
#pragma unroll
                    for (int j = 0; j < 8; ++j) { const float v = c8[j] * rstd; ss += v * v; } }
                const float rn = rsqrtf(ss * (1.0f / 96.0f) + EPS) * rstd;
                bf16_t* dst = Qa + ((size_t)h * S + t) * 96;
#pragma unroll
                for (int i = 0; i < 8; ++i) { float c8[8]; unpack8(rq[i], c8);
#pragma unroll
                    for (int j = 0; j < 8; ++j) c8[j] *= rn * wq[i * 8 + j] * scl;
                    *(u32x4*)(dst + 8 * i) = pack8(c8); }
#pragma unroll
                for (int i = 0; i < 2; ++i) { float a8[8], b8[8]; unpack8(rq[8 + i], a8); unpack8(rq[10 + i], b8);
#pragma unroll
                    for (int j = 0; j < 8; ++j) { const float a = a8[j] * rn * wq[64 + i * 8 + j], b = b8[j] * rn * wq[80 + i * 8 + j];
                        const float c = cosT[t * 16 + i * 8 + j], sn = sinT[t * 16 + i * 8 + j];
                        a8[j] = (a * c - b * sn) * scl; b8[j] = (a * sn + b * c) * scl; }
                    *(u32x4*)(dst + 64 + 8 * i) = pack8(a8); *(u32x4*)(dst + 80 + 8 * i) = pack8(b8); }
              } else {
                const int it = it2 - S * 8;
                const int t = it >> 3, h = it & 7;
                size_t wz_ = 0; asm volatile("" : "+s"(wz_)); const float* wk = P.mla_qk_norm + (l * 2 + 1) * 96 + wz_;
                const bf16_t* src = kvup + (size_t)t * 1024 + h * 128;
                const bf16_t* srcr = proj + (size_t)t * LDP + C_AKR;
                u32x4 rc[2], rk[8], rr[4], rv[8];
#pragma unroll
                for (int i = 0; i < 2; ++i) rc[i] = *(const u32x4*)(proj + (size_t)t * LDP + C_ACKV + h * 16 + i * 8);
#pragma unroll
                for (int i = 0; i < 8; ++i) { rk[i] = *(const u32x4*)(src + i * 8); rv[i] = *(const u32x4*)(src + 64 + i * 8); }
#pragma unroll
                for (int i = 0; i < 4; ++i) rr[i] = *(const u32x4*)(srcr + i * 8);
                float cs = 0.f;
#pragma unroll
                for (int i = 0; i < 2; ++i) { float c8[8]; unpack8(rc[i], c8);
#pragma unroll
                    for (int j = 0; j < 8; ++j) cs += c8[j] * c8[j]; }
                cs += shx(cs, 1, lane); cs += shx(cs, 2, lane); cs += shx(cs, 4, lane);
                const float rstd = rsqrtf(cs * (1.0f / 128.0f) + EPS);
                float ss = 0.f;
#pragma unroll
                for (int i = 0; i < 8; ++i) { float c8[8]; unpack8(rk[i], c8);
#pragma unroll
                    for (int j = 0; j < 8; ++j) { const float v = c8[j] * rstd; ss += v * v; } }
#pragma unroll
                for (int i = 0; i < 4; ++i) { float c8[8]; unpack8(rr[i], c8);
#pragma unroll
                    for (int j = 0; j < 8; ++j) ss += c8[j] * c8[j]; }
                const float rn = rsqrtf(ss * (1.0f / 96.0f) + EPS);
                bf16_t* dst = Ka + ((size_t)h * S + t) * 96;
#pragma unroll
                for (int i = 0; i < 8; ++i) { float c8[8]; unpack8(rk[i], c8);
#pragma unroll
                    for (int j = 0; j < 8; ++j) c8[j] *= rstd * rn * wk[i * 8 + j];
                    *(u32x4*)(dst + 8 * i) = pack8(c8); }
#pragma unroll
                for (int i = 0; i < 2; ++i) { float a8[8], b8[8]; unpack8(rr[i], a8); unpack8(rr[2 + i], b8);
#pragma unroll
                    for (int j = 0; j < 8; ++j) { const float a = a8[j] * rn * wk[64 + i * 8 + j], b = b8[j] * rn * wk[80 + i * 8 + j];
                        const float c = cosT[t * 16 + i * 8 + j], sn = sinT[t * 16 + i * 8 + j];
                        a8[j] = a * c - b * sn; b8[j] = a * sn + b * c; }
                    *(u32x4*)(dst + 64 + 8 * i) = pack8(a8); *(u32x4*)(dst + 80 + 8 * i) = pack8(b8); }
                bf16_t* dv = Va + ((size_t)h * S + t) * 64;
#pragma unroll
                for (int i = 0; i < 8; ++i) { float c8[8]; unpack8(rv[i], c8);
#pragma unroll
                    for (int j = 0; j < 8; ++j) c8[j] *= rstd;
                    *(u32x4*)(dv + 8 * i) = pack8(c8); }
              }
            }
        }
        XCD_ARRIVE();
        {
            for (int rd_ = 0; rd_ < ((REP_MASK >> 10) & 1) + 1; ++rd_)
            {
                PHASE_BEGIN
                float maxb = 0.f;
                for (int i = lane; i < 32 * 28; i += 64) maxb = fmaxf(maxb, fabsf(P.rel_bias[i]));
#pragma unroll
                for (int o_ = 1; o_ < 64; o_ <<= 1) maxb = fmaxf(maxb, shx(maxb, o_, lane));
                const float nbound = uni(-((64.0f * 0.125f * LOG2E * 1.02f) * wave_absmax(P.diff_qk_norm + (l * 2 + 0) * 64, 64, lane) * wave_absmax(P.diff_qk_norm + (l * 2 + 1) * 64, 64, lane) + maxb * LOG2E));
                constexpr int DBUF = 2 * (64 * (128 * 2 + 16) + 64 * (128 * 2 + 64));
                LAS float* dtab = (LAS float*)(lds + DBUF);
                LAS float* xch = (LAS float*)lds;
                for (int u = vcu; u < 256; u += G) {
                    const int h = u >> 6, qb = u & 63, map = wid >> 2, q0 = qb * 128 + (wid & 3) * 32;
                    for (int i = tid; i < 2048; i += 512) dtab[i] = dtabG[h * 2048 + i] + nbound;
                    __syncthreads();
                    f32x16 o[4]; float lsum;
                    attn_dense<128, 64, 128, 1>(lds, tid, Qd + ((size_t)h * S + q0) * 128 + map * 64, 128, Kd + (size_t)h * S * 128, 128, proj + C_DV + h * 128, LDP, map * 64, q0, dtab, nbound, 0, o, lsum);
                    const float linv = 1.0f / lsum;
                    RELANE(l2) int u2 = u; asm volatile("" : "+s"(u2));
                    const int h2 = u2 >> 6, q02 = (u2 & 63) * 128 + (wid & 3) * 32, hi2 = l2 >> 5;
                    if (map == 1) {
#pragma unroll
                        for (int d0 = 0; d0 < 4; ++d0)
#pragma unroll
                            for (int r = 0; r < 16; ++r) xch[(d0 * 16 + r) * 256 + (wid & 3) * 64 + l2] = o[d0][r] * linv;
                    }
                    __syncthreads();
                    if (map == 0) {
                        const float* lv = P.diff_lambda + l * 256;
                        const float d01 = wave_sum(lv[l2] * lv[64 + l2], l2), d23 = wave_sum(lv[128 + l2] * lv[192 + l2], l2);
                        const float lambda_init = 0.8f - 0.6f * expf(-0.3f * (float)l);
                        const float lam = expf(d01) - expf(d23) + lambda_init;
                        float ss = 0.f;
#pragma unroll
                        for (int d0 = 0; d0 < 4; ++d0)
#pragma unroll
                            for (int r = 0; r < 16; ++r) { const float v = o[d0][r] * linv - lam * xch[(d0 * 16 + r) * 256 + wid * 64 + l2]; o[d0][r] = v; ss += v * v; }
                        ss += shx(ss, 32, l2);
                        const float rn = rsqrtf(ss * (1.0f / 128.0f) + EPS) * (1.0f - lambda_init);
                        const int token = q02 + (l2 & 31); const float* sw = P.diff_subnorm + l * 128;
#pragma unroll
                        for (int d0 = 0; d0 < 4; ++d0) {
#pragma unroll
                            for (int g = 0; g < 4; ++g) {
                                const int dv = 32 * d0 + 8 * g + 4 * hi2, col = 1536 + h2 * 128 + dv;
                                const u32x2 gv = *(const u32x2*)(proj + (size_t)token * LDP + C_SILU + col);
                                const f32x4 w = *(const f32x4*)(sw + dv);
                                u32x2 ov;
                                ov.x = cvt_pk(o[d0][4 * g + 0] * rn * w.x * bflo(gv.x), o[d0][4 * g + 1] * rn * w.y * bfhi(gv.x));
                                ov.y = cvt_pk(o[d0][4 * g + 2] * rn * w.z * bflo(gv.y), o[d0][4 * g + 3] * rn * w.w * bfhi(gv.y));
                                *(u32x2*)(Yb + (size_t)token * DM + col) = ov;
                            }
                            asm volatile("" ::: "memory");
                        }
                    }
                    __syncthreads();
                }
            }
            for (int rc_ = 0; rc_ < ((REP_MASK >> 11) & 1) + 1; ++rc_)
            {
                PHASE_BEGIN const int r32 = lane & 31, hi = lane >> 5;
                float nbound;
                { RELANE(l6)
                  float maxb = 0.f;
                  for (int i = l6; i < 32 * 28; i += 64) maxb = fmaxf(maxb, fabsf(P.rel_bias[i]));
#pragma unroll
                  for (int o_ = 1; o_ < 64; o_ <<= 1) maxb = fmaxf(maxb, shx(maxb, o_, l6));
                  float wmax = 0.f;
                  for (int g_ = 0; g_ < 3; ++g_) wmax = fmaxf(wmax, wave_absmax(P.dil_qk_norm + ((l * 2 + 0) * 3 + g_) * 64, 64, l6) * wave_absmax(P.dil_qk_norm + ((l * 2 + 1) * 3 + g_) * 64, 64, l6));
                  nbound = uni(-((64.0f * 0.125f * LOG2E * 1.02f) * wmax + maxb * LOG2E)); }
                constexpr int CKP = 144, CVP = 144, CKT = 64 * CKP, CWB = CKT + 64 * CVP;
                constexpr int CR0 = 576, CR1 = 192, CR2 = 128, CT1 = 2 * CR0 + 1, CT2 = CT1 + 2 * CR1 + 1, CTN = CT2 + 2 * CR2 + 1;
                LAS float* ctab = (LAS float*)(lds + 8 * CWB);
                LAS unsigned char* wl = lds + wid * CWB;
                for (int u = vcu; u < 256; u += G) {
                    const int h = u >> 5, bb = (u >> 1) & 15, rh = u & 1, r16 = rh * 8 + wid, i0 = bb * 32;
                    __syncthreads();
                    RELANE(l5)
                    for (int i = wid * 64 + l5; i < CTN; i += 512) { const int g_ = i < CT1 ? 0 : (i < CT2 ? 1 : 2); const int rel = i - (g_ == 0 ? CR0 : (g_ == 1 ? CT1 + CR1 : CT2 + CR2));
                        ctab[i] = (rel >= -64 && rel <= 64) ? ctabG[(g_ * 8 + h) * 132 + rel + 64] + nbound : -INFINITY; }
                    __syncthreads();
                    float lsum = 0.f; f32x16 o[2];
#pragma unroll
                    for (int d0 = 0; d0 < 2; ++d0)
#pragma unroll
                        for (int r = 0; r < 16; ++r) o[d0][r] = 0.f;
                    bf16x8 qf[4]; u32x4 kreg[8], vreg[8];
                    float ls[4] = {0.f, 0.f, 0.f, 0.f};
                    const int koff = r32 * CKP + hi * 16;
                    const int voff = CKT + (4 * hi + ((lane & 15) >> 2)) * CVP + (((lane >> 4) & 1) * 16 + (lane & 3) * 4) * 2;
#define C_DECODE(T, g_, tt_) const int g_ = (T) < 10 ? 0 : ((T) < 14 ? 1 : 2); const int tt_ = (T) - (g_ == 0 ? 0 : (g_ == 1 ? 10 : 14));
#define C_GLOAD(T) do { C_DECODE(T, g__, tt__) const int sh__ = 2 * g__, e__ = 16 >> sh__, rc__ = r16 & ((1 << sh__) - 1), L__ = S >> sh__; const int kb__ = e__ * i0 - 64 + 64 * tt__; \
        const char* kg__ = (const char*)(Kc + (size_t)(g__ * 8 + h) * S * 64); const char* vg__ = (const char*)(proj + C_CV + (g__ * 8 + h) * 64); \
        if (kb__ >= 0 && kb__ + 64 <= L__) {        \
            const size_t tok0__ = (size_t)((kb__ << sh__) + rc__); const char* kt__ = kg__ + tok0__ * 128; const char* vt__ = vg__ + tok0__ * (LDP * 2); \
            _Pragma("unroll") for (int i_ = 0; i_ < 8; ++i_) { const unsigned dk_ = (unsigned)((key0 + 8 * i_) << sh__); \
                kreg[i_] = *(const u32x4*)(kt__ + dk_ * 128u + part16); vreg[i_] = *(const u32x4*)(vt__ + dk_ * (unsigned)(LDP * 2) + part16); } \
        } else { \
            _Pragma("unroll") for (int i_ = 0; i_ < 8; ++i_) { int ks_ = kb__ + key0 + 8 * i_; ks_ = ks_ < 0 ? 0 : ks_; ks_ = ks_ > L__ - 1 ? L__ - 1 : ks_; \
                const size_t tok_ = (size_t)((ks_ << sh__) + rc__); kreg[i_] = *(const u32x4*)(kg__ + tok_ * 128 + part16); vreg[i_] = *(const u32x4*)(vg__ + tok_ * (LDP * 2) + part16); } \
        } } while (0)
                    {
                        RELANE(l4) const int tid4 = wid * 64 + l4, r32g = l4 & 31, hig = l4 >> 5;
                        const int koffg = r32g * CKP + hig * 16;
                        const int voffg = CKT + (4 * hig + ((l4 & 15) >> 2)) * CVP + (((l4 >> 4) & 1) * 16 + (l4 & 3) * 4) * 2;
                        const int h0 = h;
                        const char* kg0 = (const char*)(Kc + (size_t)(0 * 8 + h0) * S * 64); const char* vg0 = (const char*)(proj + C_CV + (0 * 8 + h0) * 64);
                        const int skey = tid4 >> 3, spart16 = (tid4 & 7) * 16;
                        u32x4 kr0, vr0;
                        const bf16_t* qg = Qc + ((size_t)(0 * 8 + h0) * S + 16 * i0 + r16) * 64;
#pragma unroll
                        for (int d0 = 0; d0 < 4; ++d0) qf[d0] = *(const bf16x8*)(qg + (size_t)r32g * 1024 + d0 * 16 + hig * 8);
#define C0_GLOAD(tt_) do { int ks_ = 16 * i0 - 64 + 64 * (tt_) + skey; ks_ = ks_ < 0 ? 0 : ks_; ks_ = ks_ > S - 1 ? S - 1 : ks_; \
        kr0 = *(const u32x4*)(kg0 + (size_t)ks_ * 128 + spart16); vr0 = *(const u32x4*)(vg0 + (size_t)ks_ * (LDP * 2) + spart16); } while (0)
#define C0_LSTORE(b_) do { *(LAS u32x4*)(lds + (b_) * CWB + skey * CKP + spart16) = kr0; *(LAS u32x4*)(lds + (b_) * CWB + CKT + skey * CVP + spart16) = vr0; } while (0)
#define C0_GLOAD_K(tt_) do { int ks_ = 16 * i0 - 64 + 64 * (tt_) + skey; ks_ = ks_ < 0 ? 0 : ks_; ks_ = ks_ > S - 1 ? S - 1 : ks_; kr0 = *(const u32x4*)(kg0 + (size_t)ks_ * 128 + spart16); } while (0)
#define C0_GLOAD_V(tt_) do { int ks_ = 16 * i0 - 64 + 64 * (tt_) + skey; ks_ = ks_ < 0 ? 0 : ks_; ks_ = ks_ > S - 1 ? S - 1 : ks_; vr0 = *(const u32x4*)(vg0 + (size_t)ks_ * (LDP * 2) + spart16); } while (0)
#define C0_LSTORE_K(b_) do { *(LAS u32x4*)(lds + (b_) * CWB + skey * CKP + spart16) = kr0; } while (0)
#define C0_LSTORE_V(b_) do { *(LAS u32x4*)(lds + (b_) * CWB + CKT + skey * CVP + spart16) = vr0; } while (0)
#define C0_CINIT(P0, P1, tt_) do { const int kb_ = 16 * i0 - 64 + 64 * (tt_); const LAS float* tp_ = ctab + CR0 + (kb_ + 4 * hig - subq); \
        _Pragma("unroll") for (int r = 0; r < 16; ++r) { P0[r] = tp_[(r & 3) + 8 * (r >> 2)]; P1[r] = tp_[32 + (r & 3) + 8 * (r >> 2)]; } \
        if (kb_ < 0 || kb_ + 64 > S) { \
            _Pragma("unroll") for (int r = 0; r < 16; ++r) { const int ks0_ = kb_ + 4 * hig + (r & 3) + 8 * (r >> 2); \
                if ((unsigned)ks0_ >= (unsigned)S) P0[r] = -INFINITY; \
                if ((unsigned)(ks0_ + 32) >= (unsigned)S) P1[r] = -INFINITY; } } } while (0)
                        const int subq = 16 * (i0 + r32g) + r16;
                        C0_GLOAD_K(0); C0_LSTORE_K(0);
                        __syncthreads();
                        C0_GLOAD_K(1); C0_GLOAD_V(0);
                        u32x4 pw0_[4];
                        { f32x16 pc0, pc1; C0_CINIT(pc0, pc1, 0);
                          qk_tile<64, CKP>(pc0, pc1, lds + koffg, qf); exp_tile(pc0, pc1); pack_tile(pc0, pc1, pw0_); }
                        C0_LSTORE_K(1); C0_LSTORE_V(0);
                        __syncthreads();
                        f32x16 cdummy;
#pragma unroll
                        for (int r = 0; r < 16; ++r) cdummy[r] = 0.f;
                        for (int tt = 1; tt < 10; ++tt) {
                            C0_GLOAD_K(tt + 1 < 10 ? tt + 1 : 9); C0_GLOAD_V(tt);
                            f32x16 pn0, pn1; C0_CINIT(pn0, pn1, tt);
                            __builtin_amdgcn_sched_barrier(0);
                            tile_step<64, CKP, 64, CVP, false>(pw0_, pn0, pn1, cdummy, ls, o, qf, lds + (tt & 1) * CWB + koffg, lds + ((tt - 1) & 1) * CWB + voffg);
                            C0_LSTORE_K((tt + 1) & 1); C0_LSTORE_V(tt & 1);
                            __syncthreads();
                        }
                        rowsum_pw(pw0_, ls);
                        pv_tile<64, CVP>(o, pw0_, lds + (9 & 1) * CWB + voffg);
                        __syncthreads();
#undef C0_GLOAD_K
#undef C0_GLOAD_V
#undef C0_LSTORE_K
#undef C0_LSTORE_V
#undef C0_CINIT
#undef C0_GLOAD
#undef C0_LSTORE
                    }
                    RELANE(l3) const int key0 = l3 >> 3, part16 = (l3 & 7) * 16;
                    size_t z3_ = 0; asm volatile("" : "+s"(z3_)); const bf16_t* Kc_ = Kc + z3_; const bf16_t* Qc_ = Qc + z3_; const bf16_t* proj_ = proj + z3_;
                    int u3_ = u; asm volatile("" : "+s"(u3_));
                    const int h_ = u3_ >> 5, i0_w = ((u3_ >> 1) & 15) * 32, r16_ = (u3_ & 1) * 8 + wid, r32_ = l3 & 31, hi_ = l3 >> 5;
                    const int koff_ = r32_ * CKP + hi_ * 16;
                    const int voff_ = CKT + (4 * hi_ + ((l3 & 15) >> 2)) * CVP + (((l3 >> 4) & 1) * 16 + (l3 & 3) * 4) * 2;
#define Kc Kc_
#define Qc Qc_
#define proj proj_
#define h h_
#define i0 i0_w
#define r16 r16_
#define r32 r32_
#define hi hi_
#define koff koff_
#define voff voff_
                    C_GLOAD(10);
                    for (int T = 10; T < 17; ++T) {
                        C_DECODE(T, g, tt)
                        const int sh = 2 * g, e = 16 >> sh, L = S >> sh;
                        if (tt == 0) {
                            const bf16_t* qg = Qc + ((size_t)(g * 8 + h) * S + 16 * i0 + r16) * 64;
#pragma unroll
                            for (int d0 = 0; d0 < 4; ++d0) qf[d0] = *(const bf16x8*)(qg + (size_t)r32 * 1024 + d0 * 16 + hi * 8);
                        }
#pragma unroll
                        for (int i_ = 0; i_ < 8; ++i_) { *(LAS u32x4*)(wl + (key0 + 8 * i_) * CKP + part16) = kreg[i_]; *(LAS u32x4*)(wl + CKT + (key0 + 8 * i_) * CVP + part16) = vreg[i_]; }
                        if (T + 1 < 17) C_GLOAD(T + 1);
                        const int kb = e * i0 - 64 + 64 * tt;
                        const int subq = e * (i0 + r32) + (r16 >> sh);
                        const LAS float* tp = ctab + (g == 0 ? CR0 : (g == 1 ? CT1 + CR1 : CT2 + CR2)) + (kb + 4 * hi - subq);
                        f32x16 p0, p1;
#pragma unroll
                        for (int r = 0; r < 16; ++r) { p0[r] = tp[(r & 3) + 8 * (r >> 2)]; p1[r] = tp[32 + (r & 3) + 8 * (r >> 2)]; }
                        if (kb < 0 || kb + 64 > L) {
#pragma unroll
                            for (int r = 0; r < 16; ++r) { const int ks0 = kb + 4 * hi + (r & 3) + 8 * (r >> 2);
                                if ((unsigned)ks0 >= (unsigned)L) p0[r] = -INFINITY;
                                if ((unsigned)(ks0 + 32) >= (unsigned)L) p1[r] = -INFINITY; }
                        }
                        qk_tile<64, CKP>(p0, p1, wl + koff, qf);
                        exp_tile(p0, p1);
                        u32x4 pw_[4]; pack_tile(p0, p1, pw_); rowsum_pw(pw_, ls);
                        pv_tile<64, CVP>(o, pw_, wl + voff);
                    }
                    lsum = (ls[0] + ls[1]) + (ls[2] + ls[3]);
#undef Kc
#undef Qc
#undef proj
#undef h
#undef i0
#undef r16
#undef r32
#undef hi
#undef koff
#undef voff
#undef C_GLOAD
#undef C_DECODE
                    { RELANE(l2) lsum += shx(lsum, 32, l2); int u2 = u; asm volatile("" : "+s"(u2)); const int h2 = u2 >> 5, i02 = ((u2 >> 1) & 15) * 32, r162 = (u2 & 1) * 8 + wid;
                      store_y64(o, 1.0f / lsum, Yb, proj, 16 * (i02 + (l2 & 31)) + r162, 1024 + h2 * 64, l2 >> 5); }
                }
                __syncthreads();
            }
        }
        XCD_WAIT(2 * l + 2);
        {
            for (int ra_ = 0; ra_ < ((REP_MASK >> 8) & 1) + 1; ++ra_)
            { PHASE_BEGIN
            const float nbound = uni(-(96.0f * 0.10206207261596575f * LOG2E * 1.02f) * wave_absmax(P.mla_qk_norm + (l * 2 + 0) * 96, 96, lane) * wave_absmax(P.mla_qk_norm + (l * 2 + 1) * 96, 96, lane));
            for (int u = vcu; u < 256; u += G) {
                const int h = u >> 5, qb = u & 31, q0 = qb * 256 + wid * 32;
                f32x16 o[2]; float lsum;
                attn_dense<96, 96, 64, 0>(lds, tid, Qa + ((size_t)h * S + q0) * 96, 96, Ka + (size_t)h * S * 96, 96, Va + (size_t)h * S * 64, 64, 0, 0, nullptr, nbound, 0, o, lsum);
                { RELANE(l2) int u2 = u; asm volatile("" : "+s"(u2)); const int h2 = u2 >> 5, q02 = (u2 & 31) * 256 + wid * 32;
                  store_y64(o, 1.0f / lsum, Yb, proj, q02 + (l2 & 31), 0 + h2 * 64, l2 >> 5); }
            } }
        }
        GRID_SYNC();
        for (int rep_ = 0; rep_ < ((REP_MASK >> 6) & 1) + 1; ++rep_) {
        {
            PHASE_BEGIN
            pg8::SchedGrid sc{(const char*)Yb, (const char*)(WbT + (size_t)l * DM * DM), S / 256, DM / 256, G, bx, (size_t)256 * DM * 2, (size_t)256 * DM * 2};
            pg8::EpiBranch ep{mixB, proj + C_GATE};
            pg8::gemm_phase(lds, tid, DM, DM, DM, sc, ep);
        }
        GRID_SYNC();
        }
        if (REP_MASK & 128) { for (int k_ = 0; k_ < 8; ++k_) grid.sync(); }
        {
            PHASE_BEGIN
            const float* xin = (l == 0) ? P.x : P.out;
            pg8::SchedGrid sc{(const char*)mixB, (const char*)(WoT + (size_t)l * DM * DM), S / 256, DM / 256, G, bx, (size_t)256 * DM * 2, (size_t)256 * DM * 2};
            if (l + 1 < DEPTH) { pg8::EpiOut<true> ep{xin, P.out, Hb, (float*)(ws + WS_SSQ) + (size_t)(l + 1) * S}; pg8::gemm_phase(lds, tid, DM, DM, DM, sc, ep); }
            else { pg8::EpiOut<false> ep{xin, P.out, nullptr, nullptr}; pg8::gemm_phase(lds, tid, DM, DM, DM, sc, ep); }
        }
        if (l + 1 < DEPTH) GRID_SYNC();
    }
}

extern "C" void kernel_launch(void* const* d_in, const int* in_sizes, int n_in, void* d_out, int out_size, void* d_ws, size_t ws_size, hipStream_t stream) {
    static int grid = 0;
    if (grid == 0) {
        int dev = 0, cus = 0, per_cu = 0;
        hipGetDevice(&dev);
        hipDeviceGetAttribute(&cus, hipDeviceAttributeMultiprocessorCount, dev);
        hipFuncSetAttribute((const void*)mega, hipFuncAttributeMaxDynamicSharedMemorySize, LDS_BYTES);
        hipOccupancyMaxActiveBlocksPerMultiprocessor(&per_cu, (const void*)mega, 512, LDS_BYTES);
        if (per_cu < 1) per_cu = 1;
        grid = cus * 1;
        (void)hipGetLastError();
        if (ws_size < WS_END) { fprintf(stderr, "kernel_launch: workspace too small (%zu < %zu)\n", ws_size, (size_t)WS_END); grid = -1; }
    }
    if (grid < 0) return;
    Params p{};
    p.x = (const float*)d_in[0]; p.norm_w = (const float*)d_in[1]; p.w_in = (const float*)d_in[2]; p.mla_q_norm = (const float*)d_in[3];
    p.mla_kv_norm = (const float*)d_in[4]; p.mla_w_uq = (const float*)d_in[5]; p.mla_w_ukv = (const float*)d_in[6]; p.mla_qk_norm = (const float*)d_in[7];
    p.gqa_qk_norm = (const float*)d_in[8]; p.dil_qk_norm = (const float*)d_in[9]; p.diff_qk_norm = (const float*)d_in[10]; p.diff_lambda = (const float*)d_in[11];
    p.diff_subnorm = (const float*)d_in[12]; p.rel_bias = (const float*)d_in[13]; p.w_branch = (const float*)d_in[14]; p.w_out = (const float*)d_in[15];
    p.out = (float*)d_out; p.ws = (unsigned char*)d_ws;
    void* args[] = {&p};
    hipError_t e = hipLaunchCooperativeKernel((const void*)mega, dim3(grid), dim3(512), args, LDS_BYTES, stream);
    if (e != hipSuccess) fprintf(stderr, "cooperative launch failed: %s (grid %d)\n", hipGetErrorString(e), grid);
}
```
